# Optimizing an MI355X kernel written in HIP

```python
import math
import jax
import jax.numpy as jnp
from jax import lax
import numpy as np

D_MODEL = 2048
BATCH = 2
SEQ = 4096
DEPTH = 4

GRID_W = 64
CTX_LEN = 256
N_MIXERS = 4
NORM_EPS = 1e-6
D_FF = 4 * D_MODEL
N_ADA = 6
FNO_GROUPS = 4
GMLP_CHUNK = 128
GMLP_HEADS = 16
GMLP_WIDTH = D_MODEL
DIFF_HEADS = 8
DIFF_HEAD_DIM = D_MODEL // DIFF_HEADS // 2
DIFF_BLOCK_Q = 128
ROPE_THETA = 10000.0
GLA_HEADS = 4
GLA_DK = D_MODEL // 2
GLA_DV = D_MODEL
GLA_DK_HEAD = GLA_DK // GLA_HEADS
GLA_DV_HEAD = GLA_DV // GLA_HEADS
GLA_GATE_RANK = 16
GLA_TAU = 16.0
GLA_CHUNK = 64
GLA_IN = 2 * GLA_DK + 2 * GLA_DV + 2 * GLA_GATE_RANK

kernel_name = 'hybrid_interleaved_fourier_gmlp_diffattn_gla_dit'


def _layer_count(kind):
    return len(range(kind, DEPTH, N_MIXERS))


def _rmsnorm(x, g, eps=NORM_EPS):
    xf = x.astype(jnp.float32)
    y = xf * lax.rsqrt(jnp.mean(xf * xf, axis=-1, keepdims=True) + eps)
    return (y * g.astype(jnp.float32)).astype(x.dtype)


def _layernorm(x, g, b, eps=1e-5):
    xf = x.astype(jnp.float32)
    mu = jnp.mean(xf, axis=-1, keepdims=True)
    xc = xf - mu
    var = jnp.mean(xc * xc, axis=-1, keepdims=True)
    return (xc * lax.rsqrt(var + eps) * g.astype(jnp.float32) + b.astype(jnp.float32)).astype(x.dtype)


def _modulate(x, g, shift, scale):
    return _rmsnorm(x, g) * (1 + scale) + shift


def _sq_relu_mlp(h, w_in, w_out):
    return jnp.square(jax.nn.relu(h @ w_in)) @ w_out


def fourier_mix(h, w_out):
    b, n, d = h.shape
    hg = h.astype(jnp.float32).reshape(b, n, FNO_GROUPS, d // FNO_GROUPS)
    f = jnp.fft.fftn(hg, axes=(1, 3), norm='ortho').real
    return f.reshape(b, n, d).astype(h.dtype) @ w_out


def chunk_gmlp(h, w_in, ln_g, ln_b, w_s, b_s, w_out):
    b, n, _ = h.shape
    z = jax.nn.gelu(h @ w_in, approximate=False)
    u, v = jnp.split(z, 2, axis=-1)
    v = _layernorm(v, ln_g, ln_b)
    vc = v.reshape(b, n // GMLP_CHUNK, GMLP_CHUNK, GMLP_HEADS, GMLP_WIDTH // GMLP_HEADS)
    s = jnp.einsum('hpq,bcqhe->bcphe', w_s, vc) + b_s.T[:, :, None]
    return (u * s.reshape(b, n, GMLP_WIDTH)) @ w_out


def _axial_rope(n, head_dim):
    rows = n // GRID_W
    row = jnp.broadcast_to(jnp.arange(rows)[:, None], (rows, GRID_W)).reshape(-1).astype(jnp.float32)
    col = jnp.broadcast_to(jnp.arange(GRID_W)[None, :], (rows, GRID_W)).reshape(-1).astype(jnp.float32)
    n_freq = head_dim // 4
    inv = ROPE_THETA ** (-jnp.arange(n_freq, dtype=jnp.float32) / n_freq)
    ang = jnp.concatenate([row[:, None] * inv, col[:, None] * inv], axis=-1)
    return jnp.cos(ang), jnp.sin(ang)


def _apply_rope(x, cos, sin):
    x1, x2 = jnp.split(x, 2, axis=-1)
    cos = cos.astype(x.dtype)
    sin = sin.astype(x.dtype)
    return jnp.concatenate([x1 * cos - x2 * sin, x1 * sin + x2 * cos], axis=-1)


def diff_attention(hx, hc, w_in, lam_vecs, subln_g, w_out, lam_init):
    b, n, d = hx.shape
    nh, hd = DIFF_HEADS, DIFF_HEAD_DIM

    def qkv(h):
        l = h.shape[1]
        q, k, v = jnp.split(h @ w_in, 3, axis=-1)
        q = q.reshape(b, l, nh, 2, hd).transpose(0, 2, 3, 1, 4)
        k = k.reshape(b, l, nh, 2, hd).transpose(0, 2, 3, 1, 4)
        v = v.reshape(b, l, nh, 2 * hd).transpose(0, 2, 1, 3)
        return q, k, v

    qx, kx, vx = qkv(hx)
    qc, kc, vc = qkv(hc)
    cos, sin = _axial_rope(n, hd)
    qx = _apply_rope(qx, cos, sin)
    kx = _apply_rope(kx, cos, sin)
    lam = (jnp.exp(jnp.sum(lam_vecs[0].astype(jnp.float32) * lam_vecs[1].astype(jnp.float32)))
           - jnp.exp(jnp.sum(lam_vecs[2].astype(jnp.float32) * lam_vecs[3].astype(jnp.float32)))
           + lam_init)
    scale = hd ** -0.5

    def attend(q, k, v):
        s = jnp.einsum('bhcqd,bhckd->bhcqk', q, k, preferred_element_type=jnp.float32) * scale
        p = jax.nn.softmax(s, axis=-1)
        a = p[:, :, 0] - lam * p[:, :, 1]
        return jnp.einsum('bhqk,bhkv->bhqv', a.astype(v.dtype), v)

    oc = attend(qc, kc, vc)
    k_all = jnp.concatenate([kx, kc], axis=3)
    v_all = jnp.concatenate([vx, vc], axis=2)
    nb = n // DIFF_BLOCK_Q
    q_blocks = jnp.moveaxis(qx.reshape(b, nh, 2, nb, DIFF_BLOCK_Q, hd), 3, 0)
    ox = lax.map(lambda qb: attend(qb, k_all, v_all), q_blocks)
    ox = jnp.moveaxis(ox, 0, 2).reshape(b, nh, n, 2 * hd)

    def finish(o):
        o = _rmsnorm(o, subln_g) * (1 - lam_init)
        return o.transpose(0, 2, 1, 3).reshape(b, o.shape[2], d) @ w_out

    return finish(ox), finish(oc)


def _gla_scan(q, k, v, g, s0):
    b, nh, l, _ = q.shape
    nc = l // GLA_CHUNK
    mask = jnp.tril(jnp.ones((GLA_CHUNK, GLA_CHUNK), dtype=bool))

    def to_chunks(t):
        return jnp.moveaxis(t.reshape(b, nh, nc, GLA_CHUNK, t.shape[-1]), 2, 0)

    def step(s, inp):
        qc, kc, vc, gc = inp
        bcum = jnp.cumsum(gc, axis=-2)
        blast = bcum[..., -1:, :]
        q_dec = qc * jnp.exp(bcum)
        k_inv = kc * jnp.exp(-bcum)
        k_tail = kc * jnp.exp(blast - bcum)
        att = jnp.where(mask, jnp.einsum('bhtd,bhsd->bhts', q_dec, k_inv), 0.0)
        o = jnp.einsum('bhtd,bhdv->bhtv', q_dec, s) + jnp.einsum('bhts,bhsv->bhtv', att, vc)
        s_new = jnp.exp(blast)[..., 0, :, None] * s + jnp.einsum('bhsd,bhsv->bhdv', k_tail, vc)
        return s_new, o

    s_final, o = lax.scan(step, s0, (to_chunks(q), to_chunks(k), to_chunks(v), to_chunks(g)))
    return jnp.moveaxis(o, 0, 2).reshape(b, nh, l, v.shape[-1]), s_final


def _gla_final_state(k, v, g):
    bcum = jnp.cumsum(g, axis=2)
    return jnp.einsum('bhsd,bhsv->bhdv', k * jnp.exp(bcum[:, :, -1:] - bcum), v)


def gla_mix(hx, hc, w_in, w_gate_up, b_gate, norm_g, w_out, need_ctx_out):
    b = hx.shape[0]
    splits = [GLA_DK, 2 * GLA_DK, 2 * GLA_DK + GLA_DV, 2 * GLA_DK + 2 * GLA_DV,
              2 * GLA_DK + 2 * GLA_DV + GLA_GATE_RANK]

    def project(h):
        l = h.shape[1]

        def heads(t, e):
            return t.reshape(b, l, GLA_HEADS, e).transpose(0, 2, 1, 3).astype(jnp.float32)

        q, k, v, r, gd_f, gd_b = jnp.split(h @ w_in, splits, axis=-1)

        def log_gate(gd, j):
            z = (gd @ w_gate_up[j] + b_gate[j]).astype(jnp.float32)
            return heads(jax.nn.log_sigmoid(z) / GLA_TAU, GLA_DK_HEAD)

        q = heads(q, GLA_DK_HEAD) * (GLA_DK_HEAD ** -0.5)
        return q, heads(k, GLA_DK_HEAD), heads(v, GLA_DV_HEAD), r, log_gate(gd_f, 0), log_gate(gd_b, 1)

    def flip(t):
        return jnp.flip(t, axis=2)

    def finish(o, r):
        o = _rmsnorm(o.astype(r.dtype), norm_g)
        l = o.shape[2]
        o = o.transpose(0, 2, 1, 3).reshape(b, l, GLA_DV)
        return (o * jax.nn.silu(r)) @ w_out

    qx, kx, vx, rx, gfx, gbx = project(hx)
    qc, kc, vc, rc, gfc, gbc = project(hc)
    zeros = jnp.zeros((b, GLA_HEADS, GLA_DK_HEAD, GLA_DV_HEAD), jnp.float32)
    if need_ctx_out:
        oc_f, sc_f = _gla_scan(qc, kc, vc, gfc, zeros)
        oc_b, sc_b = _gla_scan(flip(qc), flip(kc), flip(vc), flip(gbc), zeros)
        oc = finish(oc_f + flip(oc_b), rc)
    else:
        sc_f = _gla_final_state(kc, vc, gfc)
        sc_b = _gla_final_state(flip(kc), flip(vc), flip(gbc))
        oc = None
    ox_f, _ = _gla_scan(qx, kx, vx, gfx, sc_f)
    ox_b, _ = _gla_scan(flip(qx), flip(kx), flip(vx), flip(gbx), sc_b)
    return finish(ox_f + flip(ox_b), rx), oc


def setup_inputs(seed: int = 0) -> dict:
    key = jax.random.key(seed)
    keys = iter(jax.random.split(key, 32))
    f32 = jnp.float32
    d = D_MODEL

    def nrm(shape, scale):
        return jax.random.normal(next(keys), shape, f32) * scale

    def gain(shape):
        return 1.0 + 0.05 * jax.random.normal(next(keys), shape, f32)

    n_a, n_b, n_c, n_d = (_layer_count(m) for m in range(N_MIXERS))
    return {
        'x': nrm((BATCH, SEQ, d), 1.0),
        'c': nrm((BATCH, d), 1.0),
        'ctx': nrm((BATCH, CTX_LEN, d), 1.0),
        'c_ctx': nrm((d,), 1.0),
        'w_ada': nrm((DEPTH, d, N_ADA * d), 0.5 * d ** -0.5),
        'b_ada': nrm((DEPTH, N_ADA * d), 0.02),
        'g_norm_mix': gain((DEPTH, d)),
        'g_norm_ffn': gain((DEPTH, d)),
        'w_ffn_in': nrm((DEPTH, d, D_FF), d ** -0.5),
        'w_ffn_out': nrm((DEPTH, D_FF, d), D_FF ** -0.5),
        'g_final': gain((d,)),
        'fno_w_out': nrm((n_a, d, d), d ** -0.5),
        'gmlp_w_in': nrm((n_b, d, 2 * GMLP_WIDTH), d ** -0.5),
        'gmlp_ln_g': gain((n_b, GMLP_WIDTH)),
        'gmlp_ln_b': nrm((n_b, GMLP_WIDTH), 0.02),
        'gmlp_w_s': nrm((n_b, GMLP_HEADS, GMLP_CHUNK, GMLP_CHUNK), GMLP_CHUNK ** -0.5),
        'gmlp_b_s': gain((n_b, GMLP_HEADS, GMLP_CHUNK)),
        'gmlp_w_out': nrm((n_b, GMLP_WIDTH, d), GMLP_WIDTH ** -0.5),
        'diff_w_in': nrm((n_c, d, 3 * d), d ** -0.5),
        'diff_lambda': nrm((n_c, 4, DIFF_HEAD_DIM), 0.1),
        'diff_subln_g': gain((n_c, 2 * DIFF_HEAD_DIM)),
        'diff_w_out': nrm((n_c, d, d), d ** -0.5),
        'gla_w_in': nrm((n_d, d, GLA_IN), d ** -0.5),
        'gla_w_gate_up': nrm((n_d, 2, GLA_GATE_RANK, GLA_DK), GLA_GATE_RANK ** -0.5),
        'gla_b_gate': nrm((n_d, 2, GLA_DK), 0.1),
        'gla_norm_g': gain((n_d, GLA_DV_HEAD)),
        'gla_w_out': nrm((n_d, GLA_DV, d), GLA_DV ** -0.5),
    }


def reference(x, c, ctx, c_ctx, w_ada, b_ada, g_norm_mix, g_norm_ffn, w_ffn_in, w_ffn_out, g_final,
              fno_w_out, gmlp_w_in, gmlp_ln_g, gmlp_ln_b, gmlp_w_s, gmlp_b_s, gmlp_w_out,
              diff_w_in, diff_lambda, diff_subln_g, diff_w_out,
              gla_w_in, gla_w_gate_up, gla_b_gate, gla_norm_g, gla_w_out):
    silu_c = jax.nn.silu(c)
    silu_cc = jax.nn.silu(c_ctx)
    for i in range(DEPTH):
        kind, j = i % N_MIXERS, i // N_MIXERS
        last = i == DEPTH - 1
        mod_x = (silu_c @ w_ada[i] + b_ada[i])[:, None, :]
        mod_c = silu_cc @ w_ada[i] + b_ada[i]
        sh1, sc1, ga1, sh2, sc2, ga2 = jnp.split(mod_x, N_ADA, axis=-1)
        ch1, cs1, cg1, ch2, cs2, cg2 = jnp.split(mod_c, N_ADA, axis=-1)
        hx = _modulate(x, g_norm_mix[i], sh1, sc1)
        hc = _modulate(ctx, g_norm_mix[i], ch1, cs1)
        if kind == 0:
            ox, oc = fourier_mix(hx, fno_w_out[j]), fourier_mix(hc, fno_w_out[j])
        elif kind == 1:
            gp = (gmlp_w_in[j], gmlp_ln_g[j], gmlp_ln_b[j], gmlp_w_s[j], gmlp_b_s[j], gmlp_w_out[j])
            ox, oc = chunk_gmlp(hx, *gp), chunk_gmlp(hc, *gp)
        elif kind == 2:
            lam_init = 0.8 - 0.6 * math.exp(-0.3 * i)
            ox, oc = diff_attention(hx, hc, diff_w_in[j], diff_lambda[j], diff_subln_g[j],
                                    diff_w_out[j], lam_init)
        else:
            ox, oc = gla_mix(hx, hc, gla_w_in[j], gla_w_gate_up[j], gla_b_gate[j], gla_norm_g[j],
                             gla_w_out[j], not last)
        x = x + ga1 * ox
        x = x + ga2 * _sq_relu_mlp(_modulate(x, g_norm_ffn[i], sh2, sc2), w_ffn_in[i], w_ffn_out[i])
        if not last:
            ctx = ctx + cg1 * oc
            ctx = ctx + cg2 * _sq_relu_mlp(_modulate(ctx, g_norm_ffn[i], ch2, cs2), w_ffn_in[i], w_ffn_out[i])
    return _rmsnorm(x, g_final)
```

```cpp
#include <hip/hip_runtime.h>
#include <math.h>
#include <stdio.h>

constexpr int D = 2048, BATCH = 2, SEQ = 4096, CTX = 256, RB = SEQ + CTX, M = BATCH * RB, DFF = 8192;
constexpr int NMOD = 6 * D;
__device__ __forceinline__ int mrow_of(int row) { int b = row / RB; int t = row - b * RB; return t >= SEQ ? 2 : b; }

template <class Epi, bool BT>
__global__ void __launch_bounds__(256) k_gemm(const float* __restrict__ A, const float* __restrict__ B, long sA, long sB, int lda, int ldb, int N, int K, Epi epi) {
    __shared__ float As[16][132];
    __shared__ float Bs[16][132];
    const int z = blockIdx.z; A += (long)z * sA; B += (long)z * sB;
    const int tid = threadIdx.x, tx = tid & 15, ty = tid >> 4;
    const int row0 = blockIdx.y * 128, col0 = blockIdx.x * 128;
    float acc[8][8];
#pragma unroll
    for (int i = 0; i < 8; ++i)
#pragma unroll
        for (int j = 0; j < 8; ++j) acc[i][j] = 0.f;
    for (int k0 = 0; k0 < K; k0 += 16) {
#pragma unroll
        for (int i = 0; i < 2; ++i) {
            int f = tid + i * 256; int r = f >> 2, kq = (f & 3) * 4;
            float4 v = *(const float4*)(A + (long)(row0 + r) * lda + k0 + kq);
            As[kq + 0][r] = v.x; As[kq + 1][r] = v.y; As[kq + 2][r] = v.z; As[kq + 3][r] = v.w;
        }
        if (BT) {
#pragma unroll
            for (int i = 0; i < 2; ++i) {
                int f = tid + i * 256; int r = f >> 2, kq = (f & 3) * 4;
                float4 v = make_float4(0.f, 0.f, 0.f, 0.f);
                if (col0 + r < N) v = *(const float4*)(B + (long)(col0 + r) * ldb + k0 + kq);
                Bs[kq + 0][r] = v.x; Bs[kq + 1][r] = v.y; Bs[kq + 2][r] = v.z; Bs[kq + 3][r] = v.w;
            }
        } else {
#pragma unroll
            for (int i = 0; i < 2; ++i) {
                int f = tid + i * 256; int kk = f >> 5, c4 = (f & 31) * 4;
                float4 v = make_float4(0.f, 0.f, 0.f, 0.f);
                if (col0 + c4 < N) v = *(const float4*)(B + (long)(k0 + kk) * ldb + col0 + c4);
                Bs[kk][c4 + 0] = v.x; Bs[kk][c4 + 1] = v.y; Bs[kk][c4 + 2] = v.z; Bs[kk][c4 + 3] = v.w;
            }
        }
        __syncthreads();
#pragma unroll
        for (int kk = 0; kk < 16; ++kk) {
            float a[8], b[8];
#pragma unroll
            for (int i = 0; i < 8; ++i) a[i] = As[kk][ty * 8 + i];
#pragma unroll
            for (int j = 0; j < 8; ++j) b[j] = Bs[kk][tx * 8 + j];
#pragma unroll
            for (int i = 0; i < 8; ++i)
#pragma unroll
                for (int j = 0; j < 8; ++j) acc[i][j] = fmaf(a[i], b[j], acc[i][j]);
        }
        __syncthreads();
    }
#pragma unroll
    for (int i = 0; i < 8; ++i)
#pragma unroll
        for (int j = 0; j < 8; ++j) { int r = row0 + ty * 8 + i, c = col0 + tx * 8 + j; if (c < N) epi(z, r, c, acc[i][j]); }
}

struct EpiStore { float* C; long sC; int ldc; float scale;
    __device__ void operator()(int z, int r, int c, float v) const { C[(long)z * sC + (long)r * ldc + c] = v * scale; } };
struct EpiAccum { float* C; long sC; int ldc; float scale;
    __device__ void operator()(int z, int r, int c, float v) const { C[(long)z * sC + (long)r * ldc + c] += v * scale; } };
struct EpiSqRelu { float* C; int ldc; int pad;
    __device__ void operator()(int z, int r, int c, float v) const { float t = fmaxf(v, 0.f); C[(long)r * ldc + c] = t * t; } };
struct EpiGelu { float* C; int ldc; int pad;
    __device__ void operator()(int z, int r, int c, float v) const { C[(long)r * ldc + c] = 0.5f * v * (1.f + erff(v * 0.70710678118654752f)); } };
struct EpiResid { float* X; const float* gate;
    __device__ void operator()(int z, int r, int c, float v) const { X[(long)r * D + c] += gate[(long)mrow_of(r) * NMOD + c] * v; } };

template <class Epi, bool BT>
static void gemm(hipStream_t st, const float* A, int lda, long sA, const float* B, int ldb, long sB, int Mm, int N, int K, int nz, Epi epi) {
    dim3 grid((N + 127) / 128, Mm / 128, nz);
    hipLaunchKernelGGL((k_gemm<Epi, BT>), grid, dim3(256), 0, st, A, B, sA, sB, lda, ldb, N, K, epi);
}

__global__ void k_prep(const float* __restrict__ x, const float* __restrict__ ctx, float* __restrict__ XR) {
    long n4 = (long)M * D / 4;
    for (long i = blockIdx.x * 256L + threadIdx.x; i < n4; i += gridDim.x * 256L) {
        long e = i * 4; int row = (int)(e / D), col = (int)(e % D); int b = row / RB, t = row % RB;
        const float* src = t < SEQ ? x + ((long)(b * SEQ + t)) * D + col : ctx + ((long)(b * CTX + (t - SEQ))) * D + col;
        *(float4*)(XR + e) = *(const float4*)src;
    }
}
__global__ void k_silu(const float* __restrict__ c, const float* __restrict__ cc, float* __restrict__ SC) {
    int i = blockIdx.x * 256 + threadIdx.x; if (i >= 3 * D) return;
    float v = i < 2 * D ? c[i] : cc[i - 2 * D]; SC[i] = v / (1.f + expf(-v));
}
__global__ void k_ada(const float* __restrict__ SC, const float* __restrict__ w, const float* __restrict__ b, float* __restrict__ MOD) {
    int j = blockIdx.x * 256 + threadIdx.x; int l = blockIdx.y; int ks = blockIdx.z;
    const float* wl = w + (long)l * D * NMOD; float a0 = 0, a1 = 0, a2 = 0;
    for (int k = ks * 256; k < ks * 256 + 256; ++k) { float wv = wl[(long)k * NMOD + j]; a0 = fmaf(SC[k], wv, a0); a1 = fmaf(SC[D + k], wv, a1); a2 = fmaf(SC[2 * D + k], wv, a2); }
    if (ks == 0) { float bv = b[(long)l * NMOD + j]; a0 += bv; a1 += bv; a2 += bv; }
    float* o = MOD + (long)l * 3 * NMOD + j;
    atomicAdd(o, a0); atomicAdd(o + NMOD, a1); atomicAdd(o + 2 * NMOD, a2);
}
__device__ __forceinline__ float block_sum256(float v, float* red) {
#pragma unroll
    for (int o = 32; o > 0; o >>= 1) v += __shfl_xor(v, o);
    __syncthreads();
    if ((threadIdx.x & 63) == 0) red[threadIdx.x >> 6] = v;
    __syncthreads();
    return red[0] + red[1] + red[2] + red[3];
}
__global__ void __launch_bounds__(256) k_modulate(const float* __restrict__ X, const float* __restrict__ g, const float* __restrict__ shift, const float* __restrict__ scale, float* __restrict__ H) {
    __shared__ float red[4];
    int row = blockIdx.x; const float* xr = X + (long)row * D; int mr = mrow_of(row);
    float v[8]; float s = 0;
#pragma unroll
    for (int i = 0; i < 8; ++i) { v[i] = xr[threadIdx.x + i * 256]; s += v[i] * v[i]; }
    s = block_sum256(s, red);
    float r = rsqrtf(s / D + 1e-6f);
#pragma unroll
    for (int i = 0; i < 8; ++i) { int c = threadIdx.x + i * 256; H[(long)row * D + c] = v[i] * r * g[c] * (1.f + scale[(long)mr * NMOD + c]) + shift[(long)mr * NMOD + c]; }
}
__global__ void __launch_bounds__(256) k_final(const float* __restrict__ X, const float* __restrict__ g, float* __restrict__ out) {
    __shared__ float red[4];
    int orow = blockIdx.x; int b = orow / SEQ, t = orow % SEQ; const float* xr = X + (long)(b * RB + t) * D;
    float v[8]; float s = 0;
#pragma unroll
    for (int i = 0; i < 8; ++i) { v[i] = xr[threadIdx.x + i * 256]; s += v[i] * v[i]; }
    s = block_sum256(s, red);
    float r = rsqrtf(s / D + 1e-6f);
#pragma unroll
    for (int i = 0; i < 8; ++i) { int c = threadIdx.x + i * 256; out[(long)orow * D + c] = v[i] * r * g[c]; }
}
__global__ void k_dft(float* __restrict__ Cm, float* __restrict__ Sm, int n) {
    long tot = (long)n * n;
    for (long i = blockIdx.x * 256L + threadIdx.x; i < tot; i += gridDim.x * 256L) {
        int k = (int)(i / n), j = (int)(i % n); int p = (int)(((long)k * j) % n);
        float s, c; sincospif(2.f * (float)p / (float)n, &s, &c); Cm[i] = c; Sm[i] = s;
    }
}
__global__ void __launch_bounds__(256) k_ln(const float* __restrict__ Z, const float* __restrict__ g, const float* __restrict__ b, float* __restrict__ VN) {
    __shared__ float red[4];
    int row = blockIdx.x; const float* zr = Z + (long)row * 4096 + 2048;
    float v[8]; float s = 0;
#pragma unroll
    for (int i = 0; i < 8; ++i) { v[i] = zr[threadIdx.x + i * 256]; s += v[i]; }
    s = block_sum256(s, red); float mu = s / 2048.f; float q = 0;
#pragma unroll
    for (int i = 0; i < 8; ++i) { v[i] -= mu; q += v[i] * v[i]; }
    q = block_sum256(q, red); float r = rsqrtf(q / 2048.f + 1e-5f);
#pragma unroll
    for (int i = 0; i < 8; ++i) { int c = threadIdx.x + i * 256; VN[(long)row * 2048 + c] = v[i] * r * g[c] + b[c]; }
}
__global__ void __launch_bounds__(256) k_spatial(const float* __restrict__ Z, const float* __restrict__ VN, const float* __restrict__ ws, const float* __restrict__ bs, float* __restrict__ G) {
    int chunk = blockIdx.x, h = blockIdx.y; int e = threadIdx.x & 127, ph = threadIdx.x >> 7;
    float acc[64];
#pragma unroll
    for (int p = 0; p < 64; ++p) acc[p] = 0.f;
    const float* wsh = ws + (long)h * 128 * 128;
    for (int q = 0; q < 128; ++q) {
        float vn = VN[(long)(chunk * 128 + q) * 2048 + h * 128 + e];
#pragma unroll
        for (int p = 0; p < 64; ++p) acc[p] = fmaf(wsh[(ph * 64 + p) * 128 + q], vn, acc[p]);
    }
#pragma unroll
    for (int p = 0; p < 64; ++p) { int pr = ph * 64 + p; long row = (long)chunk * 128 + pr;
        G[row * 2048 + h * 128 + e] = Z[row * 4096 + h * 128 + e] * (acc[p] + bs[h * 128 + pr]); }
}
__global__ void __launch_bounds__(256) k_rope(float* __restrict__ QKV) {
    int lrow = blockIdx.x; int b = lrow / SEQ, t = lrow % SEQ; float* base = QKV + (long)(b * RB + t) * 6144;
    float prow = (float)(t / 64), pcol = (float)(t % 64);
    for (int i = threadIdx.x; i < 2 * 16 * 64; i += 256) {
        int j = i & 63, hc = (i >> 6) & 15, qk = i >> 10;
        int f = j & 31; float inv = powf(10000.f, -(float)f / 32.f);
        float ang = (j < 32 ? prow : pcol) * inv; float sn, cs; sincosf(ang, &sn, &cs);
        float* p = base + qk * 2048 + hc * 128; float x1 = p[j], x2 = p[j + 64];
        p[j] = x1 * cs - x2 * sn; p[j + 64] = x1 * sn + x2 * cs;
    }
}
__global__ void __launch_bounds__(256) k_subln(float* __restrict__ O, const float* __restrict__ g, float mul) {
    __shared__ float red[4];
    long row = blockIdx.x; int h = blockIdx.y; float* p = O + row * 2048 + h * 256;
    float v = p[threadIdx.x]; float s = block_sum256(v * v, red);
    p[threadIdx.x] = v * rsqrtf(s / 256.f + 1e-6f) * g[threadIdx.x] * mul;
}
__global__ void __launch_bounds__(256) k_gates(const float* __restrict__ P, const float* __restrict__ wup, const float* __restrict__ bg, float* __restrict__ GG) {
    int row = blockIdx.x, dir = blockIdx.y; const float* gd = P + (long)row * 6176 + 6144 + 16 * dir;
    float g[16];
#pragma unroll
    for (int r = 0; r < 16; ++r) g[r] = gd[r];
    for (int c = threadIdx.x; c < 1024; c += 256) {
        float z = bg[dir * 1024 + c];
#pragma unroll
        for (int r = 0; r < 16; ++r) z = fmaf(g[r], wup[(long)(dir * 16 + r) * 1024 + c], z);
        float ls = fminf(z, 0.f) - log1pf(expf(-fabsf(z)));
        GG[((long)dir * M + row) * 1024 + c] = ls * (1.f / 16.f);
    }
}
__global__ void __launch_bounds__(256) k_gla_scan(const float* __restrict__ P, const float* __restrict__ GG, float* __restrict__ OD) {
    constexpr int TB = 8;
    __shared__ float sq[TB][256], sk[TB][256], sa[TB][256], sv[TB][32], part[TB][8][33];
    int slice = blockIdx.x, combo = blockIdx.y; int b = combo >> 3, h = (combo >> 1) & 3, dir = combo & 1;
    int j = threadIdx.x & 31, dg = threadIdx.x >> 5;
    float S[32];
#pragma unroll
    for (int i = 0; i < 32; ++i) S[i] = 0.f;
    const float* G = GG + (long)dir * M * 1024;
    float* O = OD + (long)dir * M * 2048;
    for (int step = 0; step < RB / TB; ++step) {
        bool isctx = step < CTX / TB; int s2 = isctx ? step : step - CTX / TB; int len = isctx ? CTX : SEQ; int tbase = isctx ? SEQ : 0;
        __syncthreads();
        for (int i = threadIdx.x; i < TB * 256; i += 256) {
            int u = i >> 8, d = i & 255; int tt = s2 * TB + u; if (dir) tt = len - 1 - tt; long row = (long)b * RB + tbase + tt;
            sq[u][d] = P[row * 6176 + h * 256 + d] * 0.0625f;
            sk[u][d] = P[row * 6176 + 1024 + h * 256 + d];
            sa[u][d] = expf(G[row * 1024 + h * 256 + d]);
        }
        for (int i = threadIdx.x; i < TB * 32; i += 256) {
            int u = i >> 5, jj = i & 31; int tt = s2 * TB + u; if (dir) tt = len - 1 - tt; long row = (long)b * RB + tbase + tt;
            sv[u][jj] = P[row * 6176 + 2048 + h * 512 + slice * 32 + jj];
        }
        __syncthreads();
        for (int u = 0; u < TB; ++u) {
            float vj = sv[u][j]; float po = 0.f;
#pragma unroll
            for (int i = 0; i < 32; ++i) { int d = dg * 32 + i; S[i] = fmaf(sa[u][d], S[i], sk[u][d] * vj); po = fmaf(sq[u][d], S[i], po); }
            part[u][dg][j] = po;
        }
        __syncthreads();
        if (!isctx) {
            for (int i = threadIdx.x; i < TB * 32; i += 256) {
                int u = i >> 5, jj = i & 31; float o = 0.f;
#pragma unroll
                for (int g8 = 0; g8 < 8; ++g8) o += part[u][g8][jj];
                int tt = s2 * TB + u; if (dir) tt = len - 1 - tt; long row = (long)b * RB + tt;
                O[row * 2048 + h * 512 + slice * 32 + jj] = o;
            }
        }
    }
}
__global__ void __launch_bounds__(256) k_gla_finish(const float* __restrict__ OD, const float* __restrict__ P, const float* __restrict__ g, float* __restrict__ OA) {
    __shared__ float red[4];
    long row = blockIdx.x; int h = blockIdx.y;
    const float* of = OD + row * 2048 + h * 512; const float* ob = OD + (long)M * 2048 + row * 2048 + h * 512;
    float v0 = of[threadIdx.x] + ob[threadIdx.x], v1 = of[threadIdx.x + 256] + ob[threadIdx.x + 256];
    float s = block_sum256(v0 * v0 + v1 * v1, red); float r = rsqrtf(s / 512.f + 1e-6f);
    const float* rr = P + row * 6176 + 4096 + h * 512;
    float r0 = rr[threadIdx.x], r1 = rr[threadIdx.x + 256];
    OA[row * 2048 + h * 512 + threadIdx.x] = v0 * r * g[threadIdx.x] * (r0 / (1.f + expf(-r0)));
    OA[row * 2048 + h * 512 + threadIdx.x + 256] = v1 * r * g[threadIdx.x + 256] * (r1 / (1.f + expf(-r1)));
}

__global__ void __launch_bounds__(256) k_softmax2_dev(float* __restrict__ S0, float* __restrict__ S1, int nk, const float* __restrict__ lamv, float lam_init) {
    __shared__ float red[4]; __shared__ float redm[4];
    float d0 = 0.f, d1 = 0.f;
    for (int i = 0; i < 128; ++i) { d0 += lamv[i] * lamv[128 + i]; d1 += lamv[256 + i] * lamv[384 + i]; }
    const float lam = expf(d0) - expf(d1) + lam_init;
    long row = blockIdx.x; float* a = S0 + row * nk; float* b = S1 + row * nk;
    float m0 = -1e30f, m1 = -1e30f;
    for (int i = threadIdx.x; i < nk; i += 256) { m0 = fmaxf(m0, a[i]); m1 = fmaxf(m1, b[i]); }
#pragma unroll
    for (int o = 32; o > 0; o >>= 1) { m0 = fmaxf(m0, __shfl_xor(m0, o)); m1 = fmaxf(m1, __shfl_xor(m1, o)); }
    if ((threadIdx.x & 63) == 0) { red[threadIdx.x >> 6] = m0; redm[threadIdx.x >> 6] = m1; }
    __syncthreads();
    m0 = fmaxf(fmaxf(red[0], red[1]), fmaxf(red[2], red[3])); m1 = fmaxf(fmaxf(redm[0], redm[1]), fmaxf(redm[2], redm[3]));
    float s0 = 0, s1 = 0;
    for (int i = threadIdx.x; i < nk; i += 256) { s0 += expf(a[i] - m0); s1 += expf(b[i] - m1); }
    s0 = block_sum256(s0, red); s1 = block_sum256(s1, red);
    float i0 = 1.f / s0, i1 = lam / s1;
    for (int i = threadIdx.x; i < nk; i += 256) a[i] = expf(a[i] - m0) * i0 - expf(b[i] - m1) * i1;
}
static void launch_softmax(hipStream_t st, float* S0, float* S1, int nq, int nk, const float* lamv, float lam_init) {
    hipLaunchKernelGGL(k_softmax2_dev, dim3(nq), dim3(256), 0, st, S0, S1, nk, lamv, lam_init);
}
extern "C" void kernel_launch(void* const* d_in, const int* in_sizes, int n_in, void* d_out, int out_size, void* d_ws, size_t ws_size, hipStream_t st) {
    const float* x = (const float*)d_in[0]; const float* c = (const float*)d_in[1]; const float* ctx = (const float*)d_in[2]; const float* cc = (const float*)d_in[3];
    const float* w_ada = (const float*)d_in[4]; const float* b_ada = (const float*)d_in[5]; const float* g_mix = (const float*)d_in[6]; const float* g_ffn = (const float*)d_in[7];
    const float* w_in = (const float*)d_in[8]; const float* w_out = (const float*)d_in[9]; const float* g_final = (const float*)d_in[10];
    const float* fno_w = (const float*)d_in[11];
    const float* gm_win = (const float*)d_in[12]; const float* gm_lng = (const float*)d_in[13]; const float* gm_lnb = (const float*)d_in[14]; const float* gm_ws = (const float*)d_in[15]; const float* gm_bs = (const float*)d_in[16]; const float* gm_wout = (const float*)d_in[17];
    const float* df_win = (const float*)d_in[18]; const float* df_lam = (const float*)d_in[19]; const float* df_g = (const float*)d_in[20]; const float* df_wout = (const float*)d_in[21];
    const float* gl_win = (const float*)d_in[22]; const float* gl_wup = (const float*)d_in[23]; const float* gl_bg = (const float*)d_in[24]; const float* gl_g = (const float*)d_in[25]; const float* gl_wout = (const float*)d_in[26];
    float* out = (float*)d_out;
    float* w = (float*)d_ws; size_t off = 0;
    auto take = [&](size_t n) { float* p = w + off; off += (n + 63) / 64 * 64; return p; };
    float* XR = take((size_t)M * D); float* H = take((size_t)M * D); float* T1 = take((size_t)M * 8192); float* T2 = take((size_t)M * D); float* T3 = take((size_t)M * D);
    float* T4 = take((size_t)2 * M * D);
    float* SB = take((size_t)2 * SEQ * RB); float* MOD = take((size_t)4 * 3 * NMOD); float* SC = take(3 * D);
    float* Cn = take((size_t)SEQ * SEQ); float* Sn = take((size_t)SEQ * SEQ); float* Cc = take(512 * 512); float* Sc = take(512 * 512); float* C2 = take(256 * 256); float* S2 = take(256 * 256);
    float* LAMH = take(64);
    if (off * 4 > ws_size) { fprintf(stderr, "ws too small: need %zu have %zu\n", off * 4, ws_size); return; }

    hipLaunchKernelGGL(k_prep, dim3(2048), dim3(256), 0, st, x, ctx, XR);
    hipLaunchKernelGGL(k_silu, dim3(3 * D / 256), dim3(256), 0, st, c, cc, SC);
    (void)hipMemsetAsync(MOD, 0, (size_t)4 * 3 * NMOD * 4, st);
    hipLaunchKernelGGL(k_ada, dim3(NMOD / 256, 4, 8), dim3(256), 0, st, SC, w_ada, b_ada, MOD);
    hipLaunchKernelGGL(k_dft, dim3(4096), dim3(256), 0, st, Cn, Sn, SEQ);
    hipLaunchKernelGGL(k_dft, dim3(256), dim3(256), 0, st, Cc, Sc, 512);
    hipLaunchKernelGGL(k_dft, dim3(256), dim3(256), 0, st, C2, S2, 256);
    const long BS = (long)RB * D;

    for (int l = 0; l < 4; ++l) {
        const float* mod = MOD + (size_t)l * 3 * NMOD;
        hipLaunchKernelGGL(k_modulate, dim3(M), dim3(256), 0, st, XR, g_mix + l * D, mod + 0 * D, mod + 1 * D, H);
        if (l == 0) {
            float* YC = T2; float* YS = T3; float* FB = T4;
            gemm<EpiStore, false>(st, H, D, 512, Cc, 512, 0, M, 512, 512, 4, EpiStore{YC, 512, D, 1.f});
            gemm<EpiStore, false>(st, H, D, 512, Sc, 512, 0, M, 512, 512, 4, EpiStore{YS, 512, D, 1.f});
            const float sl = 1.f / sqrtf(4096.f * 512.f), sc = 1.f / sqrtf(256.f * 512.f);
            gemm<EpiStore, false>(st, Cn, SEQ, 0, YC, D, BS, SEQ, D, SEQ, 2, EpiStore{FB, BS, D, sl});
            gemm<EpiAccum, false>(st, Sn, SEQ, 0, YS, D, BS, SEQ, D, SEQ, 2, EpiAccum{FB, BS, D, -sl});
            gemm<EpiStore, false>(st, C2, CTX, 0, YC + (long)SEQ * D, D, BS, CTX, D, CTX, 2, EpiStore{FB + (long)SEQ * D, BS, D, sc});
            gemm<EpiAccum, false>(st, S2, CTX, 0, YS + (long)SEQ * D, D, BS, CTX, D, CTX, 2, EpiAccum{FB + (long)SEQ * D, BS, D, -sc});
            gemm<EpiResid, false>(st, FB, D, 0, fno_w, D, 0, M, D, D, 1, EpiResid{XR, mod + 2 * D});
        } else if (l == 1) {
            float* Z = T1; float* VN = T2; float* G = T3;
            gemm<EpiGelu, false>(st, H, D, 0, gm_win, 4096, 0, M, 4096, D, 1, EpiGelu{Z, 4096, 0});
            hipLaunchKernelGGL(k_ln, dim3(M), dim3(256), 0, st, Z, gm_lng, gm_lnb, VN);
            hipLaunchKernelGGL(k_spatial, dim3(M / 128, 16), dim3(256), 0, st, Z, VN, gm_ws, gm_bs, G);
            gemm<EpiResid, false>(st, G, D, 0, gm_wout, D, 0, M, D, D, 1, EpiResid{XR, mod + 2 * D});
        } else if (l == 2) {
            float* QKV = T1; float* OA = T2;
            gemm<EpiStore, false>(st, H, D, 0, df_win, 6144, 0, M, 6144, D, 1, EpiStore{QKV, 0, 6144, 1.f});
            hipLaunchKernelGGL(k_rope, dim3(BATCH * SEQ), dim3(256), 0, st, QKV);
            const float lam_init = (float)(0.8 - 0.6 * exp(-0.3 * 2.0));
            (void)LAMH;
            const float scale = 1.f / sqrtf(128.f);
            for (int b = 0; b < BATCH; ++b) for (int h = 0; h < 8; ++h) {
                const float* qb = QKV + (long)b * RB * 6144 + h * 256; const float* kb = qb + 2048; const float* vb = qb + 4096;
                gemm<EpiStore, true>(st, qb, 6144, 128, kb, 6144, 128, SEQ, RB, 128, 2, EpiStore{SB, (long)SEQ * RB, RB, scale});
                launch_softmax(st, SB, SB + (long)SEQ * RB, SEQ, RB, df_lam, lam_init);
                gemm<EpiStore, false>(st, SB, RB, 0, vb, 6144, 0, SEQ, 256, RB, 1, EpiStore{OA + (long)b * RB * D + h * 256, 0, D, 1.f});
                const float* qc = qb + (long)SEQ * 6144; const float* kc = kb + (long)SEQ * 6144; const float* vc = vb + (long)SEQ * 6144;
                gemm<EpiStore, true>(st, qc, 6144, 128, kc, 6144, 128, CTX, CTX, 128, 2, EpiStore{SB, (long)CTX * CTX, CTX, scale});
                launch_softmax(st, SB, SB + (long)CTX * CTX, CTX, CTX, df_lam, lam_init);
                gemm<EpiStore, false>(st, SB, CTX, 0, vc, 6144, 0, CTX, 256, CTX, 1, EpiStore{OA + ((long)b * RB + SEQ) * D + h * 256, 0, D, 1.f});
            }
            hipLaunchKernelGGL(k_subln, dim3(M, 8), dim3(256), 0, st, OA, df_g, 1.f - lam_init);
            gemm<EpiResid, false>(st, OA, D, 0, df_wout, D, 0, M, D, D, 1, EpiResid{XR, mod + 2 * D});
        } else {
            float* P = T1; float* GG = T4; float* OD = SB; float* OA = T2;
            gemm<EpiStore, false>(st, H, D, 0, gl_win, 6176, 0, M, 6176, D, 1, EpiStore{P, 0, 6176, 1.f});
            hipLaunchKernelGGL(k_gates, dim3(M, 2), dim3(256), 0, st, P, gl_wup, gl_bg, GG);
            hipLaunchKernelGGL(k_gla_scan, dim3(16, 16), dim3(256), 0, st, P, GG, OD);
            (void)hipMemsetAsync(OA, 0, (size_t)M * D * 4, st);
            for (int b = 0; b < BATCH; ++b)
                hipLaunchKernelGGL(k_gla_finish, dim3(SEQ, 4), dim3(256), 0, st, OD + (long)b * RB * D, P + (long)b * RB * 6176, gl_g, OA + (long)b * RB * D);
            gemm<EpiResid, false>(st, OA, D, 0, gl_wout, D, 0, M, D, D, 1, EpiResid{XR, mod + 2 * D});
        }
        hipLaunchKernelGGL(k_modulate, dim3(M), dim3(256), 0, st, XR, g_ffn + l * D, mod + 3 * D, mod + 4 * D, H);
        gemm<EpiSqRelu, false>(st, H, D, 0, w_in + (size_t)l * D * DFF, DFF, 0, M, DFF, D, 1, EpiSqRelu{T1, DFF, 0});
        gemm<EpiResid, false>(st, T1, DFF, 0, w_out + (size_t)l * DFF * D, D, 0, M, D, DFF, 1, EpiResid{XR, mod + 5 * D});
    }
    hipLaunchKernelGGL(k_final, dim3(BATCH * SEQ), dim3(256), 0, st, XR, g_final, out);
}
```

```cpp
#include <hip/hip_runtime.h>
#include <math.h>
#include <stdio.h>

constexpr int D = 2048, BATCH = 2, SEQ = 4096, CTX = 256, RB = SEQ + CTX, M = BATCH * RB, DFF = 8192;
constexpr int NMOD = 6 * D;
__device__ __forceinline__ int mrow_of(int row) { int b = row / RB; int t = row - b * RB; return t >= SEQ ? 2 : b; }

template <class Epi, bool BT>
__global__ void __launch_bounds__(256) k_gemm(const float* __restrict__ A, const float* __restrict__ B, long sA, long sB, int lda, int ldb, int N, int K, Epi epi) {
    __shared__ float As[16][132];
    __shared__ float Bs[16][132];
    const int z = blockIdx.z; A += (long)z * sA; B += (long)z * sB;
    const int tid = threadIdx.x, tx = tid & 15, ty = tid >> 4;
    const int row0 = blockIdx.y * 128, col0 = blockIdx.x * 128;
    float acc[8][8];
#pragma unroll
    for (int i = 0; i < 8; ++i)
#pragma unroll
        for (int j = 0; j < 8; ++j) acc[i][j] = 0.f;
    for (int k0 = 0; k0 < K; k0 += 16) {
#pragma unroll
        for (int i = 0; i < 2; ++i) {
            int f = tid + i * 256; int r = f >> 2, kq = (f & 3) * 4;
            float4 v = *(const float4*)(A + (long)(row0 + r) * lda + k0 + kq);
            As[kq + 0][r] = v.x; As[kq + 1][r] = v.y; As[kq + 2][r] = v.z; As[kq + 3][r] = v.w;
        }
        if (BT) {
#pragma unroll
            for (int i = 0; i < 2; ++i) {
                int f = tid + i * 256; int r = f >> 2, kq = (f & 3) * 4;
                float4 v = make_float4(0.f, 0.f, 0.f, 0.f);
                if (col0 + r < N) v = *(const float4*)(B + (long)(col0 + r) * ldb + k0 + kq);
                Bs[kq + 0][r] = v.x; Bs[kq + 1][r] = v.y; Bs[kq + 2][r] = v.z; Bs[kq + 3][r] = v.w;
            }
        } else {
#pragma unroll
            for (int i = 0; i < 2; ++i) {
                int f = tid + i * 256; int kk = f >> 5, c4 = (f & 31) * 4;
                float4 v = make_float4(0.f, 0.f, 0.f, 0.f);
                if (col0 + c4 < N) v = *(const float4*)(B + (long)(k0 + kk) * ldb + col0 + c4);
                Bs[kk][c4 + 0] = v.x; Bs[kk][c4 + 1] = v.y; Bs[kk][c4 + 2] = v.z; Bs[kk][c4 + 3] = v.w;
            }
        }
        __syncthreads();
#pragma unroll
        for (int kk = 0; kk < 16; ++kk) {
            float a[8], b[8];
#pragma unroll
            for (int i = 0; i < 8; ++i) a[i] = As[kk][ty * 8 + i];
#pragma unroll
            for (int j = 0; j < 8; ++j) b[j] = Bs[kk][tx * 8 + j];
#pragma unroll
            for (int i = 0; i < 8; ++i)
#pragma unroll
                for (int j = 0; j < 8; ++j) acc[i][j] = fmaf(a[i], b[j], acc[i][j]);
        }
        __syncthreads();
    }
#pragma unroll
    for (int i = 0; i < 8; ++i)
#pragma unroll
        for (int j = 0; j < 8; ++j) { int r = row0 + ty * 8 + i, c = col0 + tx * 8 + j; if (c < N) epi(z, r, c, acc[i][j]); }
}

struct EpiStore { float* C; long sC; int ldc; float scale;
    __device__ void operator()(int z, int r, int c, float v) const { C[(long)z * sC + (long)r * ldc + c] = v * scale; } };
struct EpiAccum { float* C; long sC; int ldc; float scale;
    __device__ void operator()(int z, int r, int c, float v) const { C[(long)z * sC + (long)r * ldc + c] += v * scale; } };
struct EpiSqRelu { float* C; int ldc; int pad;
    __device__ void operator()(int z, int r, int c, float v) const { float t = fmaxf(v, 0.f); C[(long)r * ldc + c] = t * t; } };
struct EpiGelu { float* C; int ldc; int pad;
    __device__ void operator()(int z, int r, int c, float v) const { C[(long)r * ldc + c] = 0.5f * v * (1.f + erff(v * 0.70710678118654752f)); } };
struct EpiResid { float* X; const float* gate;
    __device__ void operator()(int z, int r, int c, float v) const { X[(long)r * D + c] += gate[(long)mrow_of(r) * NMOD + c] * v; } };

template <class Epi, bool BT>
static void gemm(hipStream_t st, const float* A, int lda, long sA, const float* B, int ldb, long sB, int Mm, int N, int K, int nz, Epi epi) {
    dim3 grid((N + 127) / 128, Mm / 128, nz);
    hipLaunchKernelGGL((k_gemm<Epi, BT>), grid, dim3(256), 0, st, A, B, sA, sB, lda, ldb, N, K, epi);
}

__global__ void k_prep(const float* __restrict__ x, const float* __restrict__ ctx, float* __restrict__ XR) {
    long n4 = (long)M * D / 4;
    for (long i = blockIdx.x * 256L + threadIdx.x; i < n4; i += gridDim.x * 256L) {
        long e = i * 4; int row = (int)(e / D), col = (int)(e % D); int b = row / RB, t = row % RB;
        const float* src = t < SEQ ? x + ((long)(b * SEQ + t)) * D + col : ctx + ((long)(b * CTX + (t - SEQ))) * D + col;
        *(float4*)(XR + e) = *(const float4*)src;
    }
}
__global__ void k_silu(const float* __restrict__ c, const float* __restrict__ cc, float* __restrict__ SC) {
    int i = blockIdx.x * 256 + threadIdx.x; if (i >= 3 * D) return;
    float v = i < 2 * D ? c[i] : cc[i - 2 * D]; SC[i] = v / (1.f + expf(-v));
}
__global__ void k_ada(const float* __restrict__ SC, const float* __restrict__ w, const float* __restrict__ b, float* __restrict__ MOD) {
    int j = blockIdx.x * 256 + threadIdx.x; int l = blockIdx.y; int ks = blockIdx.z;
    const float* wl = w + (long)l * D * NMOD; float a0 = 0, a1 = 0, a2 = 0;
    for (int k = ks * 256; k < ks * 256 + 256; ++k) { float wv = wl[(long)k * NMOD + j]; a0 = fmaf(SC[k], wv, a0); a1 = fmaf(SC[D + k], wv, a1); a2 = fmaf(SC[2 * D + k], wv, a2); }
    if (ks == 0) { float bv = b[(long)l * NMOD + j]; a0 += bv; a1 += bv; a2 += bv; }
    float* o = MOD + (long)l * 3 * NMOD + j;
    atomicAdd(o, a0); atomicAdd(o + NMOD, a1); atomicAdd(o + 2 * NMOD, a2);
}
__device__ __forceinline__ float block_sum256(float v, float* red) {
#pragma unroll
    for (int o = 32; o > 0; o >>= 1) v += __shfl_xor(v, o);
    __syncthreads();
    if ((threadIdx.x & 63) == 0) red[threadIdx.x >> 6] = v;
    __syncthreads();
    return red[0] + red[1] + red[2] + red[3];
}
__global__ void __launch_bounds__(256) k_modulate(const float* __restrict__ X, const float* __restrict__ g, const float* __restrict__ shift, const float* __restrict__ scale, float* __restrict__ H) {
    __shared__ float red[4];
    int row = blockIdx.x; const float* xr = X + (long)row * D; int mr = mrow_of(row);
    float v[8]; float s = 0;
#pragma unroll
    for (int i = 0; i < 8; ++i) { v[i] = xr[threadIdx.x + i * 256]; s += v[i] * v[i]; }
    s = block_sum256(s, red);
    float r = rsqrtf(s / D + 1e-6f);
#pragma unroll
    for (int i = 0; i < 8; ++i) { int c = threadIdx.x + i * 256; H[(long)row * D + c] = v[i] * r * g[c] * (1.f + scale[(long)mr * NMOD + c]) + shift[(long)mr * NMOD + c]; }
}
__global__ void __launch_bounds__(256) k_final(const float* __restrict__ X, const float* __restrict__ g, float* __restrict__ out) {
    __shared__ float red[4];
    int orow = blockIdx.x; int b = orow / SEQ, t = orow % SEQ; const float* xr = X + (long)(b * RB + t) * D;
    float v[8]; float s = 0;
#pragma unroll
    for (int i = 0; i < 8; ++i) { v[i] = xr[threadIdx.x + i * 256]; s += v[i] * v[i]; }
    s = block_sum256(s, red);
    float r = rsqrtf(s / D + 1e-6f);
#pragma unroll
    for (int i = 0; i < 8; ++i) { int c = threadIdx.x + i * 256; out[(long)orow * D + c] = v[i] * r * g[c]; }
}
__global__ void k_dft(float* __restrict__ Cm, float* __restrict__ Sm, int n) {
    long tot = (long)n * n;
    for (long i = blockIdx.x * 256L + threadIdx.x; i < tot; i += gridDim.x * 256L) {
        int k = (int)(i / n), j = (int)(i % n); int p = (int)(((long)k * j) % n);
        float s, c; sincospif(2.f * (float)p / (float)n, &s, &c); Cm[i] = c; Sm[i] = s;
    }
}
__global__ void __launch_bounds__(256) k_ln(const float* __restrict__ Z, const float* __restrict__ g, const float* __restrict__ b, float* __restrict__ VN) {
    __shared__ float red[4];
    int row = blockIdx.x; const float* zr = Z + (long)row * 4096 + 2048;
    float v[8]; float s = 0;
#pragma unroll
    for (int i = 0; i < 8; ++i) { v[i] = zr[threadIdx.x + i * 256]; s += v[i]; }
    s = block_sum256(s, red); float mu = s / 2048.f; float q = 0;
#pragma unroll
    for (int i = 0; i < 8; ++i) { v[i] -= mu; q += v[i] * v[i]; }
    q = block_sum256(q, red); float r = rsqrtf(q / 2048.f + 1e-5f);
#pragma unroll
    for (int i = 0; i < 8; ++i) { int c = threadIdx.x + i * 256; VN[(long)row * 2048 + c] = v[i] * r * g[c] + b[c]; }
}
__global__ void __launch_bounds__(256) k_spatial(const float* __restrict__ Z, const float* __restrict__ VN, const float* __restrict__ ws, const float* __restrict__ bs, float* __restrict__ G) {
    int chunk = blockIdx.x, h = blockIdx.y; int e = threadIdx.x & 127, ph = threadIdx.x >> 7;
    float acc[64];
#pragma unroll
    for (int p = 0; p < 64; ++p) acc[p] = 0.f;
    const float* wsh = ws + (long)h * 128 * 128;
    for (int q = 0; q < 128; ++q) {
        float vn = VN[(long)(chunk * 128 + q) * 2048 + h * 128 + e];
#pragma unroll
        for (int p = 0; p < 64; ++p) acc[p] = fmaf(wsh[(ph * 64 + p) * 128 + q], vn, acc[p]);
    }
#pragma unroll
    for (int p = 0; p < 64; ++p) { int pr = ph * 64 + p; long row = (long)chunk * 128 + pr;
        G[row * 2048 + h * 128 + e] = Z[row * 4096 + h * 128 + e] * (acc[p] + bs[h * 128 + pr]); }
}
__global__ void __launch_bounds__(256) k_rope(float* __restrict__ QKV) {
    int lrow = blockIdx.x; int b = lrow / SEQ, t = lrow % SEQ; float* base = QKV + (long)(b * RB + t) * 6144;
    float prow = (float)(t / 64), pcol = (float)(t % 64);
    for (int i = threadIdx.x; i < 2 * 16 * 64; i += 256) {
        int j = i & 63, hc = (i >> 6) & 15, qk = i >> 10;
        int f = j & 31; float inv = powf(10000.f, -(float)f / 32.f);
        float ang = (j < 32 ? prow : pcol) * inv; float sn, cs; sincosf(ang, &sn, &cs);
        float* p = base + qk * 2048 + hc * 128; float x1 = p[j], x2 = p[j + 64];
        p[j] = x1 * cs - x2 * sn; p[j + 64] = x1 * sn + x2 * cs;
    }
}
__global__ void __launch_bounds__(256) k_subln(float* __restrict__ O, const float* __restrict__ g, float mul) {
    __shared__ float red[4];
    long row = blockIdx.x; int h = blockIdx.y; float* p = O + row * 2048 + h * 256;
    float v = p[threadIdx.x]; float s = block_sum256(v * v, red);
    p[threadIdx.x] = v * rsqrtf(s / 256.f + 1e-6f) * g[threadIdx.x] * mul;
}
__global__ void __launch_bounds__(256) k_gates(const float* __restrict__ P, const float* __restrict__ wup, const float* __restrict__ bg, float* __restrict__ GG) {
    int row = blockIdx.x, dir = blockIdx.y; const float* gd = P + (long)row * 6176 + 6144 + 16 * dir;
    float g[16];
#pragma unroll
    for (int r = 0; r < 16; ++r) g[r] = gd[r];
    for (int c = threadIdx.x; c < 1024; c += 256) {
        float z = bg[dir * 1024 + c];
#pragma unroll
        for (int r = 0; r < 16; ++r) z = fmaf(g[r], wup[(long)(dir * 16 + r) * 1024 + c], z);
        float ls = fminf(z, 0.f) - log1pf(expf(-fabsf(z)));
        GG[((long)dir * M + row) * 1024 + c] = ls * (1.f / 16.f);
    }
}
__global__ void __launch_bounds__(256) k_gla_scan(const float* __restrict__ P, const float* __restrict__ GG, float* __restrict__ OD) {
    constexpr int TB = 8;
    __shared__ float sq[TB][256], sk[TB][256], sa[TB][256], sv[TB][32], part[TB][8][33];
    int slice = blockIdx.x, combo = blockIdx.y; int b = combo >> 3, h = (combo >> 1) & 3, dir = combo & 1;
    int j = threadIdx.x & 31, dg = threadIdx.x >> 5;
    float S[32];
#pragma unroll
    for (int i = 0; i < 32; ++i) S[i] = 0.f;
    const float* G = GG + (long)dir * M * 1024;
    float* O = OD + (long)dir * M * 2048;
    for (int step = 0; step < RB / TB; ++step) {
        bool isctx = step < CTX / TB; int s2 = isctx ? step : step - CTX / TB; int len = isctx ? CTX : SEQ; int tbase = isctx ? SEQ : 0;
        __syncthreads();
        for (int i = threadIdx.x; i < TB * 256; i += 256) {
            int u = i >> 8, d = i & 255; int tt = s2 * TB + u; if (dir) tt = len - 1 - tt; long row = (long)b * RB + tbase + tt;
            sq[u][d] = P[row * 6176 + h * 256 + d] * 0.0625f;
            sk[u][d] = P[row * 6176 + 1024 + h * 256 + d];
            sa[u][d] = expf(G[row * 1024 + h * 256 + d]);
        }
        for (int i = threadIdx.x; i < TB * 32; i += 256) {
            int u = i >> 5, jj = i & 31; int tt = s2 * TB + u; if (dir) tt = len - 1 - tt; long row = (long)b * RB + tbase + tt;
            sv[u][jj] = P[row * 6176 + 2048 + h * 512 + slice * 32 + jj];
        }
        __syncthreads();
        for (int u = 0; u < TB; ++u) {
            float vj = sv[u][j]; float po = 0.f;
#pragma unroll
            for (int i = 0; i < 32; ++i) { int d = dg * 32 + i; S[i] = fmaf(sa[u][d], S[i], sk[u][d] * vj); po = fmaf(sq[u][d], S[i], po); }
            part[u][dg][j] = po;
        }
        __syncthreads();
        if (!isctx) {
            for (int i = threadIdx.x; i < TB * 32; i += 256) {
                int u = i >> 5, jj = i & 31; float o = 0.f;
#pragma unroll
                for (int g8 = 0; g8 < 8; ++g8) o += part[u][g8][jj];
                int tt = s2 * TB + u; if (dir) tt = len - 1 - tt; long row = (long)b * RB + tt;
                O[row * 2048 + h * 512 + slice * 32 + jj] = o;
            }
        }
    }
}
__global__ void __launch_bounds__(256) k_gla_finish(const float* __restrict__ OD, const float* __restrict__ P, const float* __restrict__ g, float* __restrict__ OA) {
    __shared__ float red[4];
    long row = blockIdx.x; int h = blockIdx.y;
    const float* of = OD + row * 2048 + h * 512; const float* ob = OD + (long)M * 2048 + row * 2048 + h * 512;
    float v0 = of[threadIdx.x] + ob[threadIdx.x], v1 = of[threadIdx.x + 256] + ob[threadIdx.x + 256];
    float s = block_sum256(v0 * v0 + v1 * v1, red); float r = rsqrtf(s / 512.f + 1e-6f);
    const float* rr = P + row * 6176 + 4096 + h * 512;
    float r0 = rr[threadIdx.x], r1 = rr[threadIdx.x + 256];
    OA[row * 2048 + h * 512 + threadIdx.x] = v0 * r * g[threadIdx.x] * (r0 / (1.f + expf(-r0)));
    OA[row * 2048 + h * 512 + threadIdx.x + 256] = v1 * r * g[threadIdx.x + 256] * (r1 / (1.f + expf(-r1)));
}

__global__ void __launch_bounds__(256) k_softmax2_dev(float* __restrict__ S0, float* __restrict__ S1, int nk, const float* __restrict__ lamv, float lam_init) {
    __shared__ float red[4]; __shared__ float redm[4];
    float d0 = 0.f, d1 = 0.f;
    for (int i = 0; i < 128; ++i) { d0 += lamv[i] * lamv[128 + i]; d1 += lamv[256 + i] * lamv[384 + i]; }
    const float lam = expf(d0) - expf(d1) + lam_init;
    long row = blockIdx.x; float* a = S0 + row * nk; float* b = S1 + row * nk;
    float m0 = -1e30f, m1 = -1e30f;
    for (int i = threadIdx.x; i < nk; i += 256) { m0 = fmaxf(m0, a[i]); m1 = fmaxf(m1, b[i]); }
#pragma unroll
    for (int o = 32; o > 0; o >>= 1) { m0 = fmaxf(m0, __shfl_xor(m0, o)); m1 = fmaxf(m1, __shfl_xor(m1, o)); }
    if ((threadIdx.x & 63) == 0) { red[threadIdx.x >> 6] = m0; redm[threadIdx.x >> 6] = m1; }
    __syncthreads();
    m0 = fmaxf(fmaxf(red[0], red[1]), fmaxf(red[2], red[3])); m1 = fmaxf(fmaxf(redm[0], redm[1]), fmaxf(redm[2], redm[3]));
    float s0 = 0, s1 = 0;
    for (int i = threadIdx.x; i < nk; i += 256) { s0 += expf(a[i] - m0); s1 += expf(b[i] - m1); }
    s0 = block_sum256(s0, red); s1 = block_sum256(s1, red);
    float i0 = 1.f / s0, i1 = lam / s1;
    for (int i = threadIdx.x; i < nk; i += 256) a[i] = expf(a[i] - m0) * i0 - expf(b[i] - m1) * i1;
}
static void launch_softmax(hipStream_t st, float* S0, float* S1, int nq, int nk, const float* lamv, float lam_init) {
    hipLaunchKernelGGL(k_softmax2_dev, dim3(nq), dim3(256), 0, st, S0, S1, nk, lamv, lam_init);
}
#define LAS __attribute__((address_space(3)))
#define GAS __attribute__((address_space(1)))
typedef unsigned short bf16_t;
typedef short bf16x8 __attribute__((ext_vector_type(8)));
typedef float f32x4 __attribute__((ext_vector_type(4)));
typedef float f32x2 __attribute__((ext_vector_type(2)));
typedef float f32x16 __attribute__((ext_vector_type(16)));
typedef unsigned u32x4 __attribute__((ext_vector_type(4)));
typedef unsigned u32x2 __attribute__((ext_vector_type(2)));
typedef short s16x4 __attribute__((ext_vector_type(4)));

__device__ __forceinline__ unsigned cvt_pk_bf16(float lo, float hi) { unsigned r; asm volatile("v_cvt_pk_bf16_f32 %0, %1, %2" : "=v"(r) : "v"(lo), "v"(hi)); return r; }
__device__ __forceinline__ float bf2f(unsigned short h) { return __uint_as_float((unsigned)h << 16); }
__device__ __forceinline__ float bflo(unsigned w) { return __uint_as_float(w << 16); }
__device__ __forceinline__ float bfhi(unsigned w) { return __uint_as_float(w & 0xffff0000u); }
#define LDS_WAIT() asm volatile("s_waitcnt lgkmcnt(0)" ::: "memory")
#define VM_WAIT() asm volatile("s_waitcnt vmcnt(0)" ::: "memory")

__device__ __forceinline__ int mrow_of_tile(int pm) { const int b = pm >= 17 ? 1 : 0; const int t = pm - 17 * b; return t == 16 ? 2 : b; }

namespace pg8 {
constexpr int BM = 256, BK = 64, HALF = 128, HTB = HALF * BK * 2, STAGE_BYTES = 8 * HTB, NXCD = 8, WGM = 8;
__host__ __device__ __forceinline__ int lds_byte(int r, int c) { const int st = (r >> 4) * 2 + (c >> 5), rr = r & 15, cc = c & 31, ob = rr * 64 + cc * 2; return st * 1024 + (ob ^ (((ob >> 9) & 1) << 5)); }
__host__ __device__ __forceinline__ void stage_rc(int b, int& R, int& C) { const int st = b / 1024, sb = b % 1024, swz = sb ^ (((sb >> 9) & 1) << 5); R = (st >> 1) * 16 + swz / 64; C = (st & 1) * 32 + (swz % 64) / 2; }
__host__ __device__ __forceinline__ int perm32(int rho) { const int n = rho >> 4, i = rho & 15; return 8 * (i >> 2) + 4 * n + (i & 3); }

struct Unit { int pm, pn, z; size_t aoff, boff; };
struct Gemm { const bf16_t* A; const bf16_t* Bt; int lda, ldb, K; };

__device__ __forceinline__ bool static_tile(int i, int G, int c, int nM, int nN, int& pm, int& pn) {
    const int nwg = nM * nN; const long L = (long)i * G + c; if (L >= nwg) return false;
    int wgid = (int)L; { const int q = nwg / NXCD, r = nwg % NXCD, xcd = wgid % NXCD, off = wgid / NXCD; wgid = (xcd < r ? xcd * (q + 1) : r * (q + 1) + (xcd - r) * q) + off; }
    const int nig = WGM * nN, gid = wgid / nig, fm = gid * WGM, gsz = (nM - fm) < WGM ? (nM - fm) : WGM;
    pm = fm + ((wgid % nig) % gsz); pn = (wgid % nig) / gsz; return true;
}
struct Sched2D {
    int nM, nN, G, c, lda, ldb, skip_ctx;
    __device__ __forceinline__ bool next(int i, Unit& u) const {
        int pm, pn; if (!static_tile(i, G, c, nM, nN, pm, pn)) return false;
        if (skip_ctx) pm += (pm >= 16) ? 1 : 0;
        u.pm = pm; u.pn = pn; u.z = 0; u.aoff = (size_t)pm * BM * lda * 2; u.boff = (size_t)pn * BM * ldb * 2; return true;
    }
};

template <class Epi, class Sched, bool ALIGN_EPI>
__device__ __forceinline__ void gemm_phase(LAS unsigned char* lds, const Gemm g, const Sched& S, const Epi& E) {
    const int tid = threadIdx.x, wid = __builtin_amdgcn_readfirstlane(tid >> 6), lane = tid & 63, wr = wid >> 2, wc = wid & 3, fr = lane & 15, fq = lane >> 4;
    const int nt = g.K / BK;
    unsigned voffA[2], voffB[2];
#pragma unroll
    for (int i = 0; i < 2; ++i) { int R, C; stage_rc(tid * 16 + i * 8192, R, C); const int Rb = Epi::PERM ? ((R & ~31) + perm32(R & 31)) : R;
        voffA[i] = (unsigned)(R * g.lda + C) * 2u; voffB[i] = (unsigned)(Rb * g.ldb + C) * 2u; }
    const size_t kstep = (size_t)(BK * 2);
    const size_t hstepA = (size_t)HALF * g.lda * 2, hstepB = (size_t)HALF * g.ldb * 2;
    const unsigned ldsw = (unsigned)wid * 1024u;
    const int aoff = lds_byte(wr * 64 + fr, fq * 8), boff = lds_byte(wc * 32 + fr, fq * 8);
#define PG8_SA(b, h) (((b) * 2 + (h)) * HTB)
#define PG8_SB(b, h) ((4 + (b) * 2 + (h)) * HTB)
#define PG8_STAGE(bufoff, gbase, voff) do { _Pragma("unroll") for (int _i = 0; _i < 2; ++_i) \
        __builtin_amdgcn_global_load_lds((const unsigned*)((const char*)(gbase) + (voff)[_i]), (LAS unsigned*)(lds + (bufoff) + ldsw + _i * 8192), 16, 0, 0); } while (0)
#define PG8_LDA(dst, b, h) do { _Pragma("unroll") for (int m = 0; m < 4; ++m) _Pragma("unroll") for (int k = 0; k < 2; ++k) dst[m][k] = *(const LAS bf16x8*)(lds + PG8_SA(b, h) + aoff + m * 2048 + k * 1024); } while (0)
#define PG8_LDB(dst, b, h) do { _Pragma("unroll") for (int n = 0; n < 2; ++n) _Pragma("unroll") for (int k = 0; k < 2; ++k) dst[n][k] = *(const LAS bf16x8*)(lds + PG8_SB(b, h) + boff + n * 2048 + k * 1024); } while (0)
#define PG8_MMA(ai, bj, At, Bt) do { __builtin_amdgcn_s_setprio(1); _Pragma("unroll") for (int m = 0; m < 4; ++m) _Pragma("unroll") for (int n = 0; n < 2; ++n) _Pragma("unroll") for (int k = 0; k < 2; ++k) \
        acc[ai][bj][m][n] = __builtin_amdgcn_mfma_f32_16x16x32_bf16(Bt[n][k], At[m][k], acc[ai][bj][m][n], 0, 0, 0); __builtin_amdgcn_s_setprio(0); } while (0)
#define PG8_WAIT_V(n) asm volatile("s_waitcnt vmcnt(" #n ")" ::: "memory")
#define PG8_WAIT_L(n) asm volatile("s_waitcnt lgkmcnt(" #n ")" ::: "memory")
#define PG8_BAR __builtin_amdgcn_s_barrier()
#define PG8_SCHED __builtin_amdgcn_sched_barrier(0)
    Unit cur, nxt; int ui = 0;
    if (!S.next(0, cur)) return;
    f32x4 acc[2][2][4][2];
#pragma unroll
    for (int a = 0; a < 2; ++a)
#pragma unroll
        for (int b = 0; b < 2; ++b)
#pragma unroll
            for (int m = 0; m < 4; ++m)
#pragma unroll
                for (int n = 0; n < 2; ++n) acc[a][b][m][n] = (f32x4){0.f, 0.f, 0.f, 0.f};
    bf16x8 At[4][2], B0[2][2], B1[2][2];
    const char* cA = (const char*)g.A + cur.aoff; const char* cB = (const char*)g.Bt + cur.boff;
    PG8_STAGE(PG8_SB(0, 0), cB, voffB); PG8_STAGE(PG8_SB(0, 1), cB + hstepB, voffB); PG8_STAGE(PG8_SA(0, 0), cA, voffA); PG8_STAGE(PG8_SA(0, 1), cA + hstepA, voffA);
    if (wr == 1) PG8_BAR;
    PG8_WAIT_V(2); PG8_BAR;
    PG8_STAGE(PG8_SB(1, 0), cB + kstep, voffB); PG8_STAGE(PG8_SA(1, 0), cA + kstep, voffA); PG8_STAGE(PG8_SB(1, 1), cB + hstepB + kstep, voffB);
    PG8_WAIT_V(6); PG8_BAR;
    for (;;) {
        const bool has_next = S.next(ui + 1, nxt);
        const char* nA = has_next ? (const char*)g.A + nxt.aoff : cA; const char* nB = has_next ? (const char*)g.Bt + nxt.boff : cB;
        for (int t = 0; t < nt; t += 2) {
            const bool last = (t == nt - 2);
            const char* a1 = cA + (size_t)(t + 1) * kstep;
            const char* a2 = last ? nA : cA + (size_t)(t + 2) * kstep; const char* b2 = last ? nB : cB + (size_t)(t + 2) * kstep;
            const char* a3 = a2 + kstep; const char* b3 = b2 + kstep;
            PG8_LDB(B0, 0, 0); PG8_LDB(B1, 0, 1); PG8_SCHED; PG8_LDA(At, 0, 0); PG8_STAGE(PG8_SA(1, 1), a1 + hstepA, voffA);
            PG8_WAIT_V(8); PG8_WAIT_L(0); PG8_BAR; PG8_MMA(0, 0, At, B0); PG8_MMA(0, 1, At, B1); PG8_BAR; PG8_SCHED;
            PG8_LDA(At, 0, 1); PG8_STAGE(PG8_SB(0, 0), b2, voffB); PG8_STAGE(PG8_SB(0, 1), b2 + hstepB, voffB); PG8_STAGE(PG8_SA(0, 0), a2, voffA);
            PG8_WAIT_V(8); PG8_WAIT_L(0); PG8_BAR; PG8_MMA(1, 0, At, B0); PG8_MMA(1, 1, At, B1); PG8_BAR; PG8_SCHED;
            PG8_LDB(B0, 1, 0); PG8_LDB(B1, 1, 1); PG8_SCHED; PG8_LDA(At, 1, 0); PG8_STAGE(PG8_SA(0, 1), a2 + hstepA, voffA);
            PG8_WAIT_V(8); PG8_WAIT_L(0); PG8_BAR; PG8_MMA(0, 0, At, B0); PG8_MMA(0, 1, At, B1); PG8_BAR; PG8_SCHED;
            PG8_LDA(At, 1, 1); PG8_STAGE(PG8_SB(1, 0), b3, voffB); PG8_STAGE(PG8_SB(1, 1), b3 + hstepB, voffB); PG8_STAGE(PG8_SA(1, 0), a3, voffA);
            PG8_WAIT_V(8); PG8_WAIT_L(0); PG8_BAR; PG8_MMA(1, 0, At, B0); PG8_MMA(1, 1, At, B1); PG8_BAR; PG8_SCHED;
        }
        if constexpr (ALIGN_EPI) { if (wr == 0) PG8_BAR; }
        E(acc, cur, wr, wc, fr, fq);
        if (!has_next) break;
#pragma unroll
        for (int a = 0; a < 2; ++a)
#pragma unroll
            for (int b = 0; b < 2; ++b)
#pragma unroll
                for (int m = 0; m < 4; ++m)
#pragma unroll
                    for (int n = 0; n < 2; ++n) acc[a][b][m][n] = (f32x4){0.f, 0.f, 0.f, 0.f};
        cur = nxt; cA = nA; cB = nB; ++ui;
        if constexpr (ALIGN_EPI) { if (wr == 1) PG8_BAR; }
    }
    PG8_WAIT_V(0);
    if constexpr (!ALIGN_EPI) { if (wr == 0) PG8_BAR; }
    PG8_BAR;
#undef PG8_SA
#undef PG8_SB
#undef PG8_STAGE
#undef PG8_LDA
#undef PG8_LDB
#undef PG8_MMA
#undef PG8_WAIT_V
#undef PG8_WAIT_L
#undef PG8_BAR
#undef PG8_SCHED
}

__device__ __forceinline__ f32x2 gelu_pk(f32x2 v) {
    const f32x2 av = __builtin_elementwise_abs(v), d = av * 0.2316418882f + 1.0f;
    f32x2 t; t.x = __builtin_amdgcn_rcpf(d.x); t.y = __builtin_amdgcn_rcpf(d.y);
    f32x2 q = t * 0.5307027145f + (-0.7265760135f); q = q * t + 0.7107068705f; q = q * t + (-0.142248368f); q = q * t + 0.127414796f; q = q * t;
    const f32x2 s = (v * v) * (-0.72134752044f);
    f32x2 e; e.x = __builtin_amdgcn_exp2f(s.x); e.y = __builtin_amdgcn_exp2f(s.y);
    const f32x2 m = v * (q * e), r = v - m;
    f32x2 o; o.x = v.x < 0.f ? m.x : r.x; o.y = v.y < 0.f ? m.y : r.y; return o;
}
template <int ACT> struct EpiBf16 {
    static constexpr bool PERM = true;
    bf16_t* O; int ldc; float scale;
    __device__ __forceinline__ void operator()(const f32x4 (&acc)[2][2][4][2], const Unit& u, int wr, int wc, int fr, int fq) const {
        const int row0 = u.pm * BM + wr * 64 + fr, col0 = u.pn * BM + wc * 32 + 8 * fq;
#pragma unroll
        for (int ai = 0; ai < 2; ++ai)
#pragma unroll
            for (int m = 0; m < 4; ++m) { bf16_t* rowp = O + (size_t)(row0 + ai * HALF + m * 16) * ldc + col0;
#pragma unroll
                for (int bj = 0; bj < 2; ++bj) { f32x4 v0 = acc[ai][bj][m][0], v1 = acc[ai][bj][m][1];
                    if (ACT == 2) { v0 = __builtin_elementwise_max(v0, (f32x4){0.f, 0.f, 0.f, 0.f}); v1 = __builtin_elementwise_max(v1, (f32x4){0.f, 0.f, 0.f, 0.f}); v0 = v0 * v0; v1 = v1 * v1; }
                    else { v0 = v0 * scale; v1 = v1 * scale; }
                    u32x4 w; w.x = cvt_pk_bf16(v0[0], v0[1]); w.y = cvt_pk_bf16(v0[2], v0[3]); w.z = cvt_pk_bf16(v1[0], v1[1]); w.w = cvt_pk_bf16(v1[2], v1[3]);
                    *(u32x4*)(rowp + bj * HALF) = w; } }
    }
};
struct EpiResid {
    static constexpr bool PERM = false;
    float* X; const float* gate;
    __device__ __forceinline__ void operator()(const f32x4 (&acc)[2][2][4][2], const Unit& u, int wr, int wc, int fr, int fq) const {
        const int row0 = u.pm * BM + wr * 64 + fr, col0 = u.pn * BM + wc * 32 + 4 * fq;
        const float* gp = gate + (size_t)mrow_of_tile(u.pm) * NMOD + col0;
        f32x4 gv[2][2];
#pragma unroll
        for (int bj = 0; bj < 2; ++bj)
#pragma unroll
            for (int n = 0; n < 2; ++n) gv[bj][n] = *(const f32x4*)(gp + bj * HALF + n * 16);
#pragma unroll
        for (int ai = 0; ai < 2; ++ai)
#pragma unroll
            for (int m = 0; m < 4; ++m) { float* rowp = X + (size_t)(row0 + ai * HALF + m * 16) * D + col0;
#pragma unroll
                for (int bj = 0; bj < 2; ++bj)
#pragma unroll
                    for (int n = 0; n < 2; ++n) { f32x4* p = (f32x4*)(rowp + bj * HALF + n * 16); *p = *p + gv[bj][n] * acc[ai][bj][m][n]; } }
    }
};

template <bool STATS> struct EpiGeluStats {
    static constexpr bool PERM = true;
    bf16_t* O; int ldc; float* stats;
    __device__ __forceinline__ void operator()(const f32x4 (&acc)[2][2][4][2], const Unit& u, int wr, int wc, int fr, int fq) const {
        const int row0 = u.pm * BM + wr * 64 + fr, col0 = u.pn * BM + wc * 32 + 8 * fq;
        const bool st = STATS && (u.pn >= 8);
#pragma unroll
        for (int ai = 0; ai < 2; ++ai)
#pragma unroll
            for (int m = 0; m < 4; ++m) { const int row = row0 + ai * HALF + m * 16; bf16_t* rowp = O + (size_t)row * ldc + col0; float s = 0.f, q = 0.f;
#pragma unroll
                for (int bj = 0; bj < 2; ++bj) { f32x4 v0 = acc[ai][bj][m][0], v1 = acc[ai][bj][m][1];
                    f32x2 a = gelu_pk((f32x2){v0[0], v0[1]}), b = gelu_pk((f32x2){v0[2], v0[3]}), c = gelu_pk((f32x2){v1[0], v1[1]}), d = gelu_pk((f32x2){v1[2], v1[3]});
                    s += (a.x + a.y) + (b.x + b.y) + (c.x + c.y) + (d.x + d.y);
                    q += (a.x * a.x + a.y * a.y) + (b.x * b.x + b.y * b.y) + (c.x * c.x + c.y * c.y) + (d.x * d.x + d.y * d.y);
                    u32x4 w; w.x = cvt_pk_bf16(a.x, a.y); w.y = cvt_pk_bf16(b.x, b.y); w.z = cvt_pk_bf16(c.x, c.y); w.w = cvt_pk_bf16(d.x, d.y);
                    *(u32x4*)(rowp + bj * HALF) = w; }
                if (st) { s += __shfl_xor(s, 16); s += __shfl_xor(s, 32); q += __shfl_xor(q, 16); q += __shfl_xor(q, 32);
                    if (fq == 0) *(f32x2*)(stats + (((size_t)row * 8 + (u.pn - 8)) * 4 + wc) * 2) = (f32x2){s, q}; } }
    }
};
struct SchedChan {
    int G, c;
    __device__ __forceinline__ bool next(int i, Unit& u) const {
        const int L = i * G + c; if (L >= 544) return false;
        int b, g, pm, pn, ctx;
        if (L < 512) { ctx = 0; pn = L & 15; pm = (L >> 4) & 3; g = (L >> 6) & 3; b = L >> 8; }
        else { const int r = L - 512; ctx = 1; pn = 0; pm = r & 3; g = (r >> 2) & 3; b = r >> 4; }
        u.pm = pm; u.pn = pn; u.z = b | (g << 1) | (ctx << 3);
        u.aoff = (size_t)pm * BM * 512 * 2;
        u.boff = ((size_t)(b * RB + (ctx ? SEQ : pn * BM)) * D + g * 512) * 2;
        return true;
    }
};
struct EpiChan {
    static constexpr bool PERM = true;
    bf16_t* PB; bf16_t* PBc;
    __device__ __forceinline__ void operator()(const f32x4 (&acc)[2][2][4][2], const Unit& u, int wr, int wc, int fr, int fq) const {
        const int b = u.z & 1, g = (u.z >> 1) & 3, ctx = u.z >> 3;
        const int ldc = ctx ? 512 : 8192;
        bf16_t* base = (ctx ? PBc + (size_t)b * 2048 * 512 : PB + (size_t)b * 2048 * 8192) + (size_t)(g * 512 + (u.pm & 1) * 256) * ldc + (u.pm >> 1) * (ctx ? 256 : 4096) + u.pn * BM;
        const int row0 = wr * 64 + fr, col0 = wc * 32 + 8 * fq;
#pragma unroll
        for (int ai = 0; ai < 2; ++ai)
#pragma unroll
            for (int m = 0; m < 4; ++m) { bf16_t* rowp = base + (size_t)(row0 + ai * HALF + m * 16) * ldc + col0;
#pragma unroll
                for (int bj = 0; bj < 2; ++bj) { const f32x4 v0 = acc[ai][bj][m][0], v1 = acc[ai][bj][m][1];
                    u32x4 w; w.x = cvt_pk_bf16(v0[0], v0[1]); w.y = cvt_pk_bf16(v0[2], v0[3]); w.z = cvt_pk_bf16(v1[0], v1[1]); w.w = cvt_pk_bf16(v1[2], v1[3]);
                    *(u32x4*)(rowp + bj * HALF) = w; } }
    }
};
struct SchedPosL {
    int G, c;
    __device__ __forceinline__ bool next(int i, Unit& u) const {
        int pm, pn; if (!static_tile(i, G, c, 32, 8, pm, pn)) return false;
        const int b = pm >> 4; pm &= 15;
        u.pm = b * 17 + pm; u.pn = pn; u.z = b; u.aoff = (size_t)pm * BM * 8192 * 2; u.boff = ((size_t)b * 2048 + pn * BM) * 8192 * 2; return true;
    }
};
struct SchedPosC {
    int G, c;
    __device__ __forceinline__ bool next(int i, Unit& u) const {
        const int L = i * G + (G - 1 - c); if (L >= 16) return false;
        const int b = L >> 3, pn = L & 7;
        u.pm = b * 17 + 16; u.pn = pn; u.z = b; u.aoff = 0; u.boff = ((size_t)b * 2048 + pn * BM) * 512 * 2; return true;
    }
};

struct EpiQKV {
    static constexpr bool PERM = true;
    bf16_t* O; const float* rope;
    __device__ __forceinline__ void operator()(const f32x4 (&acc)[2][2][4][2], const Unit& u, int wr, int wc, int fr, int fq) const {
        const int rloc = wr * 64 + fr, col0 = u.pn * BM + wc * 32 + 8 * fq;
        const int mr = mrow_of_tile(u.pm); const bool dorope = (u.pn < 16) && (mr != 2);
        const int b = u.pm >= 17 ? 1 : 0, t0 = (u.pm - 17 * b) * BM; const int i0 = wc * 16 + 4 * fq;
#pragma unroll
        for (int ai = 0; ai < 2; ++ai)
#pragma unroll
            for (int m = 0; m < 4; ++m) { const int rl = rloc + ai * HALF + m * 16; bf16_t* rowp = O + (size_t)(u.pm * BM + rl) * 6144 + col0;
                f32x4 cs = {1.f, 1.f, 1.f, 1.f}, sn = {0.f, 0.f, 0.f, 0.f};
                if (dorope) { const int pos = t0 + rl; cs = *(const f32x4*)(rope + (size_t)pos * 64 + i0); sn = *(const f32x4*)(rope + (size_t)4096 * 64 + (size_t)pos * 64 + i0); }
#pragma unroll
                for (int bj = 0; bj < 2; ++bj) { const f32x4 v0 = acc[ai][bj][m][0], v1 = acc[ai][bj][m][1];
                    const float e0 = v0[0] * cs[0] - v0[1] * sn[0], o0 = v0[0] * sn[0] + v0[1] * cs[0];
                    const float e1 = v0[2] * cs[1] - v0[3] * sn[1], o1 = v0[2] * sn[1] + v0[3] * cs[1];
                    const float e2 = v1[0] * cs[2] - v1[1] * sn[2], o2 = v1[0] * sn[2] + v1[1] * cs[2];
                    const float e3 = v1[2] * cs[3] - v1[3] * sn[3], o3 = v1[2] * sn[3] + v1[3] * cs[3];
                    u32x4 w; w.x = cvt_pk_bf16(e0, o0); w.y = cvt_pk_bf16(e1, o1); w.z = cvt_pk_bf16(e2, o2); w.w = cvt_pk_bf16(e3, o3);
                    *(u32x4*)(rowp + bj * HALF) = w; } }
    }
};
}

#define XB_TMO      128
#define XB_XCNT(j)  (256  + 64 * (j))
#define XB_XSUB(j)  (1280 + 64 * (j))
#define XB_XGEN(j)  (2304 + 64 * (j))
#define XB_TOP      3328
#define XB_TOPGEN   3392
#define XCD_BAR_WORDS 3456
#define XB_SPIN_CAP (1u << 18)
__device__ __forceinline__ unsigned xb_ld(unsigned* p)              { return __hip_atomic_load(p, __ATOMIC_RELAXED, __HIP_MEMORY_SCOPE_AGENT); }
__device__ __forceinline__ unsigned xb_add(unsigned* p, unsigned v) { return __hip_atomic_fetch_add(p, v, __ATOMIC_RELAXED, __HIP_MEMORY_SCOPE_AGENT); }
__device__ __forceinline__ unsigned xb_xcc_id() { return (unsigned)__builtin_amdgcn_s_getreg((3 << 11) | 20) & 0xFu; }
#define XB_SPIN(cond, bar) do { unsigned _sp = 0; while (cond) { __builtin_amdgcn_s_sleep(1); \
    if ((++_sp & 255u) == 0u) { if (xb_ld(&(bar)[XB_TMO])) break; if (_sp > XB_SPIN_CAP) { atomicAdd(&(bar)[XB_TMO], 1u); break; } } } } while (0)
struct XcdBarrier { unsigned* bar; unsigned x; volatile LAS unsigned* st; };
__device__ __forceinline__ XcdBarrier xcd_barrier_post(unsigned* bar, volatile LAS unsigned* st) {
    XcdBarrier b; b.bar = bar; b.x = xb_xcc_id(); b.st = st;
    if (threadIdx.x == 0) (void)xb_add(&bar[XB_XCNT(b.x)], 1u);
    return b;
}
__device__ __forceinline__ void xcd_barrier_complete(unsigned* bar, unsigned x, unsigned& nloc, unsigned& nx) {
    const unsigned G = gridDim.x * gridDim.y * gridDim.z;
    unsigned sum, cnt, mine, sp = 0u;
    for (;;) {
        sum = 0u; cnt = 0u; mine = 0u;
#pragma unroll
        for (unsigned j = 0; j < 16; ++j) { const unsigned c = xb_ld(&bar[XB_XCNT(j)]); sum += c; cnt += (c > 0u) ? 1u : 0u; mine = (j == x) ? c : mine; }
        if (sum == G) break;
        __builtin_amdgcn_s_sleep(1);
        if ((++sp & 255u) == 0u) { if (xb_ld(&bar[XB_TMO])) break; if (sp > XB_SPIN_CAP) { atomicAdd(&bar[XB_TMO], 1u); break; } }
    }
    nloc = mine > 0u ? mine : 1u; nx = cnt > 0u ? cnt : 1u;
}
__device__ __forceinline__ void xcd_barrier(const XcdBarrier& b) {
    asm volatile("s_waitcnt vmcnt(0)" ::: "memory");
    __syncthreads();
    if (threadIdx.x == 0) {
        unsigned* bar = b.bar;
        __builtin_amdgcn_s_waitcnt(0);
        unsigned nloc = b.st[0], nx = b.st[1];
        if (nloc == 0u) { xcd_barrier_complete(bar, b.x, nloc, nx); b.st[0] = nloc; b.st[1] = nx; }
        const unsigned old = xb_add(&bar[XB_XSUB(b.x)], 1u);
        const unsigned gen = old / nloc;
        if (old + 1u == (gen + 1u) * nloc) {
            __builtin_amdgcn_fence(__ATOMIC_RELEASE, "agent");
            asm volatile("s_waitcnt vmcnt(0)" ::: "memory");
            const unsigned og = xb_add(&bar[XB_TOP], 1u);
            const unsigned tg = og / nx;
            if (og + 1u == (tg + 1u) * nx) xb_add(&bar[XB_TOPGEN], 1u);
            else XB_SPIN(xb_ld(&bar[XB_TOPGEN]) == tg, bar);
            __builtin_amdgcn_fence(__ATOMIC_ACQUIRE, "agent");
            xb_add(&bar[XB_XGEN(b.x)], 1u);
            asm volatile("s_waitcnt vmcnt(0)" ::: "memory");
        } else {
            XB_SPIN(xb_ld(&bar[XB_XGEN(b.x)]) == gen, bar);
            __builtin_amdgcn_fence(__ATOMIC_ACQUIRE, "agent");
            asm volatile("s_waitcnt vmcnt(0)" ::: "memory");
        }
    }
    __syncthreads();
}
constexpr size_t MiB = 1u << 20;
constexpr size_t WS_CTL = 0, CTL_ZERO_BYTES = 4 * MiB;
constexpr size_t WS_MOD = 1 * MiB;
constexpr size_t WS_WIN_T = 4 * MiB;
constexpr size_t WS_WOUT_T = WS_WIN_T + 128 * MiB;
constexpr size_t WS_FNO_T = WS_WOUT_T + 128 * MiB;
constexpr size_t WS_GMIN_T = WS_FNO_T + 8 * MiB;
constexpr size_t WS_GMOUT_T = WS_GMIN_T + 16 * MiB;
constexpr size_t WS_DFIN_T = WS_GMOUT_T + 8 * MiB;
constexpr size_t WS_DFOUT_T = WS_DFIN_T + 24 * MiB;
constexpr size_t WS_GLIN_T = WS_DFOUT_T + 8 * MiB;
constexpr size_t WS_GLOUT_T = WS_GLIN_T + 25 * MiB;
constexpr size_t WS_TC = WS_GLOUT_T + 8 * MiB;
constexpr size_t WS_PT = WS_TC + 1 * MiB;
constexpr size_t WS_PC = WS_PT + 64 * MiB;
constexpr size_t WS_ROPE = WS_PC + 1 * MiB;
constexpr size_t WS_GMWS = WS_ROPE + 2 * MiB;
constexpr size_t WS_XR = WS_GMWS + 1 * MiB;
constexpr size_t WS_H = WS_XR + 68 * MiB;
constexpr size_t WS_BIG = WS_H + 34 * MiB;
constexpr size_t WS_A2 = WS_BIG + 136 * MiB;
constexpr size_t WS_F1 = WS_A2 + 34 * MiB;
constexpr size_t WS_F2 = WS_F1 + 68 * MiB;
constexpr size_t WS_LNS = WS_F1;
constexpr size_t WS_G1 = WS_F2 + 68 * MiB;
constexpr size_t WS_NAIVE = WS_G1 + 128 * MiB;
constexpr size_t WS_END_MK = WS_NAIVE;

constexpr int NWAVES = 8;
constexpr int RING_BYTES = 131072, MISC_OFF = RING_BYTES + 320, LDS_BYTES = 147456;

struct Args { const float* in[27]; float* out; unsigned char* ws; int ph_lo, ph_hi, li, pad; };

struct Frame {
    LAS unsigned char* lds; volatile LAS unsigned* MISC; unsigned* ctl;
    int tid, lane, wave, vcu, G;
};
__device__ __forceinline__ float wave_sum(float v) {
#pragma unroll
    for (int o = 1; o < 64; o <<= 1) v += __shfl_xor(v, o);
    return v;
}
__device__ __forceinline__ unsigned f2bf(float f) { unsigned u = __float_as_uint(f); return (u + 0x7fffu + ((u >> 16) & 1u)) >> 16; }
__device__ __forceinline__ unsigned pk2(float lo, float hi) { return f2bf(lo) | (f2bf(hi) << 16); }

template <int MAP>
__device__ __forceinline__ void transpose_item(const float* W, int K, int N, bf16_t* WT, int ldt, LAS float* scr, int item, int lane) {
    const int nblk = N / 32, kb = item / nblk, nb = item % nblk, k0 = 64 * kb, n0 = 32 * nb;
#pragma unroll 8
    for (int i = 0; i < 32; ++i) { const int kk = 2 * i + (lane >> 5); scr[kk * 33 + (lane & 31)] = W[(size_t)(k0 + kk) * N + n0 + (lane & 31)]; }
    LDS_WAIT(); asm volatile("" ::: "memory");
    const int c = lane & 7;
#pragma unroll
    for (int j = 0; j < 4; ++j) { const int n = (lane >> 3) + 8 * j; const LAS float* s = scr + (8 * c) * 33 + n;
        u32x4 o; o.x = pk2(s[0 * 33], s[1 * 33]); o.y = pk2(s[2 * 33], s[3 * 33]); o.z = pk2(s[4 * 33], s[5 * 33]); o.w = pk2(s[6 * 33], s[7 * 33]);
        int nn = n0 + n;
        if (MAP == 1) { if (nn < 4096) { const int blk = nn >> 7, w = nn & 127, sgn = w >> 6, i2 = w & 63; nn = blk * 128 + 2 * i2 + sgn; } }
        *(u32x4*)(WT + (size_t)nn * ldt + k0 + 8 * c) = o; }
    LDS_WAIT(); asm volatile("" ::: "memory");
}
template <int MAP>
__device__ __forceinline__ void transpose_all(Frame& F, const float* W, int K, int N, bf16_t* WT) {
    LAS float* scr = (LAS float*)(F.lds + F.wave * 16384);
    const int gw = F.vcu * NWAVES + F.wave, NGW = F.G * NWAVES, nitems = (K / 64) * (N / 32);
    for (int it = gw; it < nitems; it += NGW) transpose_item<MAP>(W, K, N, WT, K, scr, it, F.lane);
}

__device__ __forceinline__ void phase_prologue(Frame& F, const Args& a) {
    unsigned char* ws = a.ws;
    const int gw = F.vcu * NWAVES + F.wave, NGW = F.G * NWAVES, lane = F.lane;
    {
        float* XR = (float*)(ws + WS_XR);
        for (int row = gw; row < M; row += NGW) {
            const int b = row >= RB ? 1 : 0, t = row - b * RB;
            const float* src = t < SEQ ? a.in[0] + (size_t)(b * SEQ + t) * D : a.in[2] + (size_t)(b * CTX + (t - SEQ)) * D;
            const f32x4* s4 = (const f32x4*)src + lane; f32x4* d4 = (f32x4*)(XR + (size_t)row * D) + lane;
#pragma unroll
            for (int j = 0; j < 8; ++j) d4[64 * j] = s4[64 * j];
        }
    }
    if (F.vcu < 192) {
        float* MOD = (float*)(ws + WS_MOD);
        const float* c = a.in[1]; const float* cc = a.in[3]; const float* wa = a.in[4]; const float* ba = a.in[5];
        const int l = F.vcu / 48, jg = F.vcu % 48, col = jg * 256 + 4 * lane, w = F.wave;
        const float* wp = wa + ((size_t)l * D + w * 256) * NMOD + col;
        f32x4 a0 = {0.f, 0.f, 0.f, 0.f}, a1 = a0, a2 = a0;
#pragma unroll 8
        for (int k = 0; k < 256; ++k) {
            const f32x4 wv = *(const f32x4*)(wp + (size_t)k * NMOD);
            const int kk = w * 256 + k;
            float c0 = c[kk], c1 = c[D + kk], c2 = cc[kk];
            c0 = c0 / (1.f + __expf(-c0)); c1 = c1 / (1.f + __expf(-c1)); c2 = c2 / (1.f + __expf(-c2));
            a0 = a0 + wv * c0; a1 = a1 + wv * c1; a2 = a2 + wv * c2;
        }
        LAS float* part = (LAS float*)F.lds;
        *(LAS f32x4*)(part + (w * 3 + 0) * 256 + 4 * lane) = a0; *(LAS f32x4*)(part + (w * 3 + 1) * 256 + 4 * lane) = a1; *(LAS f32x4*)(part + (w * 3 + 2) * 256 + 4 * lane) = a2;
        __syncthreads();
        for (int i = F.tid; i < 768; i += NWAVES * 64) { const int r = i >> 8, cj = i & 255; float sacc = ba[(size_t)l * NMOD + jg * 256 + cj];
#pragma unroll
            for (int ww = 0; ww < 8; ++ww) sacc += part[(ww * 3 + r) * 256 + cj];
            MOD[((size_t)l * 3 + r) * NMOD + jg * 256 + cj] = sacc; }
        __syncthreads();
    }
    for (int l = 0; l < 4; ++l) {
        transpose_all<0>(F, a.in[8] + (size_t)l * D * DFF, D, DFF, (bf16_t*)(ws + WS_WIN_T) + (size_t)l * DFF * D);
        transpose_all<0>(F, a.in[9] + (size_t)l * DFF * D, DFF, D, (bf16_t*)(ws + WS_WOUT_T) + (size_t)l * DFF * D);
    }
    transpose_all<0>(F, a.in[11], D, D, (bf16_t*)(ws + WS_FNO_T));
    transpose_all<0>(F, a.in[12], D, 4096, (bf16_t*)(ws + WS_GMIN_T));
    transpose_all<0>(F, a.in[17], D, D, (bf16_t*)(ws + WS_GMOUT_T));
    transpose_all<1>(F, a.in[18], D, 6144, (bf16_t*)(ws + WS_DFIN_T));
    transpose_all<0>(F, a.in[21], D, D, (bf16_t*)(ws + WS_DFOUT_T));
    transpose_all<0>(F, a.in[22], D, 6176, (bf16_t*)(ws + WS_GLIN_T));
    transpose_all<0>(F, a.in[26], D, D, (bf16_t*)(ws + WS_GLOUT_T));
    {
        u32x4* z = (u32x4*)((bf16_t*)(ws + WS_GLIN_T) + (size_t)6176 * D);
        const int n16 = 224 * D * 2 / 16;
        for (int i = gw * 64 + lane; i < n16; i += NGW * 64) z[i] = (u32x4){0u, 0u, 0u, 0u};
    }
    {
        bf16_t* TC = (bf16_t*)(ws + WS_TC); bf16_t* PT = (bf16_t*)(ws + WS_PT); bf16_t* PC = (bf16_t*)(ws + WS_PC);
        const int gt = gw * 64 + lane, NT = NGW * 64;
        for (int i = gt; i < 4096 * 8192 / 8; i += NT) {
            const int k = i >> 10, j0 = (i & 1023) * 8; const bool isn = j0 >= 4096; const int n0 = j0 & 4095; unsigned w[4];
#pragma unroll
            for (int e = 0; e < 8; e += 2) { float s0, c0, s1, c1; sincospif((float)((k * (n0 + e)) & 4095) * (1.f / 2048.f), &s0, &c0); sincospif((float)((k * (n0 + e + 1)) & 4095) * (1.f / 2048.f), &s1, &c1);
                w[e >> 1] = isn ? pk2(-s0, -s1) : pk2(c0, c1); }
            *(u32x4*)(PT + (size_t)k * 8192 + j0) = (u32x4){w[0], w[1], w[2], w[3]};
        }
        for (int i = gt; i < 1024 * 512 / 8; i += NT) {
            const int r = i >> 6, c0 = (i & 63) * 8; const bool isn = r >= 512; const int rr = r & 511; unsigned w[4];
#pragma unroll
            for (int e = 0; e < 8; e += 2) { float s0, cc0, s1, cc1; sincospif((float)((rr * (c0 + e)) & 511) * (1.f / 256.f), &s0, &cc0); sincospif((float)((rr * (c0 + e + 1)) & 511) * (1.f / 256.f), &s1, &cc1);
                w[e >> 1] = isn ? pk2(s0, s1) : pk2(cc0, cc1); }
            *(u32x4*)(TC + (size_t)r * 512 + c0) = (u32x4){w[0], w[1], w[2], w[3]};
        }
        for (int i = gt; i < 256 * 512 / 8; i += NT) {
            const int k = i >> 6, j0 = (i & 63) * 8; const bool isn = j0 >= 256; const int n0 = j0 & 255; unsigned w[4];
#pragma unroll
            for (int e = 0; e < 8; e += 2) { float s0, c0, s1, c1; sincospif((float)((k * (n0 + e)) & 255) * (1.f / 128.f), &s0, &c0); sincospif((float)((k * (n0 + e + 1)) & 255) * (1.f / 128.f), &s1, &c1);
                w[e >> 1] = isn ? pk2(-s0, -s1) : pk2(c0, c1); }
            *(u32x4*)(PC + (size_t)k * 512 + j0) = (u32x4){w[0], w[1], w[2], w[3]};
        }
        {
            float* rc = (float*)(ws + WS_ROPE); float* rs = rc + 4096 * 64;
            for (int i = gt; i < 4096 * 64; i += NT) { const int pos = i >> 6, j = i & 63; const float inv = powf(10000.f, -(float)(j & 31) * (1.f / 32.f));
                const float ang = (float)(j < 32 ? (pos >> 6) : (pos & 63)) * inv; float sn, cs; sincosf(ang, &sn, &cs); rc[i] = cs; rs[i] = sn; }
        }
        const float* wsf = a.in[15]; bf16_t* wsb = (bf16_t*)(ws + WS_GMWS);
        for (int i = gt; i < 16 * 128 * 128 / 8; i += NT) { const f32x4 x0 = *(const f32x4*)(wsf + (size_t)i * 8), x1 = *(const f32x4*)(wsf + (size_t)i * 8 + 4);
            *(u32x4*)(wsb + (size_t)i * 8) = (u32x4){pk2(x0.x, x0.y), pk2(x0.z, x0.w), pk2(x1.x, x1.y), pk2(x1.z, x1.w)}; }
    }
}

__device__ __forceinline__ void phase_modulate(Frame& F, const float* X, const float* g, const float* shift, const float* scale, bf16_t* H, bool skip_ctx) {
    const int gw = F.vcu * NWAVES + F.wave, NGW = F.G * NWAVES, lane = F.lane;
    for (int row = gw; row < M; row += NGW) {
        const int mr = mrow_of_tile(row >> 8);
        if (skip_ctx && mr == 2) continue;
        const f32x4* xr = (const f32x4*)(X + (size_t)row * D) + lane;
        f32x4 v[8]; float s = 0.f;
#pragma unroll
        for (int j = 0; j < 8; ++j) { v[j] = xr[64 * j]; s += (v[j].x * v[j].x + v[j].y * v[j].y) + (v[j].z * v[j].z + v[j].w * v[j].w); }
        const float r = rsqrtf(wave_sum(s) * (1.f / D) + 1e-6f);
        const f32x4* g4 = (const f32x4*)g + lane; const f32x4* sc4 = (const f32x4*)(scale + (size_t)mr * NMOD) + lane; const f32x4* sh4 = (const f32x4*)(shift + (size_t)mr * NMOD) + lane;
        u32x2* o8 = (u32x2*)(H + (size_t)row * D) + lane;
#pragma unroll
        for (int j = 0; j < 8; ++j) { const f32x4 o = v[j] * r * g4[64 * j] * (sc4[64 * j] + 1.f) + sh4[64 * j];
            u32x2 w; w.x = cvt_pk_bf16(o.x, o.y); w.y = cvt_pk_bf16(o.z, o.w); o8[64 * j] = w; }
    }
}
__device__ __forceinline__ void phase_final(Frame& F, const float* X, const float* g, float* out) {
    const int gw = F.vcu * NWAVES + F.wave, NGW = F.G * NWAVES, lane = F.lane;
    for (int orow = gw; orow < BATCH * SEQ; orow += NGW) {
        const int b = orow >> 12, t = orow & 4095;
        const f32x4* xr = (const f32x4*)(X + (size_t)(b * RB + t) * D) + lane;
        f32x4 v[8]; float s = 0.f;
#pragma unroll
        for (int j = 0; j < 8; ++j) { v[j] = xr[64 * j]; s += (v[j].x * v[j].x + v[j].y * v[j].y) + (v[j].z * v[j].z + v[j].w * v[j].w); }
        const float r = rsqrtf(wave_sum(s) * (1.f / D) + 1e-6f);
        const f32x4* g4 = (const f32x4*)g + lane; f32x4* o4 = (f32x4*)(out + (size_t)orow * D) + lane;
#pragma unroll
        for (int j = 0; j < 8; ++j) o4[64 * j] = v[j] * r * g4[64 * j];
    }
}

__device__ __forceinline__ void phase_spatial(Frame& F, const bf16_t* Z, const float* LNS, const float* ln_g, const float* ln_b, const bf16_t* WsB, const float* b_s, bf16_t* OUT) {
    LAS bf16_t* VT = (LAS bf16_t*)(F.lds); LAS float* S = (LAS float*)(F.lds + 36864); LAS float* ST = (LAS float*)(F.lds + 104448);
    const int tid = F.tid, lane = F.lane, w = F.wave, l32 = lane & 31, hi = lane >> 5;
    for (int unit = F.vcu; unit < 68 * 16; unit += F.G) {
        const int chunk = unit >> 4, h = unit & 15; const int row0 = chunk * 128;
        if (tid < 128) { float sm = 0.f, sq = 0.f; const f32x2* pp = (const f32x2*)(LNS + (size_t)(row0 + tid) * 64);
#pragma unroll
            for (int j = 0; j < 32; ++j) { const f32x2 t = pp[j]; sm += t.x; sq += t.y; }
            const float mu = sm * (1.f / 2048.f); const float var = sq * (1.f / 2048.f) - mu * mu;
            ST[tid * 2] = mu; ST[tid * 2 + 1] = rsqrtf(fmaxf(var, 0.f) + 1e-5f); }
        __syncthreads();
#pragma unroll
        for (int i = 0; i < 4; ++i) { const int idx = tid + 512 * i, q = idx >> 4, e8 = (idx & 15) * 8;
            const u32x4 raw = *(const u32x4*)(Z + (size_t)(row0 + q) * 4096 + 2048 + h * 128 + e8);
            const float mu = ST[q * 2], rs = ST[q * 2 + 1];
            const f32x4 g0 = *(const f32x4*)(ln_g + h * 128 + e8), g1 = *(const f32x4*)(ln_g + h * 128 + e8 + 4), b0 = *(const f32x4*)(ln_b + h * 128 + e8), b1 = *(const f32x4*)(ln_b + h * 128 + e8 + 4);
            float v[8] = {bflo(raw.x), bfhi(raw.x), bflo(raw.y), bfhi(raw.y), bflo(raw.z), bfhi(raw.z), bflo(raw.w), bfhi(raw.w)};
            const float gg[8] = {g0.x, g0.y, g0.z, g0.w, g1.x, g1.y, g1.z, g1.w}, bb[8] = {b0.x, b0.y, b0.z, b0.w, b1.x, b1.y, b1.z, b1.w};
#pragma unroll
            for (int j = 0; j < 8; ++j) { const float o = (v[j] - mu) * rs * gg[j] + bb[j]; VT[(e8 + j) * 136 + q] = (bf16_t)f2bf(o); } }
        __syncthreads();
        const int pt = w >> 1, et0 = (w & 1) * 2;
        f32x16 acc0 = {}, acc1 = {};
        const bf16_t* Ap = WsB + ((size_t)h * 128 + pt * 32 + l32) * 128 + hi * 8;
#pragma unroll
        for (int ks = 0; ks < 8; ++ks) {
            const bf16x8 af = *(const bf16x8*)(Ap + ks * 16);
            const bf16x8 b0 = *(const LAS bf16x8*)(VT + (et0 * 32 + l32) * 136 + ks * 16 + hi * 8);
            const bf16x8 b1 = *(const LAS bf16x8*)(VT + ((et0 + 1) * 32 + l32) * 136 + ks * 16 + hi * 8);
            acc0 = __builtin_amdgcn_mfma_f32_32x32x16_bf16(af, b0, acc0, 0, 0, 0);
            acc1 = __builtin_amdgcn_mfma_f32_32x32x16_bf16(af, b1, acc1, 0, 0, 0);
        }
#pragma unroll
        for (int r = 0; r < 16; ++r) { const int p = pt * 32 + (r & 3) + 8 * (r >> 2) + 4 * hi; const float bs = b_s[h * 128 + p];
            S[p * 132 + et0 * 32 + l32] = acc0[r] + bs; S[p * 132 + (et0 + 1) * 32 + l32] = acc1[r] + bs; }
        __syncthreads();
#pragma unroll
        for (int i = 0; i < 4; ++i) { const int idx = tid + 512 * i, p = idx >> 4, e8 = (idx & 15) * 8;
            const u32x4 raw = *(const u32x4*)(Z + (size_t)(row0 + p) * 4096 + h * 128 + e8);
            const LAS float* sp = S + p * 132 + e8;
            u32x4 o; o.x = cvt_pk_bf16(bflo(raw.x) * sp[0], bfhi(raw.x) * sp[1]); o.y = cvt_pk_bf16(bflo(raw.y) * sp[2], bfhi(raw.y) * sp[3]);
            o.z = cvt_pk_bf16(bflo(raw.z) * sp[4], bfhi(raw.z) * sp[5]); o.w = cvt_pk_bf16(bflo(raw.w) * sp[6], bfhi(raw.w) * sp[7]);
            *(u32x4*)(OUT + (size_t)(row0 + p) * D + h * 128 + e8) = o; }
        __syncthreads();
    }
}

__device__ __forceinline__ void phase_lnstats(Frame& F, const bf16_t* Z, float* LNS) {
    const int gw = F.vcu * NWAVES + F.wave, NGW = F.G * NWAVES, lane = F.lane;
    for (int row = gw; row < M; row += NGW) {
        const u32x4* zr = (const u32x4*)(Z + (size_t)row * 4096 + 2048) + lane; float s = 0.f, q = 0.f;
#pragma unroll
        for (int j = 0; j < 4; ++j) { const u32x4 r = zr[64 * j]; const float v[8] = {bflo(r.x), bfhi(r.x), bflo(r.y), bfhi(r.y), bflo(r.z), bfhi(r.z), bflo(r.w), bfhi(r.w)};
#pragma unroll
            for (int e = 0; e < 8; ++e) { s += v[e]; q += v[e] * v[e]; } }
        s = wave_sum(s); q = wave_sum(q);
        if (lane < 32) *(f32x2*)(LNS + (size_t)row * 64 + lane * 2) = lane == 0 ? (f32x2){s, q} : (f32x2){0.f, 0.f};
    }
}
namespace attn {
using bf16 = unsigned short;
using f32x8  = __attribute__((ext_vector_type(8))) float;
constexpr int D_ = 128, NW = 8, QBLK = 32, KVBLK = 64;
constexpr float SCALE = 0.088388347648318440f;
constexpr float THR = 8.f;
constexpr size_t SHM_V = KVBLK * D_ * 2, SHM_K = KVBLK * D_ * 2, SHM_ATTN = 2 * SHM_V + 2 * SHM_K + NW * 64 * 4;
#define KSWZ(row, colB) ((row) * 256 + ((colB) ^ (((row) & 7) << 4)))
#define SBAR() __builtin_amdgcn_sched_barrier(0)
__device__ __forceinline__ int crow(int r, int hi) { return (r & 3) + 8 * (r >> 2) + 4 * hi; }
__device__ __forceinline__ unsigned cvtpk(float lo, float hi) { unsigned r; asm volatile("v_cvt_pk_bf16_f32 %0, %1, %2" : "=v"(r) : "v"(lo), "v"(hi)); return r; }
__device__ __forceinline__ bf16x8 ld8(const bf16* p) { return *reinterpret_cast<const bf16x8*>(p); }

__device__ __forceinline__ void partialSM(f32x16& p0, f32x16& p1, float& m_reg, float& mn, float& alpha) {
  constexpr float C = SCALE * 1.4426950408889634f;
  float pmax = p0[0]; for (int r = 1; r < 16; ++r) pmax = fmaxf(pmax, p0[r]); for (int r = 0; r < 16; ++r) pmax = fmaxf(pmax, p1[r]);
  { auto rr = __builtin_amdgcn_permlane32_swap(__float_as_uint(pmax), __float_as_uint(pmax), false, false);
    pmax = fmaxf(__uint_as_float(rr[0]), __uint_as_float(rr[1])); }
  if (__builtin_expect(__all(pmax - m_reg <= THR / SCALE), 1)) { mn = m_reg; alpha = 1.f; }
  else { mn = fmaxf(m_reg, pmax); alpha = __builtin_amdgcn_exp2f((m_reg - mn) * C); m_reg = mn; }
  float mnC = -mn * C;
  for (int r = 0; r < 16; ++r) p0[r] = fmaf(p0[r], C, mnC); for (int r = 0; r < 16; ++r) p1[r] = fmaf(p1[r], C, mnC);
  for (int r = 0; r < 16; ++r) p0[r] = __builtin_amdgcn_exp2f(p0[r]);
}
__device__ __forceinline__ void finishSM(f32x16& p0, f32x16& p1, float alpha, float& l_reg, bf16x8& pa0, bf16x8& pa1, bf16x8& pa2, bf16x8& pa3) {
  for (int r = 0; r < 16; ++r) p1[r] = __builtin_amdgcn_exp2f(p1[r]);
  float ps = 0; for (int r = 0; r < 16; ++r) ps += p0[r]; for (int r = 0; r < 16; ++r) ps += p1[r];
  { auto rr = __builtin_amdgcn_permlane32_swap(__float_as_uint(ps), __float_as_uint(ps), false, false);
    ps = __uint_as_float(rr[0]) + __uint_as_float(rr[1]); }
  l_reg = l_reg * alpha + ps;
#define PK4(P, BASE, OUT) do { unsigned a0 = cvtpk(P[BASE + 0], P[BASE + 1]), a1 = cvtpk(P[BASE + 2], P[BASE + 3]);   \
    unsigned b0 = cvtpk(P[BASE + 4], P[BASE + 5]), b1 = cvtpk(P[BASE + 6], P[BASE + 7]);                              \
    auto r0 = __builtin_amdgcn_permlane32_swap(a0, b0, false, false); auto r1 = __builtin_amdgcn_permlane32_swap(a1, b1, false, false); \
    u32x4 w = {r0[0], r1[0], r0[1], r1[1]}; OUT = *reinterpret_cast<bf16x8*>(&w); } while (0)
  PK4(p0, 0, pa0); PK4(p0, 8, pa1); PK4(p1, 0, pa2); PK4(p1, 8, pa3);
#undef PK4
}
__device__ __forceinline__ void qkt(f32x16& p0, f32x16& p1, const bf16* Ks, const bf16x8* qr, int r32, int hi) {
  p0 = f32x16{}; p1 = f32x16{};
  for (int d0 = 0; d0 < 8; ++d0) { int cb = (d0 * 16 + hi * 8) * 2;
    bf16x8 b0 = *reinterpret_cast<const bf16x8*>((const char*)Ks + KSWZ(r32, cb));
    bf16x8 b1 = *reinterpret_cast<const bf16x8*>((const char*)Ks + KSWZ(32 + r32, cb));
    p0 = __builtin_amdgcn_mfma_f32_32x32x16_bf16(b0, qr[d0], p0, 0, 0, 0);
    p1 = __builtin_amdgcn_mfma_f32_32x32x16_bf16(b1, qr[d0], p1, 0, 0, 0); }
}
__device__ __forceinline__ int v_st(int k, int c) { const int kk = (k & ~0xC) | ((k & 4) << 1) | ((k & 8) >> 1); return ((kk >> 3) * 4 + (c >> 5)) * 512 + ((kk & 7) * 32 + (c & 31)) * 2; }
__device__ __forceinline__ int v_rd_base(int lane) { return ((lane & 3) << 3) | (((lane >> 2) & 3) << 6) | (((lane >> 4) & 1) << 5) | (((lane >> 5) & 1) << 8); }
constexpr int v_rd_off(int d0, int ks, int half) { return d0 * 512 + ks * 4096 + half * 2048; }
template <int OFF> __device__ __forceinline__ s16x4 tr_read(int vb) {
  s16x4 r; asm volatile("ds_read_b64_tr_b16 %0, %1 offset:%2" : "=&v"(r) : "v"(vb), "i"(OFF) : "memory"); return r;
}
template <int D0> __device__ __forceinline__ void pv_one(f32x16& od, int vb, bf16x8 pa0, bf16x8 pa1, bf16x8 pa2, bf16x8 pa3) {
  const s16x4 l0 = tr_read<v_rd_off(D0, 0, 0)>(vb), h0 = tr_read<v_rd_off(D0, 0, 1)>(vb), l1 = tr_read<v_rd_off(D0, 1, 0)>(vb), h1 = tr_read<v_rd_off(D0, 1, 1)>(vb);
  const s16x4 l2 = tr_read<v_rd_off(D0, 2, 0)>(vb), h2 = tr_read<v_rd_off(D0, 2, 1)>(vb), l3 = tr_read<v_rd_off(D0, 3, 0)>(vb), h3 = tr_read<v_rd_off(D0, 3, 1)>(vb);
  asm volatile("s_waitcnt lgkmcnt(0)" ::: "memory"); SBAR();
#define PK(L, H) (bf16x8){L[0], L[1], L[2], L[3], H[0], H[1], H[2], H[3]}
  od = __builtin_amdgcn_mfma_f32_32x32x16_bf16(pa0, PK(l0, h0), od, 0, 0, 0);
  od = __builtin_amdgcn_mfma_f32_32x32x16_bf16(pa1, PK(l1, h1), od, 0, 0, 0);
  od = __builtin_amdgcn_mfma_f32_32x32x16_bf16(pa2, PK(l2, h2), od, 0, 0, 0);
  od = __builtin_amdgcn_mfma_f32_32x32x16_bf16(pa3, PK(l3, h3), od, 0, 0, 0);
#undef PK
}
__device__ __forceinline__ void pv_d0(f32x16* o, int vb, bf16x8 pa0, bf16x8 pa1, bf16x8 pa2, bf16x8 pa3) {
  pv_one<0>(o[0], vb, pa0, pa1, pa2, pa3); pv_one<1>(o[1], vb, pa0, pa1, pa2, pa3); pv_one<2>(o[2], vb, pa0, pa1, pa2, pa3); pv_one<3>(o[3], vb, pa0, pa1, pa2, pa3);
}
template <int LDQ, int LDK, int LDO>
__device__ __forceinline__ void attn_dense_body(const bf16* __restrict__ Qb, const bf16* __restrict__ Kh, const bf16* __restrict__ Vh, float* __restrict__ Ob, int seq, char* lds) {
  const int tid = threadIdx.x, wid = tid >> 6, lane = tid & 63, r32 = lane & 31, hi = lane >> 5;
  bf16* V_lds = (bf16*)lds; bf16* K_lds = (bf16*)(lds + 2 * SHM_V);
  float* ws = (float*)(lds + 2 * SHM_V + 2 * SHM_K) + wid * 64; float* li_l = ws; float* al_l = ws + 32;
  float m_reg = -1e30f, l_reg = 0; f32x16 o[4] = {}; bf16x8 qr[8];
  const bf16* Qw = Qb + (long)(wid * QBLK + r32) * LDQ + hi * 8;
#pragma unroll
  for (int d0 = 0; d0 < 8; ++d0) qr[d0] = ld8(Qw + d0 * 16);
  const int sr = tid >> 4, sc = (tid & 15) * 8, vst0 = v_st(sr, sc), vst1 = v_st(32 + sr, sc);
  const int vb0 = (int)(uintptr_t)V_lds + v_rd_base(lane);
  struct { bf16x8 vs0, vs1, ks0, ks1; } sr_[2];
#define SLOAD(i, k0) do { sr_[i].vs0 = ld8(&Vh[(long)((k0) + sr) * LDK + sc]); sr_[i].vs1 = ld8(&Vh[(long)((k0) + 32 + sr) * LDK + sc]); \
    sr_[i].ks0 = ld8(&Kh[(long)((k0) + sr) * LDK + sc]); sr_[i].ks1 = ld8(&Kh[(long)((k0) + 32 + sr) * LDK + sc]); } while (0)
#define SWRITE(b, i) do { *(bf16x8*)((char*)V_lds + (b) * SHM_V + vst0) = sr_[i].vs0;          \
    *(bf16x8*)((char*)V_lds + (b) * SHM_V + vst1) = sr_[i].vs1; int kc = sc * 2;               \
    *(bf16x8*)((char*)K_lds + (b) * SHM_K + KSWZ(sr, kc)) = sr_[i].ks0;                       \
    *(bf16x8*)((char*)K_lds + (b) * SHM_K + KSWZ(32 + sr, kc)) = sr_[i].ks1; } while (0)
#define SWAIT() asm volatile("s_waitcnt vmcnt(4)" ::: "memory")
#define RESC(a) do { if (__any((a) < 1.f)) { if (hi == 0) al_l[r32] = (a); asm volatile("s_waitcnt lgkmcnt(0)" ::: "memory"); \
    for (int d = 0; d < 4; ++d) for (int r = 0; r < 16; ++r) o[d][r] *= al_l[crow(r, hi)]; } } while (0)
  f32x16 pA0, pA1, pB0, pB1; float mnA, mnB, alA, alB; bf16x8 pa0, pa1, pa2, pa3; const int NT = seq / KVBLK;
  constexpr int SE = 0, SO = 1;
  SLOAD(SE, 0); asm volatile("s_waitcnt vmcnt(0)" ::: "memory"); SWRITE(0, SE); __syncthreads();
  qkt(pA0, pA1, K_lds, qr, r32, hi); partialSM(pA0, pA1, m_reg, mnA, alA);
  SLOAD(SO, KVBLK); if (2 < NT) SLOAD(SE, 2 * KVBLK);
  SWAIT(); SWRITE(1, SO); __syncthreads();
  for (int j = 1; j + 1 < NT; j += 2) {
    SBAR(); qkt(pB0, pB1, (bf16*)((char*)K_lds + SHM_K), qr, r32, hi);
    finishSM(pA0, pA1, alA, l_reg, pa0, pa1, pa2, pa3); SBAR();
    SLOAD(SO, (j + 2) * KVBLK); SBAR();
    pv_d0(o, vb0, pa0, pa1, pa2, pa3); partialSM(pB0, pB1, m_reg, mnB, alB);
    __syncthreads(); SWAIT(); SWRITE(0, SE);
    RESC(alB); __syncthreads();
    SBAR(); qkt(pA0, pA1, K_lds, qr, r32, hi);
    finishSM(pB0, pB1, alB, l_reg, pa0, pa1, pa2, pa3); SBAR();
    if (j + 3 < NT) SLOAD(SE, (j + 3) * KVBLK); SBAR();
    pv_d0(o, vb0 + (int)SHM_V, pa0, pa1, pa2, pa3); partialSM(pA0, pA1, m_reg, mnA, alA);
    __syncthreads(); SWAIT(); SWRITE(1, SO);
    RESC(alA); __syncthreads();
  }
  SBAR(); qkt(pB0, pB1, (bf16*)((char*)K_lds + SHM_K), qr, r32, hi);
  finishSM(pA0, pA1, alA, l_reg, pa0, pa1, pa2, pa3); SBAR();
  pv_d0(o, vb0, pa0, pa1, pa2, pa3); partialSM(pB0, pB1, m_reg, mnB, alB);
  __syncthreads(); RESC(alB);
  finishSM(pB0, pB1, alB, l_reg, pa0, pa1, pa2, pa3); SBAR();
  pv_d0(o, vb0 + (int)SHM_V, pa0, pa1, pa2, pa3);
  if (hi == 0) li_l[r32] = l_reg; asm volatile("s_waitcnt lgkmcnt(0)" ::: "memory");
  float rli[16];
#pragma unroll
  for (int r = 0; r < 16; ++r) rli[r] = __builtin_amdgcn_rcpf(li_l[crow(r, hi)]);
  float* Ow = Ob + (long)(wid * QBLK) * LDO;
#pragma unroll
  for (int r = 0; r < 16; ++r) { int orow = crow(r, hi);
    for (int d0 = 0; d0 < 4; ++d0) Ow[(long)orow * LDO + d0 * 32 + r32] = o[d0][r] * rli[r]; }
  __syncthreads();
#undef SLOAD
#undef SWRITE
#undef SWAIT
#undef RESC
}
#undef KSWZ
#undef SBAR
}

__device__ __forceinline__ void phase_attention(Frame& F, const bf16_t* QKV, float* O0, float* O1, char* lds) {
    for (int L = (int)blockIdx.x; L < 1088; L += F.G) {
        int b, h, comp, vh, qb, seq; long krow0, qrow0;
        if (L < 1024) { qb = L & 15; vh = (L >> 4) & 1; comp = (L >> 5) & 1; h = (L >> 6) & 7; b = L >> 9; seq = RB; krow0 = (long)b * RB; qrow0 = krow0 + qb * 256; }
        else { const int r = L - 1024; vh = r & 1; comp = (r >> 1) & 1; h = (r >> 2) & 7; b = r >> 5; seq = CTX; krow0 = (long)b * RB + SEQ; qrow0 = krow0; }
        const bf16_t* Q = QKV + qrow0 * 6144 + h * 256 + comp * 128;
        const bf16_t* K = QKV + krow0 * 6144 + 2048 + h * 256 + comp * 128;
        const bf16_t* V = QKV + krow0 * 6144 + 4096 + h * 256 + vh * 128;
        float* O = (comp ? O1 : O0) + qrow0 * 2048 + h * 256 + vh * 128;
        attn::attn_dense_body<6144, 6144, 2048>(Q, K, V, O, seq, lds);
    }
}
__device__ __forceinline__ void phase_diffcombine(Frame& F, const float* O0, const float* O1, const float* lamv, const float* g, bf16_t* OUT) {
    const int gw = F.vcu * NWAVES + F.wave, NGW = F.G * NWAVES, lane = F.lane;
    constexpr float LAM_INIT = 0.47071301834358414f;
    const float d0 = wave_sum(lamv[lane] * lamv[128 + lane] + lamv[64 + lane] * lamv[192 + lane]);
    const float d1 = wave_sum(lamv[256 + lane] * lamv[384 + lane] + lamv[320 + lane] * lamv[448 + lane]);
    const float lam = expf(d0) - expf(d1) + LAM_INIT;
    const f32x4 g4 = *(const f32x4*)(g + 4 * lane) * (1.f - LAM_INIT);
    for (int row = gw; row < M; row += NGW) {
#pragma unroll
        for (int h = 0; h < 8; ++h) {
            const f32x4 a = *(const f32x4*)(O0 + (size_t)row * D + h * 256 + 4 * lane), bq = *(const f32x4*)(O1 + (size_t)row * D + h * 256 + 4 * lane);
            const f32x4 o = a - bq * lam;
            const float ss = wave_sum((o.x * o.x + o.y * o.y) + (o.z * o.z + o.w * o.w));
            const float r = rsqrtf(ss * (1.f / 256.f) + 1e-6f);
            const f32x4 y = o * r * g4;
            u32x2 w; w.x = cvt_pk_bf16(y.x, y.y); w.y = cvt_pk_bf16(y.z, y.w);
            *(u32x2*)(OUT + (size_t)row * D + h * 256 + 4 * lane) = w;
        }
    }
}
enum { PH_PRO = 0, L0_MOD = 1, L0_CH = 2, L0_POS = 3, L0_OUT = 4, L0_FMOD = 5, L0_FIN = 6, L0_FOUT = 7,
       L1_MOD = 8, L1_IN = 9, L1_SP = 10, L1_OUT = 11, L1_FMOD = 12, L1_FIN = 13, L1_FOUT = 14,
       L2_MOD = 15, L2_QKV = 16, L2_ATT = 17, L2_CMB = 18, L2_OUT = 19, L2_FMOD = 20, L2_FIN = 21, L2_FOUT = 22,
       L3_MOD = 23, L3_IN = 24, L3_G1 = 25, L3_G2 = 26, L3_FSH = 27, L3_OUT = 28, L3_FMOD = 29, L3_FIN = 30, L3_FOUT = 31, PH_FINAL = 32, NPH = 33 };

__global__ void __launch_bounds__(NWAVES * 64, 2) mk_fwd(Args args) {
    extern __shared__ __attribute__((aligned(16))) unsigned char lds_raw[];
    Frame F;
    F.lds = (LAS unsigned char*)lds_raw; F.MISC = (volatile LAS unsigned*)(F.lds + MISC_OFF);
    F.tid = threadIdx.x; F.lane = F.tid & 63; F.wave = __builtin_amdgcn_readfirstlane(F.tid >> 6);
    F.G = gridDim.x; { const int bx = blockIdx.x; F.vcu = (F.G % 8 == 0) ? (bx % 8) * (F.G / 8) + bx / 8 : bx; }
    unsigned char* ws = args.ws; F.ctl = (unsigned*)(ws + WS_CTL);
    for (int u = F.tid; u < (LDS_BYTES - RING_BYTES) / 4; u += NWAVES * 64) ((LAS unsigned*)(F.lds + RING_BYTES))[u] = 0u;
    __syncthreads();
    const int lo = args.ph_lo, hi = args.ph_hi;
    XcdBarrier bar; bar.bar = F.ctl + args.li * XCD_BAR_WORDS; bar.x = 0; bar.st = F.MISC + 8;
    if (hi - lo > 1) bar = xcd_barrier_post(F.ctl + args.li * XCD_BAR_WORDS, F.MISC + 8);
#define IN(k) (lo <= (k) && (k) < hi)
#define SEAM(k) do { if (IN(k) && IN((k) + 1)) xcd_barrier(bar); } while (0)
    float* XR = (float*)(ws + WS_XR); const float* MOD = (const float*)(ws + WS_MOD);
    bf16_t* H = (bf16_t*)(ws + WS_H); bf16_t* BIG = (bf16_t*)(ws + WS_BIG);
    const int cu = (int)blockIdx.x;

    if (IN(PH_PRO)) { phase_prologue(F, args); SEAM(PH_PRO); }

#define FFN_PHASES(l, P_FMOD, P_FIN, P_FOUT, SKIPC) \
    if (IN(P_FMOD)) { const float* mod = MOD + (size_t)(l) * 3 * NMOD; phase_modulate(F, XR, args.in[7] + (l) * D, mod + 3 * D, mod + 4 * D, H, SKIPC); SEAM(P_FMOD); } \
    if (IN(P_FIN)) { pg8::Gemm g{H, (const bf16_t*)(ws + WS_WIN_T) + (size_t)(l) * DFF * D, D, D, D}; pg8::Sched2D S{(SKIPC) ? 32 : 34, DFF / 256, F.G, cu, D, D, SKIPC}; \
        pg8::EpiBf16<2> E{BIG, DFF, 1.f}; pg8::gemm_phase<pg8::EpiBf16<2>, pg8::Sched2D, true>(F.lds, g, S, E); SEAM(P_FIN); } \
    if (IN(P_FOUT)) { const float* mod = MOD + (size_t)(l) * 3 * NMOD; pg8::Gemm g{BIG, (const bf16_t*)(ws + WS_WOUT_T) + (size_t)(l) * DFF * D, DFF, DFF, DFF}; \
        pg8::Sched2D S{(SKIPC) ? 32 : 34, D / 256, F.G, cu, DFF, DFF, SKIPC}; pg8::EpiResid E{XR, mod + 5 * D}; \
        pg8::gemm_phase<pg8::EpiResid, pg8::Sched2D, true>(F.lds, g, S, E); SEAM(P_FOUT); }


    bf16_t* A2 = (bf16_t*)(ws + WS_A2);
    if (IN(L0_MOD)) { phase_modulate(F, XR, args.in[6] + 0 * D, MOD + 0 * D, MOD + 1 * D, H, false); SEAM(L0_MOD); }
    if (IN(L0_CH)) { pg8::Gemm g{(const bf16_t*)(ws + WS_TC), H, 512, D, 512}; pg8::SchedChan S{F.G, cu}; pg8::EpiChan E{BIG, BIG + (size_t)2 * 2048 * 8192};
        pg8::gemm_phase<pg8::EpiChan, pg8::SchedChan, true>(F.lds, g, S, E); SEAM(L0_CH); }
    if (IN(L0_POS)) {
        { pg8::Gemm g{(const bf16_t*)(ws + WS_PT), BIG, 8192, 8192, 8192}; pg8::SchedPosL S{F.G, cu}; pg8::EpiBf16<0> E{A2, D, 0.00069053396600248786f};
          pg8::gemm_phase<pg8::EpiBf16<0>, pg8::SchedPosL, true>(F.lds, g, S, E); }
        { pg8::Gemm g{(const bf16_t*)(ws + WS_PC), BIG + (size_t)2 * 2048 * 8192, 512, 512, 512}; pg8::SchedPosC S{F.G, cu}; pg8::EpiBf16<0> E{A2, D, 0.0027621358640099515f};
          pg8::gemm_phase<pg8::EpiBf16<0>, pg8::SchedPosC, true>(F.lds, g, S, E); }
        SEAM(L0_POS); }
    if (IN(L0_OUT)) { pg8::Gemm g{A2, (const bf16_t*)(ws + WS_FNO_T), D, D, D}; pg8::Sched2D S{34, D / 256, F.G, cu, D, D, 0}; pg8::EpiResid E{XR, MOD + 2 * D};
        pg8::gemm_phase<pg8::EpiResid, pg8::Sched2D, true>(F.lds, g, S, E); SEAM(L0_OUT); }
    FFN_PHASES(0, L0_FMOD, L0_FIN, L0_FOUT, 0)

    if (IN(L1_MOD)) { const float* mod = MOD + (size_t)1 * 3 * NMOD; phase_modulate(F, XR, args.in[6] + 1 * D, mod + 0 * D, mod + 1 * D, H, false); SEAM(L1_MOD); }
    if (IN(L1_IN)) { pg8::Gemm g{H, (const bf16_t*)(ws + WS_GMIN_T), D, D, D}; pg8::Sched2D S{34, 16, F.G, cu, D, D, 0}; pg8::EpiGeluStats<true> E{BIG, 4096, (float*)(ws + WS_LNS)};
        pg8::gemm_phase<pg8::EpiGeluStats<true>, pg8::Sched2D, true>(F.lds, g, S, E); SEAM(L1_IN); }
    if (IN(L1_SP)) { phase_spatial(F, BIG, (const float*)(ws + WS_LNS), args.in[13], args.in[14], (const bf16_t*)(ws + WS_GMWS), args.in[16], A2); SEAM(L1_SP); }
    if (IN(L1_OUT)) { const float* mod = MOD + (size_t)1 * 3 * NMOD; pg8::Gemm g{A2, (const bf16_t*)(ws + WS_GMOUT_T), D, D, D}; pg8::Sched2D S{34, D / 256, F.G, cu, D, D, 0}; pg8::EpiResid E{XR, mod + 2 * D};
        pg8::gemm_phase<pg8::EpiResid, pg8::Sched2D, true>(F.lds, g, S, E); SEAM(L1_OUT); }
    FFN_PHASES(1, L1_FMOD, L1_FIN, L1_FOUT, 0)

    float* F1 = (float*)(ws + WS_F1); float* F2 = (float*)(ws + WS_F2);
    if (IN(L2_MOD)) { const float* mod = MOD + (size_t)2 * 3 * NMOD; phase_modulate(F, XR, args.in[6] + 2 * D, mod + 0 * D, mod + 1 * D, H, false); SEAM(L2_MOD); }
    if (IN(L2_QKV)) { pg8::Gemm g{H, (const bf16_t*)(ws + WS_DFIN_T), D, D, D}; pg8::Sched2D S{34, 24, F.G, cu, D, D, 0}; pg8::EpiQKV E{BIG, (const float*)(ws + WS_ROPE)};
        pg8::gemm_phase<pg8::EpiQKV, pg8::Sched2D, true>(F.lds, g, S, E); SEAM(L2_QKV); }
    if (IN(L2_ATT)) { phase_attention(F, BIG, F1, F2, (char*)lds_raw); SEAM(L2_ATT); }
    if (IN(L2_CMB)) { phase_diffcombine(F, F1, F2, args.in[19], args.in[20], A2); SEAM(L2_CMB); }
    if (IN(L2_OUT)) { const float* mod = MOD + (size_t)2 * 3 * NMOD; pg8::Gemm g{A2, (const bf16_t*)(ws + WS_DFOUT_T), D, D, D}; pg8::Sched2D S{34, D / 256, F.G, cu, D, D, 0}; pg8::EpiResid E{XR, mod + 2 * D};
        pg8::gemm_phase<pg8::EpiResid, pg8::Sched2D, true>(F.lds, g, S, E); SEAM(L2_OUT); }
    FFN_PHASES(2, L2_FMOD, L2_FIN, L2_FOUT, 0)
    FFN_PHASES(3, L3_FMOD, L3_FIN, L3_FOUT, 1)

    if (IN(PH_FINAL)) { phase_final(F, XR, args.in[10], args.out); }
#undef IN
#undef SEAM
}
extern "C" void kernel_launch(void* const* d_in, const int* in_sizes, int n_in, void* d_out, int out_size, void* d_ws, size_t ws_size, hipStream_t st) {
    static int grid = 0;
    if (grid == 0) {
        int dev = 0, cus = 0;
        if (hipGetDevice(&dev) != hipSuccess || hipDeviceGetAttribute(&cus, hipDeviceAttributeMultiprocessorCount, dev) != hipSuccess) { fprintf(stderr, "device query failed\n"); grid = -1; return; }
        if (hipFuncSetAttribute((const void*)mk_fwd, hipFuncAttributeMaxDynamicSharedMemorySize, LDS_BYTES) != hipSuccess) { fprintf(stderr, "hipFuncSetAttribute failed\n"); grid = -1; return; }
        grid = cus;
    }
    if (grid < 0) return;
    const float* g_mix = (const float*)d_in[6];
    const float* fno_w = (const float*)d_in[11];
    const float* gm_win = (const float*)d_in[12]; const float* gm_lng = (const float*)d_in[13]; const float* gm_lnb = (const float*)d_in[14]; const float* gm_ws = (const float*)d_in[15]; const float* gm_bs = (const float*)d_in[16]; const float* gm_wout = (const float*)d_in[17];
    const float* df_win = (const float*)d_in[18]; const float* df_lam = (const float*)d_in[19]; const float* df_g = (const float*)d_in[20]; const float* df_wout = (const float*)d_in[21];
    const float* gl_win = (const float*)d_in[22]; const float* gl_wup = (const float*)d_in[23]; const float* gl_bg = (const float*)d_in[24]; const float* gl_g = (const float*)d_in[25]; const float* gl_wout = (const float*)d_in[26];
    unsigned char* wsb = (unsigned char*)d_ws;
    float* XR = (float*)(wsb + WS_XR); float* MOD = (float*)(wsb + WS_MOD);
    float* w = (float*)(wsb + WS_G1); size_t off = 0;
    auto take = [&](size_t n) { float* p = w + off; off += (n + 63) / 64 * 64; return p; };
    float* H = take((size_t)M * D); float* T1 = take((size_t)M * 6176); float* T2 = take((size_t)M * D); float* T3 = T2;
    float* T4 = take((size_t)M * D);
    float* SB = take((size_t)2 * SEQ * RB);
    if (WS_G1 + off * 4 > ws_size) { fprintf(stderr, "ws too small: need %zu have %zu\n", WS_G1 + off * 4, ws_size); return; }

    (void)hipMemsetAsync(wsb + WS_CTL, 0, CTL_ZERO_BYTES, st);
    Args a{};
    for (int i = 0; i < 27; ++i) a.in[i] = (const float*)d_in[i];
    a.out = (float*)d_out; a.ws = wsb;
    int li = 0;
    auto run = [&](int lo, int hi) { a.ph_lo = lo; a.ph_hi = hi; a.li = li++; hipLaunchKernelGGL(mk_fwd, dim3(grid), dim3(NWAVES * 64), LDS_BYTES, st, a); };

    run(PH_PRO, PH_PRO + 1);
    const long BS = (long)RB * D;
    const int fmod[4] = {L0_FMOD, L1_FMOD, L2_FMOD, L3_FMOD};

    for (int l = 0; l < 4; ++l) {
        const float* mod = MOD + (size_t)l * 3 * NMOD;
        if (l >= 3) hipLaunchKernelGGL(k_modulate, dim3(M), dim3(256), 0, st, XR, g_mix + l * D, mod + 0 * D, mod + 1 * D, H);
        if (l == 0) { run(L0_MOD, L0_MOD + 1); run(L0_CH, L0_CH + 1); run(L0_POS, L0_POS + 1); run(L0_OUT, L0_OUT + 1);
        } else if (l == 1) { run(L1_MOD, L1_MOD + 1); run(L1_IN, L1_IN + 1); run(L1_SP, L1_SP + 1); run(L1_OUT, L1_OUT + 1);
        } else if (l == 2) { run(L2_MOD, L2_MOD + 1); run(L2_QKV, L2_QKV + 1); run(L2_ATT, L2_ATT + 1); run(L2_CMB, L2_CMB + 1); run(L2_OUT, L2_OUT + 1);
        } else {
            float* P = T1; float* GG = T4; float* OD = SB; float* OA = T2;
            gemm<EpiStore, false>(st, H, D, 0, gl_win, 6176, 0, M, 6176, D, 1, EpiStore{P, 0, 6176, 1.f});
            hipLaunchKernelGGL(k_gates, dim3(M, 2), dim3(256), 0, st, P, gl_wup, gl_bg, GG);
            hipLaunchKernelGGL(k_gla_scan, dim3(16, 16), dim3(256), 0, st, P, GG, OD);
            (void)hipMemsetAsync(OA, 0, (size_t)M * D * 4, st);
            for (int b = 0; b < BATCH; ++b)
                hipLaunchKernelGGL(k_gla_finish, dim3(SEQ, 4), dim3(256), 0, st, OD + (long)b * RB * D, P + (long)b * RB * 6176, gl_g, OA + (long)b * RB * D);
            gemm<EpiResid, false>(st, OA, D, 0, gl_wout, D, 0, M, D, D, 1, EpiResid{XR, mod + 2 * D});
        }
        run(fmod[l], fmod[l] + 1); run(fmod[l] + 1, fmod[l] + 2); run(fmod[l] + 2, fmod[l] + 3);
    }
    run(PH_FINAL, PH_FINAL + 1);
}
```

```cpp
#include <hip/hip_runtime.h>
#include <math.h>
#include <stdio.h>
#include <stdint.h>
constexpr int D = 2048, BATCH = 2, SEQ = 4096, CTX = 256, RB = SEQ + CTX, M = BATCH * RB, DFF = 8192;
constexpr int NMOD = 6 * D;
#define LAS __attribute__((address_space(3)))
#define GAS __attribute__((address_space(1)))
typedef unsigned short bf16_t;
typedef short bf16x8 __attribute__((ext_vector_type(8)));
typedef float f32x4 __attribute__((ext_vector_type(4)));
typedef float f32x2 __attribute__((ext_vector_type(2)));
typedef float f32x16 __attribute__((ext_vector_type(16)));
typedef unsigned u32x4 __attribute__((ext_vector_type(4)));
typedef unsigned u32x2 __attribute__((ext_vector_type(2)));
typedef short s16x4 __attribute__((ext_vector_type(4)));

__device__ __forceinline__ unsigned cvt_pk_bf16(float lo, float hi) { unsigned r; asm volatile("v_cvt_pk_bf16_f32 %0, %1, %2" : "=v"(r) : "v"(lo), "v"(hi)); return r; }
__device__ __forceinline__ float bf2f(unsigned short h) { return __uint_as_float((unsigned)h << 16); }
__device__ __forceinline__ float bflo(unsigned w) { return __uint_as_float(w << 16); }
__device__ __forceinline__ float bfhi(unsigned w) { return __uint_as_float(w & 0xffff0000u); }
#define LDS_WAIT() asm volatile("s_waitcnt lgkmcnt(0)" ::: "memory")
#define VM_WAIT() asm volatile("s_waitcnt vmcnt(0)" ::: "memory")

__device__ __forceinline__ int mrow_of_tile(int pm) { const int b = pm >= 17 ? 1 : 0; const int t = pm - 17 * b; return t == 16 ? 2 : b; }

namespace pg8 {
constexpr int BM = 256, BK = 64, HALF = 128, HTB = HALF * BK * 2, STAGE_BYTES = 8 * HTB, NXCD = 8, WGM = 8;
__host__ __device__ __forceinline__ int lds_byte(int r, int c) { const int st = (r >> 4) * 2 + (c >> 5), rr = r & 15, cc = c & 31, ob = rr * 64 + cc * 2; return st * 1024 + (ob ^ (((ob >> 9) & 1) << 5)); }
__host__ __device__ __forceinline__ void stage_rc(int b, int& R, int& C) { const int st = b / 1024, sb = b % 1024, swz = sb ^ (((sb >> 9) & 1) << 5); R = (st >> 1) * 16 + swz / 64; C = (st & 1) * 32 + (swz % 64) / 2; }
__host__ __device__ __forceinline__ int perm32(int rho) { const int n = rho >> 4, i = rho & 15; return 8 * (i >> 2) + 4 * n + (i & 3); }

struct Unit { int pm, pn, z; size_t aoff, boff; };
struct Gemm { const bf16_t* A; const bf16_t* Bt; int lda, ldb, K; };

__device__ __forceinline__ bool static_tile(int i, int G, int c, int nM, int nN, int& pm, int& pn) {
    const int nwg = nM * nN; const long L = (long)i * G + c; if (L >= nwg) return false;
    int wgid = (int)L; { const int q = nwg / NXCD, r = nwg % NXCD, xcd = wgid % NXCD, off = wgid / NXCD; wgid = (xcd < r ? xcd * (q + 1) : r * (q + 1) + (xcd - r) * q) + off; }
    const int nig = WGM * nN, gid = wgid / nig, fm = gid * WGM, gsz = (nM - fm) < WGM ? (nM - fm) : WGM;
    pm = fm + ((wgid % nig) % gsz); pn = (wgid % nig) / gsz; return true;
}
struct Sched2D {
    int nM, nN, G, c, lda, ldb, skip_ctx;
    __device__ __forceinline__ bool next(int i, Unit& u) const {
        int pm, pn; if (!static_tile(i, G, c, nM, nN, pm, pn)) return false;
        if (skip_ctx) pm += (pm >= 16) ? 1 : 0;
        u.pm = pm; u.pn = pn; u.z = 0; u.aoff = (size_t)pm * BM * lda * 2; u.boff = (size_t)pn * BM * ldb * 2; return true;
    }
};

template <class Epi, class Sched, bool ALIGN_EPI>
__device__ __forceinline__ void gemm_phase(LAS unsigned char* lds, const Gemm g, const Sched& S, const Epi& E) {
    const int tid = threadIdx.x, wid = __builtin_amdgcn_readfirstlane(tid >> 6), lane = tid & 63, wr = wid >> 2, wc = wid & 3, fr = lane & 15, fq = lane >> 4;
    const int nt = g.K / BK;
    unsigned voffA[2], voffB[2];
#pragma unroll
    for (int i = 0; i < 2; ++i) { int R, C; stage_rc(tid * 16 + i * 8192, R, C); const int Rb = Epi::PERM ? ((R & ~31) + perm32(R & 31)) : R;
        voffA[i] = (unsigned)(R * g.lda + C) * 2u; voffB[i] = (unsigned)(Rb * g.ldb + C) * 2u; }
    const size_t kstep = (size_t)(BK * 2);
    const size_t hstepA = (size_t)HALF * g.lda * 2, hstepB = (size_t)HALF * g.ldb * 2;
    const unsigned ldsw = (unsigned)wid * 1024u;
    const int aoff = lds_byte(wr * 64 + fr, fq * 8), boff = lds_byte(wc * 32 + fr, fq * 8);
#define PG8_SA(b, h) (((b) * 2 + (h)) * HTB)
#define PG8_SB(b, h) ((4 + (b) * 2 + (h)) * HTB)
#define PG8_STAGE(bufoff, gbase, voff) do { _Pragma("unroll") for (int _i = 0; _i < 2; ++_i) \
        __builtin_amdgcn_global_load_lds((const unsigned*)((const char*)(gbase) + (voff)[_i]), (LAS unsigned*)(lds + (bufoff) + ldsw + _i * 8192), 16, 0, 0); } while (0)
#define PG8_LDA(dst, b, h) do { _Pragma("unroll") for (int m = 0; m < 4; ++m) _Pragma("unroll") for (int k = 0; k < 2; ++k) dst[m][k] = *(const LAS bf16x8*)(lds + PG8_SA(b, h) + aoff + m * 2048 + k * 1024); } while (0)
#define PG8_LDB(dst, b, h) do { _Pragma("unroll") for (int n = 0; n < 2; ++n) _Pragma("unroll") for (int k = 0; k < 2; ++k) dst[n][k] = *(const LAS bf16x8*)(lds + PG8_SB(b, h) + boff + n * 2048 + k * 1024); } while (0)
#define PG8_MMA(ai, bj, At, Bt) do { __builtin_amdgcn_s_setprio(1); _Pragma("unroll") for (int m = 0; m < 4; ++m) _Pragma("unroll") for (int n = 0; n < 2; ++n) _Pragma("unroll") for (int k = 0; k < 2; ++k) \
        acc[ai][bj][m][n] = __builtin_amdgcn_mfma_f32_16x16x32_bf16(Bt[n][k], At[m][k], acc[ai][bj][m][n], 0, 0, 0); __builtin_amdgcn_s_setprio(0); } while (0)
#define PG8_WAIT_V(n) asm volatile("s_waitcnt vmcnt(" #n ")" ::: "memory")
#define PG8_WAIT_L(n) asm volatile("s_waitcnt lgkmcnt(" #n ")" ::: "memory")
#define PG8_BAR __builtin_amdgcn_s_barrier()
#define PG8_SCHED __builtin_amdgcn_sched_barrier(0)
    Unit cur, nxt; int ui = 0;
    if (!S.next(0, cur)) return;
    f32x4 acc[2][2][4][2];
#pragma unroll
    for (int a = 0; a < 2; ++a)
#pragma unroll
        for (int b = 0; b < 2; ++b)
#pragma unroll
            for (int m = 0; m < 4; ++m)
#pragma unroll
                for (int n = 0; n < 2; ++n) acc[a][b][m][n] = (f32x4){0.f, 0.f, 0.f, 0.f};
    bf16x8 At[4][2], B0[2][2], B1[2][2];
    const char* cA = (const char*)g.A + cur.aoff; const char* cB = (const char*)g.Bt + cur.boff;
    PG8_STAGE(PG8_SB(0, 0), cB, voffB); PG8_STAGE(PG8_SB(0, 1), cB + hstepB, voffB); PG8_STAGE(PG8_SA(0, 0), cA, voffA); PG8_STAGE(PG8_SA(0, 1), cA + hstepA, voffA);
    if (wr == 1) PG8_BAR;
    PG8_WAIT_V(2); PG8_BAR;
    PG8_STAGE(PG8_SB(1, 0), cB + kstep, voffB); PG8_STAGE(PG8_SA(1, 0), cA + kstep, voffA); PG8_STAGE(PG8_SB(1, 1), cB + hstepB + kstep, voffB);
    PG8_WAIT_V(6); PG8_BAR;
    for (;;) {
        const bool has_next = S.next(ui + 1, nxt);
        const char* nA = has_next ? (const char*)g.A + nxt.aoff : cA; const char* nB = has_next ? (const char*)g.Bt + nxt.boff : cB;
        for (int t = 0; t < nt; t += 2) {
            const bool last = (t == nt - 2);
            const char* a1 = cA + (size_t)(t + 1) * kstep;
            const char* a2 = last ? nA : cA + (size_t)(t + 2) * kstep; const char* b2 = last ? nB : cB + (size_t)(t + 2) * kstep;
            const char* a3 = a2 + kstep; const char* b3 = b2 + kstep;
            PG8_LDB(B0, 0, 0); PG8_LDB(B1, 0, 1); PG8_SCHED; PG8_LDA(At, 0, 0); PG8_STAGE(PG8_SA(1, 1), a1 + hstepA, voffA);
            PG8_WAIT_V(8); PG8_WAIT_L(0); PG8_BAR; PG8_MMA(0, 0, At, B0); PG8_MMA(0, 1, At, B1); PG8_BAR; PG8_SCHED;
            PG8_LDA(At, 0, 1); PG8_STAGE(PG8_SB(0, 0), b2, voffB); PG8_STAGE(PG8_SB(0, 1), b2 + hstepB, voffB); PG8_STAGE(PG8_SA(0, 0), a2, voffA);
            PG8_WAIT_V(8); PG8_WAIT_L(0); PG8_BAR; PG8_MMA(1, 0, At, B0); PG8_MMA(1, 1, At, B1); PG8_BAR; PG8_SCHED;
            PG8_LDB(B0, 1, 0); PG8_LDB(B1, 1, 1); PG8_SCHED; PG8_LDA(At, 1, 0); PG8_STAGE(PG8_SA(0, 1), a2 + hstepA, voffA);
            PG8_WAIT_V(8); PG8_WAIT_L(0); PG8_BAR; PG8_MMA(0, 0, At, B0); PG8_MMA(0, 1, At, B1); PG8_BAR; PG8_SCHED;
            PG8_LDA(At, 1, 1); PG8_STAGE(PG8_SB(1, 0), b3, voffB); PG8_STAGE(PG8_SB(1, 1), b3 + hstepB, voffB); PG8_STAGE(PG8_SA(1, 0), a3, voffA);
            PG8_WAIT_V(8); PG8_WAIT_L(0); PG8_BAR; PG8_MMA(1, 0, At, B0); PG8_MMA(1, 1, At, B1); PG8_BAR; PG8_SCHED;
        }
        if constexpr (ALIGN_EPI) { if (wr == 0) PG8_BAR; }
        E(acc, cur, wr, wc, fr, fq);
        if (!has_next) break;
#pragma unroll
        for (int a = 0; a < 2; ++a)
#pragma unroll
            for (int b = 0; b < 2; ++b)
#pragma unroll
                for (int m = 0; m < 4; ++m)
#pragma unroll
                    for (int n = 0; n < 2; ++n) acc[a][b][m][n] = (f32x4){0.f, 0.f, 0.f, 0.f};
        cur = nxt; cA = nA; cB = nB; ++ui;
        if constexpr (ALIGN_EPI) { if (wr == 1) PG8_BAR; }
    }
    PG8_WAIT_V(0);
    if constexpr (!ALIGN_EPI) { if (wr == 0) PG8_BAR; }
    PG8_BAR;
#undef PG8_SA
#undef PG8_SB
#undef PG8_STAGE
#undef PG8_LDA
#undef PG8_LDB
#undef PG8_MMA
#undef PG8_WAIT_V
#undef PG8_WAIT_L
#undef PG8_BAR
#undef PG8_SCHED
}

__device__ __forceinline__ f32x2 gelu_pk(f32x2 v) {
    const f32x2 av = __builtin_elementwise_abs(v), d = av * 0.2316418882f + 1.0f;
    f32x2 t; t.x = __builtin_amdgcn_rcpf(d.x); t.y = __builtin_amdgcn_rcpf(d.y);
    f32x2 q = t * 0.5307027145f + (-0.7265760135f); q = q * t + 0.7107068705f; q = q * t + (-0.142248368f); q = q * t + 0.127414796f; q = q * t;
    const f32x2 s = (v * v) * (-0.72134752044f);
    f32x2 e; e.x = __builtin_amdgcn_exp2f(s.x); e.y = __builtin_amdgcn_exp2f(s.y);
    const f32x2 m = v * (q * e), r = v - m;
    f32x2 o; o.x = v.x < 0.f ? m.x : r.x; o.y = v.y < 0.f ? m.y : r.y; return o;
}
template <int ACT> struct EpiBf16 {
    static constexpr bool PERM = true;
    bf16_t* O; int ldc; float scale;
    __device__ __forceinline__ void operator()(const f32x4 (&acc)[2][2][4][2], const Unit& u, int wr, int wc, int fr, int fq) const {
        const int row0 = u.pm * BM + wr * 64 + fr, col0 = u.pn * BM + wc * 32 + 8 * fq;
#pragma unroll
        for (int ai = 0; ai < 2; ++ai)
#pragma unroll
            for (int m = 0; m < 4; ++m) { bf16_t* rowp = O + (size_t)(row0 + ai * HALF + m * 16) * ldc + col0;
#pragma unroll
                for (int bj = 0; bj < 2; ++bj) { f32x4 v0 = acc[ai][bj][m][0], v1 = acc[ai][bj][m][1];
                    if (ACT == 2) { v0 = __builtin_elementwise_max(v0, (f32x4){0.f, 0.f, 0.f, 0.f}); v1 = __builtin_elementwise_max(v1, (f32x4){0.f, 0.f, 0.f, 0.f}); v0 = v0 * v0; v1 = v1 * v1; }
                    else { v0 = v0 * scale; v1 = v1 * scale; }
                    u32x4 w; w.x = cvt_pk_bf16(v0[0], v0[1]); w.y = cvt_pk_bf16(v0[2], v0[3]); w.z = cvt_pk_bf16(v1[0], v1[1]); w.w = cvt_pk_bf16(v1[2], v1[3]);
                    *(u32x4*)(rowp + bj * HALF) = w; } }
    }
};
struct EpiResid {
    static constexpr bool PERM = false;
    float* X; const float* gate;
    __device__ __forceinline__ void operator()(const f32x4 (&acc)[2][2][4][2], const Unit& u, int wr, int wc, int fr, int fq) const {
        const int row0 = u.pm * BM + wr * 64 + fr, col0 = u.pn * BM + wc * 32 + 4 * fq;
        const float* gp = gate + (size_t)mrow_of_tile(u.pm) * NMOD + col0;
        f32x4 gv[2][2];
#pragma unroll
        for (int bj = 0; bj < 2; ++bj)
#pragma unroll
            for (int n = 0; n < 2; ++n) gv[bj][n] = *(const f32x4*)(gp + bj * HALF + n * 16);
#pragma unroll
        for (int ai = 0; ai < 2; ++ai)
#pragma unroll
            for (int m = 0; m < 4; ++m) { float* rowp = X + (size_t)(row0 + ai * HALF + m * 16) * D + col0;
#pragma unroll
                for (int bj = 0; bj < 2; ++bj)
#pragma unroll
                    for (int n = 0; n < 2; ++n) { f32x4* p = (f32x4*)(rowp + bj * HALF + n * 16); *p = *p + gv[bj][n] * acc[ai][bj][m][n]; } }
    }
};

template <bool STATS> struct EpiGeluStats {
    static constexpr bool PERM = true;
    bf16_t* O; int ldc; float* stats;
    __device__ __forceinline__ void operator()(const f32x4 (&acc)[2][2][4][2], const Unit& u, int wr, int wc, int fr, int fq) const {
        const int row0 = u.pm * BM + wr * 64 + fr, col0 = u.pn * BM + wc * 32 + 8 * fq;
        const bool st = STATS && (u.pn >= 8);
#pragma unroll
        for (int ai = 0; ai < 2; ++ai)
#pragma unroll
            for (int m = 0; m < 4; ++m) { const int row = row0 + ai * HALF + m * 16; bf16_t* rowp = O + (size_t)row * ldc + col0; float s = 0.f, q = 0.f;
#pragma unroll
                for (int bj = 0; bj < 2; ++bj) { f32x4 v0 = acc[ai][bj][m][0], v1 = acc[ai][bj][m][1];
                    f32x2 a = gelu_pk((f32x2){v0[0], v0[1]}), b = gelu_pk((f32x2){v0[2], v0[3]}), c = gelu_pk((f32x2){v1[0], v1[1]}), d = gelu_pk((f32x2){v1[2], v1[3]});
                    s += (a.x + a.y) + (b.x + b.y) + (c.x + c.y) + (d.x + d.y);
                    q += (a.x * a.x + a.y * a.y) + (b.x * b.x + b.y * b.y) + (c.x * c.x + c.y * c.y) + (d.x * d.x + d.y * d.y);
                    u32x4 w; w.x = cvt_pk_bf16(a.x, a.y); w.y = cvt_pk_bf16(b.x, b.y); w.z = cvt_pk_bf16(c.x, c.y); w.w = cvt_pk_bf16(d.x, d.y);
                    *(u32x4*)(rowp + bj * HALF) = w; }
                if (st) { s += __shfl_xor(s, 16); s += __shfl_xor(s, 32); q += __shfl_xor(q, 16); q += __shfl_xor(q, 32);
                    if (fq == 0) *(f32x2*)(stats + (((size_t)row * 8 + (u.pn - 8)) * 4 + wc) * 2) = (f32x2){s, q}; } }
    }
};
struct SchedChan {
    int G, c;
    __device__ __forceinline__ bool next(int i, Unit& u) const {
        const int L = i * G + c; if (L >= 544) return false;
        int b, g, pm, pn, ctx;
        if (L < 512) { ctx = 0; pn = L & 15; pm = (L >> 4) & 3; g = (L >> 6) & 3; b = L >> 8; }
        else { const int r = L - 512; ctx = 1; pn = 0; pm = r & 3; g = (r >> 2) & 3; b = r >> 4; }
        u.pm = pm; u.pn = pn; u.z = b | (g << 1) | (ctx << 3);
        u.aoff = (size_t)pm * BM * 512 * 2;
        u.boff = ((size_t)(b * RB + (ctx ? SEQ : pn * BM)) * D + g * 512) * 2;
        return true;
    }
};
struct EpiChan {
    static constexpr bool PERM = true;
    bf16_t* PB; bf16_t* PBc;
    __device__ __forceinline__ void operator()(const f32x4 (&acc)[2][2][4][2], const Unit& u, int wr, int wc, int fr, int fq) const {
        const int b = u.z & 1, g = (u.z >> 1) & 3, ctx = u.z >> 3;
        const int ldc = ctx ? 512 : 8192;
        bf16_t* base = (ctx ? PBc + (size_t)b * 2048 * 512 : PB + (size_t)b * 2048 * 8192) + (size_t)(g * 512 + (u.pm & 1) * 256) * ldc + (u.pm >> 1) * (ctx ? 256 : 4096) + u.pn * BM;
        const int row0 = wr * 64 + fr, col0 = wc * 32 + 8 * fq;
#pragma unroll
        for (int ai = 0; ai < 2; ++ai)
#pragma unroll
            for (int m = 0; m < 4; ++m) { bf16_t* rowp = base + (size_t)(row0 + ai * HALF + m * 16) * ldc + col0;
#pragma unroll
                for (int bj = 0; bj < 2; ++bj) { const f32x4 v0 = acc[ai][bj][m][0], v1 = acc[ai][bj][m][1];
                    u32x4 w; w.x = cvt_pk_bf16(v0[0], v0[1]); w.y = cvt_pk_bf16(v0[2], v0[3]); w.z = cvt_pk_bf16(v1[0], v1[1]); w.w = cvt_pk_bf16(v1[2], v1[3]);
                    *(u32x4*)(rowp + bj * HALF) = w; } }
    }
};
struct SchedPosL {
    int G, c;
    __device__ __forceinline__ bool next(int i, Unit& u) const {
        int pm, pn; if (!static_tile(i, G, c, 32, 8, pm, pn)) return false;
        const int b = pm >> 4; pm &= 15;
        u.pm = b * 17 + pm; u.pn = pn; u.z = b; u.aoff = (size_t)pm * BM * 8192 * 2; u.boff = ((size_t)b * 2048 + pn * BM) * 8192 * 2; return true;
    }
};
struct SchedPosC {
    int G, c;
    __device__ __forceinline__ bool next(int i, Unit& u) const {
        const int L = i * G + (G - 1 - c); if (L >= 16) return false;
        const int b = L >> 3, pn = L & 7;
        u.pm = b * 17 + 16; u.pn = pn; u.z = b; u.aoff = 0; u.boff = ((size_t)b * 2048 + pn * BM) * 512 * 2; return true;
    }
};

struct EpiQKV {
    static constexpr bool PERM = true;
    bf16_t* O; const float* rope;
    __device__ __forceinline__ void operator()(const f32x4 (&acc)[2][2][4][2], const Unit& u, int wr, int wc, int fr, int fq) const {
        const int rloc = wr * 64 + fr, col0 = u.pn * BM + wc * 32 + 8 * fq;
        const int mr = mrow_of_tile(u.pm); const bool dorope = (u.pn < 16) && (mr != 2);
        const int b = u.pm >= 17 ? 1 : 0, t0 = (u.pm - 17 * b) * BM; const int i0 = wc * 16 + 4 * fq;
#pragma unroll
        for (int ai = 0; ai < 2; ++ai)
#pragma unroll
            for (int m = 0; m < 4; ++m) { const int rl = rloc + ai * HALF + m * 16; bf16_t* rowp = O + (size_t)(u.pm * BM + rl) * 6144 + col0;
                f32x4 cs = {1.f, 1.f, 1.f, 1.f}, sn = {0.f, 0.f, 0.f, 0.f};
                if (dorope) { const int pos = t0 + rl; cs = *(const f32x4*)(rope + (size_t)pos * 64 + i0); sn = *(const f32x4*)(rope + (size_t)4096 * 64 + (size_t)pos * 64 + i0); }
#pragma unroll
                for (int bj = 0; bj < 2; ++bj) { const f32x4 v0 = acc[ai][bj][m][0], v1 = acc[ai][bj][m][1];
                    const float e0 = v0[0] * cs[0] - v0[1] * sn[0], o0 = v0[0] * sn[0] + v0[1] * cs[0];
                    const float e1 = v0[2] * cs[1] - v0[3] * sn[1], o1 = v0[2] * sn[1] + v0[3] * cs[1];
                    const float e2 = v1[0] * cs[2] - v1[1] * sn[2], o2 = v1[0] * sn[2] + v1[1] * cs[2];
                    const float e3 = v1[2] * cs[3] - v1[3] * sn[3], o3 = v1[2] * sn[3] + v1[3] * cs[3];
                    u32x4 w; w.x = cvt_pk_bf16(e0, o0); w.y = cvt_pk_bf16(e1, o1); w.z = cvt_pk_bf16(e2, o2); w.w = cvt_pk_bf16(e3, o3);
                    *(u32x4*)(rowp + bj * HALF) = w; } }
    }
};

struct EpiGla {
    static constexpr bool PERM = true;
    bf16_t* O; float* GD;
    __device__ __forceinline__ void operator()(const f32x4 (&acc)[2][2][4][2], const Unit& u, int wr, int wc, int fr, int fq) const {
        const int row0 = u.pm * BM + wr * 64 + fr, col0 = u.pn * BM + wc * 32 + 8 * fq;
        const bool gd = (u.pn == 24) && (wc == 0);
#pragma unroll
        for (int ai = 0; ai < 2; ++ai)
#pragma unroll
            for (int m = 0; m < 4; ++m) { const int row = row0 + ai * HALF + m * 16; bf16_t* rowp = O + (size_t)row * 6400 + col0;
#pragma unroll
                for (int bj = 0; bj < 2; ++bj) { const f32x4 v0 = acc[ai][bj][m][0], v1 = acc[ai][bj][m][1];
                    u32x4 w; w.x = cvt_pk_bf16(v0[0], v0[1]); w.y = cvt_pk_bf16(v0[2], v0[3]); w.z = cvt_pk_bf16(v1[0], v1[1]); w.w = cvt_pk_bf16(v1[2], v1[3]);
                    *(u32x4*)(rowp + bj * HALF) = w;
                    if (bj == 0 && gd) { *(f32x4*)(GD + (size_t)row * 32 + 8 * fq) = v0; *(f32x4*)(GD + (size_t)row * 32 + 8 * fq + 4) = v1; } } }
    }
};
}

#define XB_TMO      128
#define XB_XCNT(j)  (256  + 64 * (j))
#define XB_XSUB(j)  (1280 + 64 * (j))
#define XB_XGEN(j)  (2304 + 64 * (j))
#define XB_TOP      3328
#define XB_TOPGEN   3392
#define XCD_BAR_WORDS 3456
#define XB_SPIN_CAP (1u << 18)
__device__ __forceinline__ unsigned xb_ld(unsigned* p)              { return __hip_atomic_load(p, __ATOMIC_RELAXED, __HIP_MEMORY_SCOPE_AGENT); }
__device__ __forceinline__ unsigned xb_add(unsigned* p, unsigned v) { return __hip_atomic_fetch_add(p, v, __ATOMIC_RELAXED, __HIP_MEMORY_SCOPE_AGENT); }
__device__ __forceinline__ unsigned xb_xcc_id() { return (unsigned)__builtin_amdgcn_s_getreg((3 << 11) | 20) & 0xFu; }
#define XB_SPIN(cond, bar) do { unsigned _sp = 0; while (cond) { __builtin_amdgcn_s_sleep(1); \
    if ((++_sp & 255u) == 0u) { if (xb_ld(&(bar)[XB_TMO])) break; if (_sp > XB_SPIN_CAP) { atomicAdd(&(bar)[XB_TMO], 1u); break; } } } } while (0)
struct XcdBarrier { unsigned* bar; unsigned x; volatile LAS unsigned* st; };
__device__ __forceinline__ XcdBarrier xcd_barrier_post(unsigned* bar, volatile LAS unsigned* st) {
    XcdBarrier b; b.bar = bar; b.x = xb_xcc_id(); b.st = st;
    if (threadIdx.x == 0) (void)xb_add(&bar[XB_XCNT(b.x)], 1u);
    return b;
}
__device__ __forceinline__ void xcd_barrier_complete(unsigned* bar, unsigned x, unsigned& nloc, unsigned& nx) {
    const unsigned G = gridDim.x * gridDim.y * gridDim.z;
    unsigned sum, cnt, mine, sp = 0u;
    for (;;) {
        sum = 0u; cnt = 0u; mine = 0u;
#pragma unroll
        for (unsigned j = 0; j < 16; ++j) { const unsigned c = xb_ld(&bar[XB_XCNT(j)]); sum += c; cnt += (c > 0u) ? 1u : 0u; mine = (j == x) ? c : mine; }
        if (sum == G) break;
        __builtin_amdgcn_s_sleep(1);
        if ((++sp & 255u) == 0u) { if (xb_ld(&bar[XB_TMO])) break; if (sp > XB_SPIN_CAP) { atomicAdd(&bar[XB_TMO], 1u); break; } }
    }
    nloc = mine > 0u ? mine : 1u; nx = cnt > 0u ? cnt : 1u;
}
__device__ __forceinline__ void xcd_barrier(const XcdBarrier& b) {
    asm volatile("s_waitcnt vmcnt(0)" ::: "memory");
    __syncthreads();
    if (threadIdx.x == 0) {
        unsigned* bar = b.bar;
        __builtin_amdgcn_s_waitcnt(0);
        unsigned nloc = b.st[0], nx = b.st[1];
        if (nloc == 0u) { xcd_barrier_complete(bar, b.x, nloc, nx); b.st[0] = nloc; b.st[1] = nx; }
        const unsigned old = xb_add(&bar[XB_XSUB(b.x)], 1u);
        const unsigned gen = old / nloc;
        if (old + 1u == (gen + 1u) * nloc) {
            __builtin_amdgcn_fence(__ATOMIC_RELEASE, "agent");
            asm volatile("s_waitcnt vmcnt(0)" ::: "memory");
            const unsigned og = xb_add(&bar[XB_TOP], 1u);
            const unsigned tg = og / nx;
            if (og + 1u == (tg + 1u) * nx) xb_add(&bar[XB_TOPGEN], 1u);
            else XB_SPIN(xb_ld(&bar[XB_TOPGEN]) == tg, bar);
            __builtin_amdgcn_fence(__ATOMIC_ACQUIRE, "agent");
            xb_add(&bar[XB_XGEN(b.x)], 1u);
            asm volatile("s_waitcnt vmcnt(0)" ::: "memory");
        } else {
            XB_SPIN(xb_ld(&bar[XB_XGEN(b.x)]) == gen, bar);
            __builtin_amdgcn_fence(__ATOMIC_ACQUIRE, "agent");
            asm volatile("s_waitcnt vmcnt(0)" ::: "memory");
        }
    }
    __syncthreads();
}
constexpr size_t MiB = 1u << 20;
constexpr size_t WS_CTL = 0, CTL_ZERO_BYTES = 4 * MiB;
constexpr size_t WS_MOD = 1 * MiB;
constexpr size_t WS_WIN_T = 4 * MiB;
constexpr size_t WS_WOUT_T = WS_WIN_T + 128 * MiB;
constexpr size_t WS_FNO_T = WS_WOUT_T + 128 * MiB;
constexpr size_t WS_GMIN_T = WS_FNO_T + 8 * MiB;
constexpr size_t WS_GMOUT_T = WS_GMIN_T + 16 * MiB;
constexpr size_t WS_DFIN_T = WS_GMOUT_T + 8 * MiB;
constexpr size_t WS_DFOUT_T = WS_DFIN_T + 24 * MiB;
constexpr size_t WS_GLIN_T = WS_DFOUT_T + 8 * MiB;
constexpr size_t WS_GLOUT_T = WS_GLIN_T + 25 * MiB;
constexpr size_t WS_TC = WS_GLOUT_T + 8 * MiB;
constexpr size_t WS_PT = WS_TC + 1 * MiB;
constexpr size_t WS_PC = WS_PT + 64 * MiB;
constexpr size_t WS_ROPE = WS_PC + 1 * MiB;
constexpr size_t WS_GMWS = WS_ROPE + 2 * MiB;
constexpr size_t WS_XR = WS_GMWS + 1 * MiB;
constexpr size_t WS_H = WS_XR + 68 * MiB;
constexpr size_t WS_BIG = WS_H + 34 * MiB;
constexpr size_t WS_A2 = WS_BIG + 136 * MiB;
constexpr size_t WS_F1 = WS_A2 + 34 * MiB;
constexpr size_t WS_F2 = WS_F1 + 68 * MiB;
constexpr size_t WS_LNS = WS_F1;
constexpr size_t WS_G1 = WS_F2 + 68 * MiB;
constexpr size_t WS_NAIVE = WS_G1 + 128 * MiB;
constexpr size_t WS_END_MK = WS_NAIVE;

constexpr int NWAVES = 8;
constexpr int RING_BYTES = 131072, LDS_BYTES = 163840, MISC_OFF = LDS_BYTES - 1024;

struct Args { const float* in[27]; float* out; unsigned char* ws; int ph_lo, ph_hi, li, pad; };

struct Frame {
    LAS unsigned char* lds; volatile LAS unsigned* MISC; unsigned* ctl;
    int tid, lane, wave, vcu, G;
};
__device__ __forceinline__ float wave_sum(float v) {
#pragma unroll
    for (int o = 1; o < 64; o <<= 1) v += __shfl_xor(v, o);
    return v;
}
__device__ __forceinline__ unsigned f2bf(float f) { unsigned u = __float_as_uint(f); return (u + 0x7fffu + ((u >> 16) & 1u)) >> 16; }
__device__ __forceinline__ unsigned pk2(float lo, float hi) { return f2bf(lo) | (f2bf(hi) << 16); }

template <int MAP>
__device__ __forceinline__ void transpose_item(const float* W, int K, int N, bf16_t* WT, int ldt, LAS float* scr, int item, int lane) {
    const int nblk = N / 32, kb = item / nblk, nb = item % nblk, k0 = 64 * kb, n0 = 32 * nb;
#pragma unroll 8
    for (int i = 0; i < 32; ++i) { const int kk = 2 * i + (lane >> 5); scr[kk * 33 + (lane & 31)] = W[(size_t)(k0 + kk) * N + n0 + (lane & 31)]; }
    LDS_WAIT(); asm volatile("" ::: "memory");
    const int c = lane & 7;
#pragma unroll
    for (int j = 0; j < 4; ++j) { const int n = (lane >> 3) + 8 * j; const LAS float* s = scr + (8 * c) * 33 + n;
        u32x4 o; o.x = pk2(s[0 * 33], s[1 * 33]); o.y = pk2(s[2 * 33], s[3 * 33]); o.z = pk2(s[4 * 33], s[5 * 33]); o.w = pk2(s[6 * 33], s[7 * 33]);
        int nn = n0 + n;
        if (MAP == 1) { if (nn < 4096) { const int blk = nn >> 7, w = nn & 127, sgn = w >> 6, i2 = w & 63; nn = blk * 128 + 2 * i2 + sgn; } }
        *(u32x4*)(WT + (size_t)nn * ldt + k0 + 8 * c) = o; }
    LDS_WAIT(); asm volatile("" ::: "memory");
}
template <int MAP>
__device__ __forceinline__ void transpose_all(Frame& F, const float* W, int K, int N, bf16_t* WT) {
    LAS float* scr = (LAS float*)(F.lds + F.wave * 16384);
    const int gw = F.vcu * NWAVES + F.wave, NGW = F.G * NWAVES, nitems = (K / 64) * (N / 32);
    for (int it = gw; it < nitems; it += NGW) transpose_item<MAP>(W, K, N, WT, K, scr, it, F.lane);
}

__device__ __forceinline__ void phase_prologue(Frame& F, const Args& a) {
    unsigned char* ws = a.ws;
    const int gw = F.vcu * NWAVES + F.wave, NGW = F.G * NWAVES, lane = F.lane;
    {
        float* XR = (float*)(ws + WS_XR);
        for (int row = gw; row < M; row += NGW) {
            const int b = row >= RB ? 1 : 0, t = row - b * RB;
            const float* src = t < SEQ ? a.in[0] + (size_t)(b * SEQ + t) * D : a.in[2] + (size_t)(b * CTX + (t - SEQ)) * D;
            const f32x4* s4 = (const f32x4*)src + lane; f32x4* d4 = (f32x4*)(XR + (size_t)row * D) + lane;
#pragma unroll
            for (int j = 0; j < 8; ++j) d4[64 * j] = s4[64 * j];
        }
    }
    if (F.vcu < 192) {
        float* MOD = (float*)(ws + WS_MOD);
        const float* c = a.in[1]; const float* cc = a.in[3]; const float* wa = a.in[4]; const float* ba = a.in[5];
        const int l = F.vcu / 48, jg = F.vcu % 48, col = jg * 256 + 4 * lane, w = F.wave;
        const float* wp = wa + ((size_t)l * D + w * 256) * NMOD + col;
        f32x4 a0 = {0.f, 0.f, 0.f, 0.f}, a1 = a0, a2 = a0;
#pragma unroll 8
        for (int k = 0; k < 256; ++k) {
            const f32x4 wv = *(const f32x4*)(wp + (size_t)k * NMOD);
            const int kk = w * 256 + k;
            float c0 = c[kk], c1 = c[D + kk], c2 = cc[kk];
            c0 = c0 / (1.f + __expf(-c0)); c1 = c1 / (1.f + __expf(-c1)); c2 = c2 / (1.f + __expf(-c2));
            a0 = a0 + wv * c0; a1 = a1 + wv * c1; a2 = a2 + wv * c2;
        }
        LAS float* part = (LAS float*)F.lds;
        *(LAS f32x4*)(part + (w * 3 + 0) * 256 + 4 * lane) = a0; *(LAS f32x4*)(part + (w * 3 + 1) * 256 + 4 * lane) = a1; *(LAS f32x4*)(part + (w * 3 + 2) * 256 + 4 * lane) = a2;
        __syncthreads();
        for (int i = F.tid; i < 768; i += NWAVES * 64) { const int r = i >> 8, cj = i & 255; float sacc = ba[(size_t)l * NMOD + jg * 256 + cj];
#pragma unroll
            for (int ww = 0; ww < 8; ++ww) sacc += part[(ww * 3 + r) * 256 + cj];
            MOD[((size_t)l * 3 + r) * NMOD + jg * 256 + cj] = sacc; }
        __syncthreads();
    }
    for (int l = 0; l < 4; ++l) {
        transpose_all<0>(F, a.in[8] + (size_t)l * D * DFF, D, DFF, (bf16_t*)(ws + WS_WIN_T) + (size_t)l * DFF * D);
        transpose_all<0>(F, a.in[9] + (size_t)l * DFF * D, DFF, D, (bf16_t*)(ws + WS_WOUT_T) + (size_t)l * DFF * D);
    }
    transpose_all<0>(F, a.in[11], D, D, (bf16_t*)(ws + WS_FNO_T));
    transpose_all<0>(F, a.in[12], D, 4096, (bf16_t*)(ws + WS_GMIN_T));
    transpose_all<0>(F, a.in[17], D, D, (bf16_t*)(ws + WS_GMOUT_T));
    transpose_all<1>(F, a.in[18], D, 6144, (bf16_t*)(ws + WS_DFIN_T));
    transpose_all<0>(F, a.in[21], D, D, (bf16_t*)(ws + WS_DFOUT_T));
    transpose_all<0>(F, a.in[22], D, 6176, (bf16_t*)(ws + WS_GLIN_T));
    transpose_all<0>(F, a.in[26], D, D, (bf16_t*)(ws + WS_GLOUT_T));
    {
        u32x4* z = (u32x4*)((bf16_t*)(ws + WS_GLIN_T) + (size_t)6176 * D);
        const int n16 = 224 * D * 2 / 16;
        for (int i = gw * 64 + lane; i < n16; i += NGW * 64) z[i] = (u32x4){0u, 0u, 0u, 0u};
    }
    {
        bf16_t* TC = (bf16_t*)(ws + WS_TC); bf16_t* PT = (bf16_t*)(ws + WS_PT); bf16_t* PC = (bf16_t*)(ws + WS_PC);
        const int gt = gw * 64 + lane, NT = NGW * 64;
        for (int i = gt; i < 4096 * 8192 / 8; i += NT) {
            const int k = i >> 10, j0 = (i & 1023) * 8; const bool isn = j0 >= 4096; const int n0 = j0 & 4095; unsigned w[4];
#pragma unroll
            for (int e = 0; e < 8; e += 2) { float s0, c0, s1, c1; sincospif((float)((k * (n0 + e)) & 4095) * (1.f / 2048.f), &s0, &c0); sincospif((float)((k * (n0 + e + 1)) & 4095) * (1.f / 2048.f), &s1, &c1);
                w[e >> 1] = isn ? pk2(-s0, -s1) : pk2(c0, c1); }
            *(u32x4*)(PT + (size_t)k * 8192 + j0) = (u32x4){w[0], w[1], w[2], w[3]};
        }
        for (int i = gt; i < 1024 * 512 / 8; i += NT) {
            const int r = i >> 6, c0 = (i & 63) * 8; const bool isn = r >= 512; const int rr = r & 511; unsigned w[4];
#pragma unroll
            for (int e = 0; e < 8; e += 2) { float s0, cc0, s1, cc1; sincospif((float)((rr * (c0 + e)) & 511) * (1.f / 256.f), &s0, &cc0); sincospif((float)((rr * (c0 + e + 1)) & 511) * (1.f / 256.f), &s1, &cc1);
                w[e >> 1] = isn ? pk2(s0, s1) : pk2(cc0, cc1); }
            *(u32x4*)(TC + (size_t)r * 512 + c0) = (u32x4){w[0], w[1], w[2], w[3]};
        }
        for (int i = gt; i < 256 * 512 / 8; i += NT) {
            const int k = i >> 6, j0 = (i & 63) * 8; const bool isn = j0 >= 256; const int n0 = j0 & 255; unsigned w[4];
#pragma unroll
            for (int e = 0; e < 8; e += 2) { float s0, c0, s1, c1; sincospif((float)((k * (n0 + e)) & 255) * (1.f / 128.f), &s0, &c0); sincospif((float)((k * (n0 + e + 1)) & 255) * (1.f / 128.f), &s1, &c1);
                w[e >> 1] = isn ? pk2(-s0, -s1) : pk2(c0, c1); }
            *(u32x4*)(PC + (size_t)k * 512 + j0) = (u32x4){w[0], w[1], w[2], w[3]};
        }
        {
            float* rc = (float*)(ws + WS_ROPE); float* rs = rc + 4096 * 64;
            for (int i = gt; i < 4096 * 64; i += NT) { const int pos = i >> 6, j = i & 63; const float inv = powf(10000.f, -(float)(j & 31) * (1.f / 32.f));
                const float ang = (float)(j < 32 ? (pos >> 6) : (pos & 63)) * inv; float sn, cs; sincosf(ang, &sn, &cs); rc[i] = cs; rs[i] = sn; }
        }
        const float* wsf = a.in[15]; bf16_t* wsb = (bf16_t*)(ws + WS_GMWS);
        for (int i = gt; i < 16 * 128 * 128 / 8; i += NT) { const f32x4 x0 = *(const f32x4*)(wsf + (size_t)i * 8), x1 = *(const f32x4*)(wsf + (size_t)i * 8 + 4);
            *(u32x4*)(wsb + (size_t)i * 8) = (u32x4){pk2(x0.x, x0.y), pk2(x0.z, x0.w), pk2(x1.x, x1.y), pk2(x1.z, x1.w)}; }
    }
}

__device__ __forceinline__ void phase_modulate(Frame& F, const float* X, const float* g, const float* shift, const float* scale, bf16_t* H, bool skip_ctx) {
    const int gw = F.vcu * NWAVES + F.wave, NGW = F.G * NWAVES, lane = F.lane;
    for (int row = gw; row < M; row += NGW) {
        const int mr = mrow_of_tile(row >> 8);
        if (skip_ctx && mr == 2) continue;
        const f32x4* xr = (const f32x4*)(X + (size_t)row * D) + lane;
        f32x4 v[8]; float s = 0.f;
#pragma unroll
        for (int j = 0; j < 8; ++j) { v[j] = xr[64 * j]; s += (v[j].x * v[j].x + v[j].y * v[j].y) + (v[j].z * v[j].z + v[j].w * v[j].w); }
        const float r = rsqrtf(wave_sum(s) * (1.f / D) + 1e-6f);
        const f32x4* g4 = (const f32x4*)g + lane; const f32x4* sc4 = (const f32x4*)(scale + (size_t)mr * NMOD) + lane; const f32x4* sh4 = (const f32x4*)(shift + (size_t)mr * NMOD) + lane;
        u32x2* o8 = (u32x2*)(H + (size_t)row * D) + lane;
#pragma unroll
        for (int j = 0; j < 8; ++j) { const f32x4 o = v[j] * r * g4[64 * j] * (sc4[64 * j] + 1.f) + sh4[64 * j];
            u32x2 w; w.x = cvt_pk_bf16(o.x, o.y); w.y = cvt_pk_bf16(o.z, o.w); o8[64 * j] = w; }
    }
}
__device__ __forceinline__ void phase_final(Frame& F, const float* X, const float* g, float* out) {
    const int gw = F.vcu * NWAVES + F.wave, NGW = F.G * NWAVES, lane = F.lane;
    for (int orow = gw; orow < BATCH * SEQ; orow += NGW) {
        const int b = orow >> 12, t = orow & 4095;
        const f32x4* xr = (const f32x4*)(X + (size_t)(b * RB + t) * D) + lane;
        f32x4 v[8]; float s = 0.f;
#pragma unroll
        for (int j = 0; j < 8; ++j) { v[j] = xr[64 * j]; s += (v[j].x * v[j].x + v[j].y * v[j].y) + (v[j].z * v[j].z + v[j].w * v[j].w); }
        const float r = rsqrtf(wave_sum(s) * (1.f / D) + 1e-6f);
        const f32x4* g4 = (const f32x4*)g + lane; f32x4* o4 = (f32x4*)(out + (size_t)orow * D) + lane;
#pragma unroll
        for (int j = 0; j < 8; ++j) o4[64 * j] = v[j] * r * g4[64 * j];
    }
}

__device__ __forceinline__ void phase_spatial(Frame& F, const bf16_t* Z, const float* LNS, const float* ln_g, const float* ln_b, const bf16_t* WsB, const float* b_s, bf16_t* OUT) {
    LAS bf16_t* VT = (LAS bf16_t*)(F.lds); LAS float* S = (LAS float*)(F.lds + 36864); LAS float* ST = (LAS float*)(F.lds + 104448);
    const int tid = F.tid, lane = F.lane, w = F.wave, l32 = lane & 31, hi = lane >> 5;
    for (int unit = F.vcu; unit < 68 * 16; unit += F.G) {
        const int chunk = unit >> 4, h = unit & 15; const int row0 = chunk * 128;
        if (tid < 128) { float sm = 0.f, sq = 0.f; const f32x2* pp = (const f32x2*)(LNS + (size_t)(row0 + tid) * 64);
#pragma unroll
            for (int j = 0; j < 32; ++j) { const f32x2 t = pp[j]; sm += t.x; sq += t.y; }
            const float mu = sm * (1.f / 2048.f); const float var = sq * (1.f / 2048.f) - mu * mu;
            ST[tid * 2] = mu; ST[tid * 2 + 1] = rsqrtf(fmaxf(var, 0.f) + 1e-5f); }
        __syncthreads();
#pragma unroll
        for (int i = 0; i < 4; ++i) { const int idx = tid + 512 * i, q = idx >> 4, e8 = (idx & 15) * 8;
            const u32x4 raw = *(const u32x4*)(Z + (size_t)(row0 + q) * 4096 + 2048 + h * 128 + e8);
            const float mu = ST[q * 2], rs = ST[q * 2 + 1];
            const f32x4 g0 = *(const f32x4*)(ln_g + h * 128 + e8), g1 = *(const f32x4*)(ln_g + h * 128 + e8 + 4), b0 = *(const f32x4*)(ln_b + h * 128 + e8), b1 = *(const f32x4*)(ln_b + h * 128 + e8 + 4);
            float v[8] = {bflo(raw.x), bfhi(raw.x), bflo(raw.y), bfhi(raw.y), bflo(raw.z), bfhi(raw.z), bflo(raw.w), bfhi(raw.w)};
            const float gg[8] = {g0.x, g0.y, g0.z, g0.w, g1.x, g1.y, g1.z, g1.w}, bb[8] = {b0.x, b0.y, b0.z, b0.w, b1.x, b1.y, b1.z, b1.w};
#pragma unroll
            for (int j = 0; j < 8; ++j) { const float o = (v[j] - mu) * rs * gg[j] + bb[j]; VT[(e8 + j) * 136 + q] = (bf16_t)f2bf(o); } }
        __syncthreads();
        const int pt = w >> 1, et0 = (w & 1) * 2;
        f32x16 acc0 = {}, acc1 = {};
        const bf16_t* Ap = WsB + ((size_t)h * 128 + pt * 32 + l32) * 128 + hi * 8;
#pragma unroll
        for (int ks = 0; ks < 8; ++ks) {
            const bf16x8 af = *(const bf16x8*)(Ap + ks * 16);
            const bf16x8 b0 = *(const LAS bf16x8*)(VT + (et0 * 32 + l32) * 136 + ks * 16 + hi * 8);
            const bf16x8 b1 = *(const LAS bf16x8*)(VT + ((et0 + 1) * 32 + l32) * 136 + ks * 16 + hi * 8);
            acc0 = __builtin_amdgcn_mfma_f32_32x32x16_bf16(af, b0, acc0, 0, 0, 0);
            acc1 = __builtin_amdgcn_mfma_f32_32x32x16_bf16(af, b1, acc1, 0, 0, 0);
        }
#pragma unroll
        for (int r = 0; r < 16; ++r) { const int p = pt * 32 + (r & 3) + 8 * (r >> 2) + 4 * hi; const float bs = b_s[h * 128 + p];
            S[p * 132 + et0 * 32 + l32] = acc0[r] + bs; S[p * 132 + (et0 + 1) * 32 + l32] = acc1[r] + bs; }
        __syncthreads();
#pragma unroll
        for (int i = 0; i < 4; ++i) { const int idx = tid + 512 * i, p = idx >> 4, e8 = (idx & 15) * 8;
            const u32x4 raw = *(const u32x4*)(Z + (size_t)(row0 + p) * 4096 + h * 128 + e8);
            const LAS float* sp = S + p * 132 + e8;
            u32x4 o; o.x = cvt_pk_bf16(bflo(raw.x) * sp[0], bfhi(raw.x) * sp[1]); o.y = cvt_pk_bf16(bflo(raw.y) * sp[2], bfhi(raw.y) * sp[3]);
            o.z = cvt_pk_bf16(bflo(raw.z) * sp[4], bfhi(raw.z) * sp[5]); o.w = cvt_pk_bf16(bflo(raw.w) * sp[6], bfhi(raw.w) * sp[7]);
            *(u32x4*)(OUT + (size_t)(row0 + p) * D + h * 128 + e8) = o; }
        __syncthreads();
    }
}

__device__ __forceinline__ void phase_lnstats(Frame& F, const bf16_t* Z, float* LNS) {
    const int gw = F.vcu * NWAVES + F.wave, NGW = F.G * NWAVES, lane = F.lane;
    for (int row = gw; row < M; row += NGW) {
        const u32x4* zr = (const u32x4*)(Z + (size_t)row * 4096 + 2048) + lane; float s = 0.f, q = 0.f;
#pragma unroll
        for (int j = 0; j < 4; ++j) { const u32x4 r = zr[64 * j]; const float v[8] = {bflo(r.x), bfhi(r.x), bflo(r.y), bfhi(r.y), bflo(r.z), bfhi(r.z), bflo(r.w), bfhi(r.w)};
#pragma unroll
            for (int e = 0; e < 8; ++e) { s += v[e]; q += v[e] * v[e]; } }
        s = wave_sum(s); q = wave_sum(q);
        if (lane < 32) *(f32x2*)(LNS + (size_t)row * 64 + lane * 2) = lane == 0 ? (f32x2){s, q} : (f32x2){0.f, 0.f};
    }
}
namespace attn {
using bf16 = unsigned short;
using f32x8  = __attribute__((ext_vector_type(8))) float;
constexpr int D_ = 128, NW = 8, QBLK = 32, KVBLK = 64;
constexpr float SCALE = 0.088388347648318440f;
constexpr float THR = 8.f;
constexpr size_t SHM_V = KVBLK * D_ * 2, SHM_K = KVBLK * D_ * 2, SHM_ATTN = 2 * SHM_V + 2 * SHM_K + NW * 64 * 4;
#define KSWZ(row, colB) ((row) * 256 + ((colB) ^ (((row) & 7) << 4)))
#define SBAR() __builtin_amdgcn_sched_barrier(0)
__device__ __forceinline__ int crow(int r, int hi) { return (r & 3) + 8 * (r >> 2) + 4 * hi; }
__device__ __forceinline__ unsigned cvtpk(float lo, float hi) { unsigned r; asm volatile("v_cvt_pk_bf16_f32 %0, %1, %2" : "=v"(r) : "v"(lo), "v"(hi)); return r; }
__device__ __forceinline__ bf16x8 ld8(const bf16* p) { return *reinterpret_cast<const bf16x8*>(p); }

__device__ __forceinline__ void partialSM(f32x16& p0, f32x16& p1, float& m_reg, float& mn, float& alpha) {
  constexpr float C = SCALE * 1.4426950408889634f;
  float pmax = p0[0]; for (int r = 1; r < 16; ++r) pmax = fmaxf(pmax, p0[r]); for (int r = 0; r < 16; ++r) pmax = fmaxf(pmax, p1[r]);
  { auto rr = __builtin_amdgcn_permlane32_swap(__float_as_uint(pmax), __float_as_uint(pmax), false, false);
    pmax = fmaxf(__uint_as_float(rr[0]), __uint_as_float(rr[1])); }
  if (__builtin_expect(__all(pmax - m_reg <= THR / SCALE), 1)) { mn = m_reg; alpha = 1.f; }
  else { mn = fmaxf(m_reg, pmax); alpha = __builtin_amdgcn_exp2f((m_reg - mn) * C); m_reg = mn; }
  float mnC = -mn * C;
  for (int r = 0; r < 16; ++r) p0[r] = fmaf(p0[r], C, mnC); for (int r = 0; r < 16; ++r) p1[r] = fmaf(p1[r], C, mnC);
  for (int r = 0; r < 16; ++r) p0[r] = __builtin_amdgcn_exp2f(p0[r]);
}
__device__ __forceinline__ void finishSM(f32x16& p0, f32x16& p1, float alpha, float& l_reg, bf16x8& pa0, bf16x8& pa1, bf16x8& pa2, bf16x8& pa3) {
  for (int r = 0; r < 16; ++r) p1[r] = __builtin_amdgcn_exp2f(p1[r]);
  float ps = 0; for (int r = 0; r < 16; ++r) ps += p0[r]; for (int r = 0; r < 16; ++r) ps += p1[r];
  { auto rr = __builtin_amdgcn_permlane32_swap(__float_as_uint(ps), __float_as_uint(ps), false, false);
    ps = __uint_as_float(rr[0]) + __uint_as_float(rr[1]); }
  l_reg = l_reg * alpha + ps;
#define PK4(P, BASE, OUT) do { unsigned a0 = cvtpk(P[BASE + 0], P[BASE + 1]), a1 = cvtpk(P[BASE + 2], P[BASE + 3]);   \
    unsigned b0 = cvtpk(P[BASE + 4], P[BASE + 5]), b1 = cvtpk(P[BASE + 6], P[BASE + 7]);                              \
    auto r0 = __builtin_amdgcn_permlane32_swap(a0, b0, false, false); auto r1 = __builtin_amdgcn_permlane32_swap(a1, b1, false, false); \
    u32x4 w = {r0[0], r1[0], r0[1], r1[1]}; OUT = *reinterpret_cast<bf16x8*>(&w); } while (0)
  PK4(p0, 0, pa0); PK4(p0, 8, pa1); PK4(p1, 0, pa2); PK4(p1, 8, pa3);
#undef PK4
}
__device__ __forceinline__ void qkt(f32x16& p0, f32x16& p1, const bf16* Ks, const bf16x8* qr, int r32, int hi) {
  p0 = f32x16{}; p1 = f32x16{};
  for (int d0 = 0; d0 < 8; ++d0) { int cb = (d0 * 16 + hi * 8) * 2;
    bf16x8 b0 = *reinterpret_cast<const bf16x8*>((const char*)Ks + KSWZ(r32, cb));
    bf16x8 b1 = *reinterpret_cast<const bf16x8*>((const char*)Ks + KSWZ(32 + r32, cb));
    p0 = __builtin_amdgcn_mfma_f32_32x32x16_bf16(b0, qr[d0], p0, 0, 0, 0);
    p1 = __builtin_amdgcn_mfma_f32_32x32x16_bf16(b1, qr[d0], p1, 0, 0, 0); }
}
__device__ __forceinline__ int v_st(int k, int c) { const int kk = (k & ~0xC) | ((k & 4) << 1) | ((k & 8) >> 1); return ((kk >> 3) * 4 + (c >> 5)) * 512 + ((kk & 7) * 32 + (c & 31)) * 2; }
__device__ __forceinline__ int v_rd_base(int lane) { return ((lane & 3) << 3) | (((lane >> 2) & 3) << 6) | (((lane >> 4) & 1) << 5) | (((lane >> 5) & 1) << 8); }
constexpr int v_rd_off(int d0, int ks, int half) { return d0 * 512 + ks * 4096 + half * 2048; }
template <int OFF> __device__ __forceinline__ s16x4 tr_read(int vb) {
  s16x4 r; asm volatile("ds_read_b64_tr_b16 %0, %1 offset:%2" : "=&v"(r) : "v"(vb), "i"(OFF) : "memory"); return r;
}
template <int D0> __device__ __forceinline__ void pv_one(f32x16& od, int vb, bf16x8 pa0, bf16x8 pa1, bf16x8 pa2, bf16x8 pa3) {
  const s16x4 l0 = tr_read<v_rd_off(D0, 0, 0)>(vb), h0 = tr_read<v_rd_off(D0, 0, 1)>(vb), l1 = tr_read<v_rd_off(D0, 1, 0)>(vb), h1 = tr_read<v_rd_off(D0, 1, 1)>(vb);
  const s16x4 l2 = tr_read<v_rd_off(D0, 2, 0)>(vb), h2 = tr_read<v_rd_off(D0, 2, 1)>(vb), l3 = tr_read<v_rd_off(D0, 3, 0)>(vb), h3 = tr_read<v_rd_off(D0, 3, 1)>(vb);
  asm volatile("s_waitcnt lgkmcnt(0)" ::: "memory"); SBAR();
#define PK(L, H) (bf16x8){L[0], L[1], L[2], L[3], H[0], H[1], H[2], H[3]}
  od = __builtin_amdgcn_mfma_f32_32x32x16_bf16(pa0, PK(l0, h0), od, 0, 0, 0);
  od = __builtin_amdgcn_mfma_f32_32x32x16_bf16(pa1, PK(l1, h1), od, 0, 0, 0);
  od = __builtin_amdgcn_mfma_f32_32x32x16_bf16(pa2, PK(l2, h2), od, 0, 0, 0);
  od = __builtin_amdgcn_mfma_f32_32x32x16_bf16(pa3, PK(l3, h3), od, 0, 0, 0);
#undef PK
}
__device__ __forceinline__ void pv_d0(f32x16* o, int vb, bf16x8 pa0, bf16x8 pa1, bf16x8 pa2, bf16x8 pa3) {
  pv_one<0>(o[0], vb, pa0, pa1, pa2, pa3); pv_one<1>(o[1], vb, pa0, pa1, pa2, pa3); pv_one<2>(o[2], vb, pa0, pa1, pa2, pa3); pv_one<3>(o[3], vb, pa0, pa1, pa2, pa3);
}
template <int LDQ, int LDK, int LDO>
__device__ __forceinline__ void attn_dense_body(const bf16* __restrict__ Qb, const bf16* __restrict__ Kh, const bf16* __restrict__ Vh, float* __restrict__ Ob, int seq, char* lds) {
  const int tid = threadIdx.x, wid = tid >> 6, lane = tid & 63, r32 = lane & 31, hi = lane >> 5;
  bf16* V_lds = (bf16*)lds; bf16* K_lds = (bf16*)(lds + 2 * SHM_V);
  float* ws = (float*)(lds + 2 * SHM_V + 2 * SHM_K) + wid * 64; float* li_l = ws; float* al_l = ws + 32;
  float m_reg = -1e30f, l_reg = 0; f32x16 o[4] = {}; bf16x8 qr[8];
  const bf16* Qw = Qb + (long)(wid * QBLK + r32) * LDQ + hi * 8;
#pragma unroll
  for (int d0 = 0; d0 < 8; ++d0) qr[d0] = ld8(Qw + d0 * 16);
  const int sr = tid >> 4, sc = (tid & 15) * 8, vst0 = v_st(sr, sc), vst1 = v_st(32 + sr, sc);
  const int vb0 = (int)(uintptr_t)V_lds + v_rd_base(lane);
  struct { bf16x8 vs0, vs1, ks0, ks1; } sr_[2];
#define SLOAD(i, k0) do { sr_[i].vs0 = ld8(&Vh[(long)((k0) + sr) * LDK + sc]); sr_[i].vs1 = ld8(&Vh[(long)((k0) + 32 + sr) * LDK + sc]); \
    sr_[i].ks0 = ld8(&Kh[(long)((k0) + sr) * LDK + sc]); sr_[i].ks1 = ld8(&Kh[(long)((k0) + 32 + sr) * LDK + sc]); } while (0)
#define SWRITE(b, i) do { *(bf16x8*)((char*)V_lds + (b) * SHM_V + vst0) = sr_[i].vs0;          \
    *(bf16x8*)((char*)V_lds + (b) * SHM_V + vst1) = sr_[i].vs1; int kc = sc * 2;               \
    *(bf16x8*)((char*)K_lds + (b) * SHM_K + KSWZ(sr, kc)) = sr_[i].ks0;                       \
    *(bf16x8*)((char*)K_lds + (b) * SHM_K + KSWZ(32 + sr, kc)) = sr_[i].ks1; } while (0)
#define SWAIT() asm volatile("s_waitcnt vmcnt(4)" ::: "memory")
#define RESC(a) do { if (__any((a) < 1.f)) { if (hi == 0) al_l[r32] = (a); asm volatile("s_waitcnt lgkmcnt(0)" ::: "memory"); \
    for (int d = 0; d < 4; ++d) for (int r = 0; r < 16; ++r) o[d][r] *= al_l[crow(r, hi)]; } } while (0)
  f32x16 pA0, pA1, pB0, pB1; float mnA, mnB, alA, alB; bf16x8 pa0, pa1, pa2, pa3; const int NT = seq / KVBLK;
  constexpr int SE = 0, SO = 1;
  SLOAD(SE, 0); asm volatile("s_waitcnt vmcnt(0)" ::: "memory"); SWRITE(0, SE); __syncthreads();
  qkt(pA0, pA1, K_lds, qr, r32, hi); partialSM(pA0, pA1, m_reg, mnA, alA);
  SLOAD(SO, KVBLK); if (2 < NT) SLOAD(SE, 2 * KVBLK);
  SWAIT(); SWRITE(1, SO); __syncthreads();
  for (int j = 1; j + 1 < NT; j += 2) {
    SBAR(); qkt(pB0, pB1, (bf16*)((char*)K_lds + SHM_K), qr, r32, hi);
    finishSM(pA0, pA1, alA, l_reg, pa0, pa1, pa2, pa3); SBAR();
    SLOAD(SO, (j + 2) * KVBLK); SBAR();
    pv_d0(o, vb0, pa0, pa1, pa2, pa3); partialSM(pB0, pB1, m_reg, mnB, alB);
    __syncthreads(); SWAIT(); SWRITE(0, SE);
    RESC(alB); __syncthreads();
    SBAR(); qkt(pA0, pA1, K_lds, qr, r32, hi);
    finishSM(pB0, pB1, alB, l_reg, pa0, pa1, pa2, pa3); SBAR();
    if (j + 3 < NT) SLOAD(SE, (j + 3) * KVBLK); SBAR();
    pv_d0(o, vb0 + (int)SHM_V, pa0, pa1, pa2, pa3); partialSM(pA0, pA1, m_reg, mnA, alA);
    __syncthreads(); SWAIT(); SWRITE(1, SO);
    RESC(alA); __syncthreads();
  }
  SBAR(); qkt(pB0, pB1, (bf16*)((char*)K_lds + SHM_K), qr, r32, hi);
  finishSM(pA0, pA1, alA, l_reg, pa0, pa1, pa2, pa3); SBAR();
  pv_d0(o, vb0, pa0, pa1, pa2, pa3); partialSM(pB0, pB1, m_reg, mnB, alB);
  __syncthreads(); RESC(alB);
  finishSM(pB0, pB1, alB, l_reg, pa0, pa1, pa2, pa3); SBAR();
  pv_d0(o, vb0 + (int)SHM_V, pa0, pa1, pa2, pa3);
  if (hi == 0) li_l[r32] = l_reg; asm volatile("s_waitcnt lgkmcnt(0)" ::: "memory");
  float rli[16];
#pragma unroll
  for (int r = 0; r < 16; ++r) rli[r] = __builtin_amdgcn_rcpf(li_l[crow(r, hi)]);
  float* Ow = Ob + (long)(wid * QBLK) * LDO;
#pragma unroll
  for (int r = 0; r < 16; ++r) { int orow = crow(r, hi);
    for (int d0 = 0; d0 < 4; ++d0) Ow[(long)orow * LDO + d0 * 32 + r32] = o[d0][r] * rli[r]; }
  __syncthreads();
#undef SLOAD
#undef SWRITE
#undef SWAIT
#undef RESC
}
#undef KSWZ
#undef SBAR
}

__device__ __forceinline__ void phase_attention(Frame& F, const bf16_t* QKV, float* O0, float* O1, char* lds) {
    for (int L = (int)blockIdx.x; L < 1088; L += F.G) {
        int b, h, comp, vh, qb, seq; long krow0, qrow0;
        if (L < 1024) { qb = L & 15; vh = (L >> 4) & 1; comp = (L >> 5) & 1; h = (L >> 6) & 7; b = L >> 9; seq = RB; krow0 = (long)b * RB; qrow0 = krow0 + qb * 256; }
        else { const int r = L - 1024; vh = r & 1; comp = (r >> 1) & 1; h = (r >> 2) & 7; b = r >> 5; seq = CTX; krow0 = (long)b * RB + SEQ; qrow0 = krow0; }
        const bf16_t* Q = QKV + qrow0 * 6144 + h * 256 + comp * 128;
        const bf16_t* K = QKV + krow0 * 6144 + 2048 + h * 256 + comp * 128;
        const bf16_t* V = QKV + krow0 * 6144 + 4096 + h * 256 + vh * 128;
        float* O = (comp ? O1 : O0) + qrow0 * 2048 + h * 256 + vh * 128;
        attn::attn_dense_body<6144, 6144, 2048>(Q, K, V, O, seq, lds);
    }
}
__device__ __forceinline__ void phase_diffcombine(Frame& F, const float* O0, const float* O1, const float* lamv, const float* g, bf16_t* OUT) {
    const int gw = F.vcu * NWAVES + F.wave, NGW = F.G * NWAVES, lane = F.lane;
    constexpr float LAM_INIT = 0.47071301834358414f;
    const float d0 = wave_sum(lamv[lane] * lamv[128 + lane] + lamv[64 + lane] * lamv[192 + lane]);
    const float d1 = wave_sum(lamv[256 + lane] * lamv[384 + lane] + lamv[320 + lane] * lamv[448 + lane]);
    const float lam = expf(d0) - expf(d1) + LAM_INIT;
    const f32x4 g4 = *(const f32x4*)(g + 4 * lane) * (1.f - LAM_INIT);
    for (int row = gw; row < M; row += NGW) {
#pragma unroll
        for (int h = 0; h < 8; ++h) {
            const f32x4 a = *(const f32x4*)(O0 + (size_t)row * D + h * 256 + 4 * lane), bq = *(const f32x4*)(O1 + (size_t)row * D + h * 256 + 4 * lane);
            const f32x4 o = a - bq * lam;
            const float ss = wave_sum((o.x * o.x + o.y * o.y) + (o.z * o.z + o.w * o.w));
            const float r = rsqrtf(ss * (1.f / 256.f) + 1e-6f);
            const f32x4 y = o * r * g4;
            u32x2 w; w.x = cvt_pk_bf16(y.x, y.y); w.y = cvt_pk_bf16(y.z, y.w);
            *(u32x2*)(OUT + (size_t)row * D + h * 256 + 4 * lane) = w;
        }
    }
}
constexpr size_t G_QD = WS_G1, G_KT = WS_G1 + 34 * MiB, G_VT = WS_G1 + 68 * MiB, G_ATT = WS_G1 + 102 * MiB, G_DEC = WS_G1 + 111 * MiB, G_GD = WS_G1 + 113 * MiB;
__device__ __forceinline__ void phase_gla_pre(Frame& F, const bf16_t* P, const float* GD, const float* wup, const float* bgate, unsigned char* ws) {
    LAS bf16_t* QDs = (LAS bf16_t*)(F.lds); LAS bf16_t* KIs = (LAS bf16_t*)(F.lds + 33792); LAS float* gds = (LAS float*)(F.lds + 67584); LAS float* tot = (LAS float*)(F.lds + 71680);
    bf16_t* QD = (bf16_t*)(ws + G_QD); bf16_t* KT = (bf16_t*)(ws + G_KT); bf16_t* VT = (bf16_t*)(ws + G_VT); bf16_t* ATT = (bf16_t*)(ws + G_ATT); float* DEC = (float*)(ws + G_DEC);
    const int tid = F.tid, lane = F.lane, w = F.wave, d = tid & 255, th = tid >> 8;
    for (int unit = F.vcu; unit < 1088; unit += F.G) {
        const int dir = unit & 1, h = (unit >> 1) & 3, uidx = unit >> 3; const int b = uidx >= 68 ? 1 : 0, c = uidx - 68 * b; const bool isctx = c >= 64;
        const size_t row0 = (size_t)b * RB + (size_t)c * 64;
        { const int t = tid >> 3, r2 = (tid & 7) * 2; const f32x2 gv = *(const f32x2*)(GD + (row0 + t) * 32 + dir * 16 + r2); gds[t * 16 + r2] = gv.x; gds[t * 16 + r2 + 1] = gv.y; }
        float wu[16];
#pragma unroll
        for (int r = 0; r < 16; ++r) wu[r] = wup[(size_t)(dir * 16 + r) * 1024 + h * 256 + d];
        const float bgv = bgate[dir * 1024 + h * 256 + d];
        if (dir == 0) {
            u32x4 pk[8];
#pragma unroll
            for (int s8 = 0; s8 < 8; ++s8) { unsigned short e[8];
#pragma unroll
                for (int j = 0; j < 8; ++j) e[j] = P[(row0 + s8 * 8 + j) * 6400 + 2048 + h * 512 + tid];
                pk[s8] = (u32x4){(unsigned)e[0] | ((unsigned)e[1] << 16), (unsigned)e[2] | ((unsigned)e[3] << 16), (unsigned)e[4] | ((unsigned)e[5] << 16), (unsigned)e[6] | ((unsigned)e[7] << 16)}; }
            u32x4* dst = (u32x4*)(VT + ((size_t)uidx * 2048 + h * 512 + tid) * 64);
#pragma unroll
            for (int s8 = 0; s8 < 8; ++s8) dst[s8] = pk[s8];
        }
        __syncthreads();
        float bc[32]; float run = 0.f;
#pragma unroll
        for (int i = 0; i < 32; ++i) { const int t = th * 32 + i; float z = bgv;
#pragma unroll
            for (int r = 0; r < 16; ++r) z = fmaf(gds[t * 16 + r], wu[r], z);
            bc[i] = (fminf(z, 0.f) - log1pf(__expf(-fabsf(z)))) * 0.0625f; }
        if (dir == 0) {
#pragma unroll
            for (int i = 0; i < 32; ++i) { run += bc[i]; bc[i] = run; }
        } else {
#pragma unroll
            for (int i = 31; i >= 0; --i) { run += bc[i]; bc[i] = run; }
        }
        tot[th * 256 + d] = run;
        __syncthreads();
        const float t0v = tot[d], t1v = tot[256 + d]; const float blast = t0v + t1v;
        const float addv = (dir == 0) ? (th == 1 ? t0v : 0.f) : (th == 0 ? t1v : 0.f);
        unsigned ktp[16];
#pragma unroll
        for (int i = 0; i < 32; i += 2) {
            float kt2[2];
#pragma unroll
            for (int e = 0; e < 2; ++e) { const int t = th * 32 + i + e; const float bcum = bc[i + e] + addv;
                const float qv = bf2f(P[(row0 + t) * 6400 + h * 256 + d]), kv = bf2f(P[(row0 + t) * 6400 + 1024 + h * 256 + d]);
                const float ex = __expf(bcum); const float qd = qv * 0.0625f * ex, ki = kv * __expf(-bcum); kt2[e] = kv * __expf(blast - bcum);
                const bf16_t qb = (bf16_t)f2bf(qd);
                QDs[t * 264 + d] = qb; KIs[t * 264 + d] = (bf16_t)f2bf(ki);
                if (!isctx) QD[((size_t)dir * M + row0 + t) * 1024 + h * 256 + d] = qb; }
            ktp[i >> 1] = cvt_pk_bf16(kt2[0], kt2[1]);
        }
        { u32x4* dst = (u32x4*)(KT + ((((size_t)dir * 136 + uidx) * 4 + h) * 256 + d) * 64 + th * 32);
#pragma unroll
          for (int j = 0; j < 4; ++j) dst[j] = (u32x4){ktp[4 * j], ktp[4 * j + 1], ktp[4 * j + 2], ktp[4 * j + 3]}; }
        if (th == 0) DEC[(((size_t)dir * 136 + uidx) * 4 + h) * 256 + d] = __expf(blast);
        __syncthreads();
        if (!isctx) {
            const int fr = lane & 15, fq = lane >> 4;
#pragma unroll
            for (int tl = 0; tl < 2; ++tl) { const int tile = 2 * w + tl, ti = tile >> 2, si = tile & 3; f32x4 acc = {0.f, 0.f, 0.f, 0.f};
#pragma unroll
                for (int ks = 0; ks < 8; ++ks) { const bf16x8 af = *(const LAS bf16x8*)(QDs + (ti * 16 + fr) * 264 + ks * 32 + fq * 8), bfr = *(const LAS bf16x8*)(KIs + (si * 16 + fr) * 264 + ks * 32 + fq * 8);
                    acc = __builtin_amdgcn_mfma_f32_16x16x32_bf16(af, bfr, acc, 0, 0, 0); }
                bf16_t* ap = ATT + ((((size_t)dir * 136 + uidx) * 4 + h) * 64) * 64;
#pragma unroll
                for (int i = 0; i < 4; ++i) { const int t = ti * 16 + 4 * fq + i, s = si * 16 + fr; const bool keep = dir == 0 ? (s <= t) : (s >= t);
                    ap[t * 64 + s] = (bf16_t)f2bf(keep ? acc[i] : 0.f); } }
        }
        __syncthreads();
    }
}
__device__ __forceinline__ void phase_gla_scan(Frame& F, unsigned char* ws, float* O0, float* O1) {
    LAS bf16_t* QDs = (LAS bf16_t*)(F.lds); LAS bf16_t* KTs = (LAS bf16_t*)(F.lds + 33792); LAS bf16_t* VTs = (LAS bf16_t*)(F.lds + 70656); LAS bf16_t* ATs = (LAS bf16_t*)(F.lds + 75264);
    LAS float* DECs = (LAS float*)(F.lds + 84480); LAS float* PART = (LAS float*)(F.lds + 85504);
    const bf16_t* QD = (const bf16_t*)(ws + G_QD); const bf16_t* KT = (const bf16_t*)(ws + G_KT); const bf16_t* VT = (const bf16_t*)(ws + G_VT); const bf16_t* ATT = (const bf16_t*)(ws + G_ATT); const float* DEC = (const float*)(ws + G_DEC);
    const int tid = F.tid, lane = F.lane, w = F.wave, l32 = lane & 31, hi = lane >> 5;
    for (int L = (int)blockIdx.x; L < 256; L += F.G) {
        const int slice = L & 15, combo = L >> 4, dir = combo & 1, h = (combo >> 1) & 3, b = combo >> 3;
        float* Od = dir ? O1 : O0;
        f32x16 S = {};
        u32x4 rq[4], rk[4], rv, ra, rd;
        rv = (u32x4){0u, 0u, 0u, 0u}; rd = rv;
#define GLA_LOAD(j) do { const int cc = dir == 0 ? ((j) < 4 ? 64 + (j) : (j) - 4) : 67 - (j); const int uidx = b * 68 + cc; const size_t row0 = (size_t)b * RB + (size_t)cc * 64; \
            const size_t kb = (((size_t)dir * 136 + uidx) * 4 + h); \
            _Pragma("unroll") for (int i = 0; i < 4; ++i) { const int idx = tid + 512 * i; rq[i] = *(const u32x4*)(QD + ((size_t)dir * M + row0 + (idx >> 5)) * 1024 + h * 256 + (idx & 31) * 8); \
                rk[i] = *(const u32x4*)(KT + kb * 16384 + (size_t)idx * 8); } \
            if (tid < 256) rv = *(const u32x4*)(VT + ((size_t)uidx * 2048 + h * 512 + slice * 32 + (tid >> 3)) * 64 + (tid & 7) * 8); \
            ra = *(const u32x4*)(ATT + kb * 4096 + (size_t)tid * 8); \
            if (tid < 64) rd = *(const u32x4*)(DEC + kb * 256 + tid * 4); } while (0)
        GLA_LOAD(0);
        for (int j = 0; j < 68; ++j) {
            const int cc = dir == 0 ? (j < 4 ? 64 + j : j - 4) : 67 - j; const bool isctx = cc >= 64; const size_t row0 = (size_t)b * RB + (size_t)cc * 64;
#pragma unroll
            for (int i = 0; i < 4; ++i) { const int idx = tid + 512 * i; *(LAS u32x4*)(QDs + (idx >> 5) * 264 + (idx & 31) * 8) = rq[i]; *(LAS u32x4*)(KTs + (idx >> 3) * 72 + (idx & 7) * 8) = rk[i]; }
            if (tid < 256) *(LAS u32x4*)(VTs + (tid >> 3) * 72 + (tid & 7) * 8) = rv;
            *(LAS u32x4*)(ATs + (tid >> 3) * 72 + (tid & 7) * 8) = ra;
            if (tid < 64) *(LAS u32x4*)(DECs + tid * 4) = rd;
            __syncthreads();
            if (j + 1 < 68) GLA_LOAD(j + 1);
            bf16x8 vb[4];
#pragma unroll
            for (int ks = 0; ks < 4; ++ks) vb[ks] = *(const LAS bf16x8*)(VTs + l32 * 72 + ks * 16 + hi * 8);
            if (!isctx) {
                bf16x8 sb[2];
#pragma unroll
                for (int jj = 0; jj < 2; ++jj) { u32x4 t4 = {cvt_pk_bf16(S[8 * jj + 0], S[8 * jj + 1]), cvt_pk_bf16(S[8 * jj + 2], S[8 * jj + 3]), cvt_pk_bf16(S[8 * jj + 4], S[8 * jj + 5]), cvt_pk_bf16(S[8 * jj + 6], S[8 * jj + 7])};
                    sb[jj] = *reinterpret_cast<bf16x8*>(&t4); }
                f32x16 ao[2] = {};
#pragma unroll
                for (int tt = 0; tt < 2; ++tt)
#pragma unroll
                    for (int jj = 0; jj < 2; ++jj) { const LAS bf16_t* qp = QDs + (tt * 32 + l32) * 264 + 32 * w + 16 * jj + 4 * hi;
                        const u32x2 lo = *(const LAS u32x2*)qp, hi2 = *(const LAS u32x2*)(qp + 8); u32x4 a4 = {lo.x, lo.y, hi2.x, hi2.y};
                        ao[tt] = __builtin_amdgcn_mfma_f32_32x32x16_bf16(*reinterpret_cast<bf16x8*>(&a4), sb[jj], ao[tt], 0, 0, 0); }
                if (w < 2) {
#pragma unroll
                    for (int ks = 0; ks < 4; ++ks) { const bf16x8 af = *(const LAS bf16x8*)(ATs + (w * 32 + l32) * 72 + ks * 16 + hi * 8);
                        if (w == 0) ao[0] = __builtin_amdgcn_mfma_f32_32x32x16_bf16(af, vb[ks], ao[0], 0, 0, 0); else ao[1] = __builtin_amdgcn_mfma_f32_32x32x16_bf16(af, vb[ks], ao[1], 0, 0, 0); }
                }
#pragma unroll
                for (int tt = 0; tt < 2; ++tt)
#pragma unroll
                    for (int r = 0; r < 16; ++r) PART[(w * 64 + tt * 32 + (r & 3) + 8 * (r >> 2) + 4 * hi) * 32 + l32] = ao[tt][r];
            }
#pragma unroll
            for (int r = 0; r < 16; ++r) S[r] *= DECs[32 * w + (r & 3) + 8 * (r >> 2) + 4 * hi];
#pragma unroll
            for (int ks = 0; ks < 4; ++ks) { const bf16x8 af = *(const LAS bf16x8*)(KTs + (32 * w + l32) * 72 + ks * 16 + hi * 8);
                S = __builtin_amdgcn_mfma_f32_32x32x16_bf16(af, vb[ks], S, 0, 0, 0); }
            __syncthreads();
            if (!isctx) { const int t = tid >> 3, v4 = (tid & 7) * 4; f32x4 acc = *(const LAS f32x4*)(PART + t * 32 + v4);
#pragma unroll
                for (int ww = 1; ww < 8; ++ww) acc = acc + *(const LAS f32x4*)(PART + (ww * 64 + t) * 32 + v4);
                *(f32x4*)(Od + (row0 + t) * D + h * 512 + slice * 32 + v4) = acc; }
        }
#undef GLA_LOAD
        __syncthreads();
    }
}
__device__ __forceinline__ void phase_gla_finish(Frame& F, const float* O0, const float* O1, const bf16_t* P, const float* g, bf16_t* OUT) {
    const int gw = F.vcu * NWAVES + F.wave, NGW = F.G * NWAVES, lane = F.lane;
    const f32x4 ga = *(const f32x4*)(g + 8 * lane), gb = *(const f32x4*)(g + 8 * lane + 4);
    for (int lr = gw; lr < BATCH * SEQ; lr += NGW) {
        const size_t row = (size_t)(lr >> 12) * RB + (lr & 4095);
#pragma unroll
        for (int h = 0; h < 4; ++h) {
            const size_t o = row * D + h * 512 + 8 * lane;
            const f32x4 a0 = *(const f32x4*)(O0 + o) + *(const f32x4*)(O1 + o), a1 = *(const f32x4*)(O0 + o + 4) + *(const f32x4*)(O1 + o + 4);
            const float ss = wave_sum((a0.x * a0.x + a0.y * a0.y) + (a0.z * a0.z + a0.w * a0.w) + (a1.x * a1.x + a1.y * a1.y) + (a1.z * a1.z + a1.w * a1.w));
            const float rn = rsqrtf(ss * (1.f / 512.f) + 1e-6f);
            const u32x4 rr = *(const u32x4*)(P + row * 6400 + 4096 + h * 512 + 8 * lane);
            const float rv[8] = {bflo(rr.x), bfhi(rr.x), bflo(rr.y), bfhi(rr.y), bflo(rr.z), bfhi(rr.z), bflo(rr.w), bfhi(rr.w)};
            float y[8] = {a0.x * ga.x, a0.y * ga.y, a0.z * ga.z, a0.w * ga.w, a1.x * gb.x, a1.y * gb.y, a1.z * gb.z, a1.w * gb.w};
#pragma unroll
            for (int e = 0; e < 8; ++e) y[e] = y[e] * rn * (rv[e] / (1.f + __expf(-rv[e])));
            *(u32x4*)(OUT + o) = (u32x4){cvt_pk_bf16(y[0], y[1]), cvt_pk_bf16(y[2], y[3]), cvt_pk_bf16(y[4], y[5]), cvt_pk_bf16(y[6], y[7])};
        }
    }
}
enum { PH_PRO = 0, L0_MOD = 1, L0_CH = 2, L0_POS = 3, L0_OUT = 4, L0_FMOD = 5, L0_FIN = 6, L0_FOUT = 7,
       L1_MOD = 8, L1_IN = 9, L1_SP = 10, L1_OUT = 11, L1_FMOD = 12, L1_FIN = 13, L1_FOUT = 14,
       L2_MOD = 15, L2_QKV = 16, L2_ATT = 17, L2_CMB = 18, L2_OUT = 19, L2_FMOD = 20, L2_FIN = 21, L2_FOUT = 22,
       L3_MOD = 23, L3_IN = 24, L3_G1 = 25, L3_G2 = 26, L3_FSH = 27, L3_OUT = 28, L3_FMOD = 29, L3_FIN = 30, L3_FOUT = 31, PH_FINAL = 32, NPH = 33 };

__global__ void __launch_bounds__(NWAVES * 64, 2) mk_fwd(Args args) {
    extern __shared__ __attribute__((aligned(16))) unsigned char lds_raw[];
    Frame F;
    F.lds = (LAS unsigned char*)lds_raw; F.MISC = (volatile LAS unsigned*)(F.lds + MISC_OFF);
    F.tid = threadIdx.x; F.lane = F.tid & 63; F.wave = __builtin_amdgcn_readfirstlane(F.tid >> 6);
    F.G = gridDim.x; { const int bx = blockIdx.x; F.vcu = (F.G % 8 == 0) ? (bx % 8) * (F.G / 8) + bx / 8 : bx; }
    unsigned char* ws = args.ws; F.ctl = (unsigned*)(ws + WS_CTL);
    for (int u = F.tid; u < (LDS_BYTES - MISC_OFF) / 4; u += NWAVES * 64) ((LAS unsigned*)(F.lds + MISC_OFF))[u] = 0u;
    __syncthreads();
    const int lo = args.ph_lo, hi = args.ph_hi;
    XcdBarrier bar; bar.bar = F.ctl + args.li * XCD_BAR_WORDS; bar.x = 0; bar.st = F.MISC + 8;
    if (hi - lo > 1) bar = xcd_barrier_post(F.ctl + args.li * XCD_BAR_WORDS, F.MISC + 8);
#define IN(k) (lo <= (k) && (k) < hi)
#define SEAM(k) do { if (IN(k) && IN((k) + 1)) xcd_barrier(bar); } while (0)
    float* XR = (float*)(ws + WS_XR); const float* MOD = (const float*)(ws + WS_MOD);
    bf16_t* H = (bf16_t*)(ws + WS_H); bf16_t* BIG = (bf16_t*)(ws + WS_BIG);
    const int cu = (int)blockIdx.x;

    if (IN(PH_PRO)) { phase_prologue(F, args); SEAM(PH_PRO); }

#define FFN_PHASES(l, P_FMOD, P_FIN, P_FOUT, SKIPC) \
    if (IN(P_FMOD)) { const float* mod = MOD + (size_t)(l) * 3 * NMOD; phase_modulate(F, XR, args.in[7] + (l) * D, mod + 3 * D, mod + 4 * D, H, SKIPC); SEAM(P_FMOD); } \
    if (IN(P_FIN)) { pg8::Gemm g{H, (const bf16_t*)(ws + WS_WIN_T) + (size_t)(l) * DFF * D, D, D, D}; pg8::Sched2D S{(SKIPC) ? 32 : 34, DFF / 256, F.G, cu, D, D, SKIPC}; \
        pg8::EpiBf16<2> E{BIG, DFF, 1.f}; pg8::gemm_phase<pg8::EpiBf16<2>, pg8::Sched2D, true>(F.lds, g, S, E); SEAM(P_FIN); } \
    if (IN(P_FOUT)) { const float* mod = MOD + (size_t)(l) * 3 * NMOD; pg8::Gemm g{BIG, (const bf16_t*)(ws + WS_WOUT_T) + (size_t)(l) * DFF * D, DFF, DFF, DFF}; \
        pg8::Sched2D S{(SKIPC) ? 32 : 34, D / 256, F.G, cu, DFF, DFF, SKIPC}; pg8::EpiResid E{XR, mod + 5 * D}; \
        pg8::gemm_phase<pg8::EpiResid, pg8::Sched2D, true>(F.lds, g, S, E); SEAM(P_FOUT); }


    bf16_t* A2 = (bf16_t*)(ws + WS_A2);
    if (IN(L0_MOD)) { phase_modulate(F, XR, args.in[6] + 0 * D, MOD + 0 * D, MOD + 1 * D, H, false); SEAM(L0_MOD); }
    if (IN(L0_CH)) { pg8::Gemm g{(const bf16_t*)(ws + WS_TC), H, 512, D, 512}; pg8::SchedChan S{F.G, cu}; pg8::EpiChan E{BIG, BIG + (size_t)2 * 2048 * 8192};
        pg8::gemm_phase<pg8::EpiChan, pg8::SchedChan, true>(F.lds, g, S, E); SEAM(L0_CH); }
    if (IN(L0_POS)) {
        { pg8::Gemm g{(const bf16_t*)(ws + WS_PT), BIG, 8192, 8192, 8192}; pg8::SchedPosL S{F.G, cu}; pg8::EpiBf16<0> E{A2, D, 0.00069053396600248786f};
          pg8::gemm_phase<pg8::EpiBf16<0>, pg8::SchedPosL, true>(F.lds, g, S, E); }
        { pg8::Gemm g{(const bf16_t*)(ws + WS_PC), BIG + (size_t)2 * 2048 * 8192, 512, 512, 512}; pg8::SchedPosC S{F.G, cu}; pg8::EpiBf16<0> E{A2, D, 0.0027621358640099515f};
          pg8::gemm_phase<pg8::EpiBf16<0>, pg8::SchedPosC, true>(F.lds, g, S, E); }
        SEAM(L0_POS); }
    if (IN(L0_OUT)) { pg8::Gemm g{A2, (const bf16_t*)(ws + WS_FNO_T), D, D, D}; pg8::Sched2D S{34, D / 256, F.G, cu, D, D, 0}; pg8::EpiResid E{XR, MOD + 2 * D};
        pg8::gemm_phase<pg8::EpiResid, pg8::Sched2D, true>(F.lds, g, S, E); SEAM(L0_OUT); }
    FFN_PHASES(0, L0_FMOD, L0_FIN, L0_FOUT, 0)

    if (IN(L1_MOD)) { const float* mod = MOD + (size_t)1 * 3 * NMOD; phase_modulate(F, XR, args.in[6] + 1 * D, mod + 0 * D, mod + 1 * D, H, false); SEAM(L1_MOD); }
    if (IN(L1_IN)) { pg8::Gemm g{H, (const bf16_t*)(ws + WS_GMIN_T), D, D, D}; pg8::Sched2D S{34, 16, F.G, cu, D, D, 0}; pg8::EpiGeluStats<true> E{BIG, 4096, (float*)(ws + WS_LNS)};
        pg8::gemm_phase<pg8::EpiGeluStats<true>, pg8::Sched2D, true>(F.lds, g, S, E); SEAM(L1_IN); }
    if (IN(L1_SP)) { phase_spatial(F, BIG, (const float*)(ws + WS_LNS), args.in[13], args.in[14], (const bf16_t*)(ws + WS_GMWS), args.in[16], A2); SEAM(L1_SP); }
    if (IN(L1_OUT)) { const float* mod = MOD + (size_t)1 * 3 * NMOD; pg8::Gemm g{A2, (const bf16_t*)(ws + WS_GMOUT_T), D, D, D}; pg8::Sched2D S{34, D / 256, F.G, cu, D, D, 0}; pg8::EpiResid E{XR, mod + 2 * D};
        pg8::gemm_phase<pg8::EpiResid, pg8::Sched2D, true>(F.lds, g, S, E); SEAM(L1_OUT); }
    FFN_PHASES(1, L1_FMOD, L1_FIN, L1_FOUT, 0)

    float* F1 = (float*)(ws + WS_F1); float* F2 = (float*)(ws + WS_F2);
    if (IN(L2_MOD)) { const float* mod = MOD + (size_t)2 * 3 * NMOD; phase_modulate(F, XR, args.in[6] + 2 * D, mod + 0 * D, mod + 1 * D, H, false); SEAM(L2_MOD); }
    if (IN(L2_QKV)) { pg8::Gemm g{H, (const bf16_t*)(ws + WS_DFIN_T), D, D, D}; pg8::Sched2D S{34, 24, F.G, cu, D, D, 0}; pg8::EpiQKV E{BIG, (const float*)(ws + WS_ROPE)};
        pg8::gemm_phase<pg8::EpiQKV, pg8::Sched2D, true>(F.lds, g, S, E); SEAM(L2_QKV); }
    if (IN(L2_ATT)) { phase_attention(F, BIG, F1, F2, (char*)lds_raw); SEAM(L2_ATT); }
    if (IN(L2_CMB)) { phase_diffcombine(F, F1, F2, args.in[19], args.in[20], A2); SEAM(L2_CMB); }
    if (IN(L2_OUT)) { const float* mod = MOD + (size_t)2 * 3 * NMOD; pg8::Gemm g{A2, (const bf16_t*)(ws + WS_DFOUT_T), D, D, D}; pg8::Sched2D S{34, D / 256, F.G, cu, D, D, 0}; pg8::EpiResid E{XR, mod + 2 * D};
        pg8::gemm_phase<pg8::EpiResid, pg8::Sched2D, true>(F.lds, g, S, E); SEAM(L2_OUT); }
    FFN_PHASES(2, L2_FMOD, L2_FIN, L2_FOUT, 0)

    if (IN(L3_MOD)) { const float* mod = MOD + (size_t)3 * 3 * NMOD; phase_modulate(F, XR, args.in[6] + 3 * D, mod + 0 * D, mod + 1 * D, H, false); SEAM(L3_MOD); }
    if (IN(L3_IN)) { pg8::Gemm g{H, (const bf16_t*)(ws + WS_GLIN_T), D, D, D}; pg8::Sched2D S{34, 25, F.G, cu, D, D, 0}; pg8::EpiGla E{BIG, (float*)(ws + G_GD)};
        pg8::gemm_phase<pg8::EpiGla, pg8::Sched2D, true>(F.lds, g, S, E); SEAM(L3_IN); }
    if (IN(L3_G1)) { phase_gla_pre(F, BIG, (const float*)(ws + G_GD), args.in[23], args.in[24], ws); SEAM(L3_G1); }
    if (IN(L3_G2)) { phase_gla_scan(F, ws, F1, F2); SEAM(L3_G2); }
    if (IN(L3_FSH)) { phase_gla_finish(F, F1, F2, BIG, args.in[25], A2); SEAM(L3_FSH); }
    if (IN(L3_OUT)) { const float* mod = MOD + (size_t)3 * 3 * NMOD; pg8::Gemm g{A2, (const bf16_t*)(ws + WS_GLOUT_T), D, D, D}; pg8::Sched2D S{32, D / 256, F.G, cu, D, D, 1}; pg8::EpiResid E{XR, mod + 2 * D};
        pg8::gemm_phase<pg8::EpiResid, pg8::Sched2D, true>(F.lds, g, S, E); SEAM(L3_OUT); }
    FFN_PHASES(3, L3_FMOD, L3_FIN, L3_FOUT, 1)

    if (IN(PH_FINAL)) { phase_final(F, XR, args.in[10], args.out); }
#undef IN
#undef SEAM
}
#ifndef MK_ONE_LAUNCH
#define MK_ONE_LAUNCH 1
#endif
extern "C" void kernel_launch(void* const* d_in, const int* in_sizes, int n_in, void* d_out, int out_size, void* d_ws, size_t ws_size, hipStream_t st) {
    static int grid = 0;
    if (grid == 0) {
        int dev = 0, cus = 0;
        if (hipGetDevice(&dev) != hipSuccess || hipDeviceGetAttribute(&cus, hipDeviceAttributeMultiprocessorCount, dev) != hipSuccess) { fprintf(stderr, "device query failed\n"); grid = -1; return; }
        if (hipFuncSetAttribute((const void*)mk_fwd, hipFuncAttributeMaxDynamicSharedMemorySize, LDS_BYTES) != hipSuccess) { fprintf(stderr, "hipFuncSetAttribute failed\n"); grid = -1; return; }
        if (WS_END_MK > ws_size) { fprintf(stderr, "ws too small: need %zu have %zu\n", (size_t)WS_END_MK, ws_size); grid = -1; return; }
        grid = cus;
    }
    if (grid < 0) return;
    unsigned char* wsb = (unsigned char*)d_ws;
    (void)hipMemsetAsync(wsb + WS_CTL, 0, CTL_ZERO_BYTES, st);
    Args a{};
    for (int i = 0; i < 27; ++i) a.in[i] = (const float*)d_in[i];
    a.out = (float*)d_out; a.ws = wsb;
    if (MK_ONE_LAUNCH) { a.ph_lo = 0; a.ph_hi = NPH; a.li = 0; hipLaunchKernelGGL(mk_fwd, dim3(grid), dim3(NWAVES * 64), LDS_BYTES, st, a); }
    else for (int p = 0; p < NPH; ++p) { a.ph_lo = p; a.ph_hi = p + 1; a.li = p; hipLaunchKernelGGL(mk_fwd, dim3(grid), dim3(NWAVES * 64), LDS_BYTES, st, a); }
}
```

```cpp
#include <hip/hip_runtime.h>
#include <math.h>
#include <stdio.h>
#include <stdint.h>
constexpr int D = 2048, BATCH = 2, SEQ = 4096, CTX = 256, RB = SEQ + CTX, M = BATCH * RB, DFF = 8192;
constexpr int NMOD = 6 * D;
constexpr int LDH = DFF + 64;
#define LAS __attribute__((address_space(3)))
#define GAS __attribute__((address_space(1)))
typedef unsigned short bf16_t;
typedef short bf16x8 __attribute__((ext_vector_type(8)));
typedef float f32x4 __attribute__((ext_vector_type(4)));
typedef float f32x2 __attribute__((ext_vector_type(2)));
typedef float f32x16 __attribute__((ext_vector_type(16)));
typedef unsigned u32x4 __attribute__((ext_vector_type(4)));
typedef unsigned u32x2 __attribute__((ext_vector_type(2)));
typedef short s16x4 __attribute__((ext_vector_type(4)));

__device__ __forceinline__ unsigned cvt_pk_bf16(float lo, float hi) { unsigned r; asm volatile("v_cvt_pk_bf16_f32 %0, %1, %2" : "=v"(r) : "v"(lo), "v"(hi)); return r; }
__device__ __forceinline__ float bf2f(unsigned short h) { return __uint_as_float((unsigned)h << 16); }
__device__ __forceinline__ float bflo(unsigned w) { return __uint_as_float(w << 16); }
__device__ __forceinline__ float bfhi(unsigned w) { return __uint_as_float(w & 0xffff0000u); }
#define LDS_WAIT() asm volatile("s_waitcnt lgkmcnt(0)" ::: "memory")
#define VM_WAIT() asm volatile("s_waitcnt vmcnt(0)" ::: "memory")

__device__ __forceinline__ int mrow_of_tile(int pm) { const int b = pm >= 17 ? 1 : 0; const int t = pm - 17 * b; return t == 16 ? 2 : b; }

namespace pg8 {
constexpr int BM = 256, BK = 64, HALF = 128, HTB = HALF * BK * 2, STAGE_BYTES = 8 * HTB, NXCD = 8, WGM = 8;
__host__ __device__ __forceinline__ int lds_byte(int r, int c) { const int st = (r >> 4) * 2 + (c >> 5), rr = r & 15, cc = c & 31, ob = rr * 64 + cc * 2; return st * 1024 + (ob ^ (((ob >> 9) & 1) << 5)); }
__host__ __device__ __forceinline__ void stage_rc(int b, int& R, int& C) { const int st = b / 1024, sb = b % 1024, swz = sb ^ (((sb >> 9) & 1) << 5); R = (st >> 1) * 16 + swz / 64; C = (st & 1) * 32 + (swz % 64) / 2; }
__host__ __device__ __forceinline__ int perm32(int rho) { const int n = rho >> 4, i = rho & 15; return 8 * (i >> 2) + 4 * n + (i & 3); }

struct Unit { int pm, pn, z; size_t aoff, boff; };
struct Gemm { const bf16_t* A; const bf16_t* Bt; int lda, ldb, K; };

__device__ __forceinline__ bool static_tile(int i, int G, int c, int nM, int nN, int& pm, int& pn) {
    const int nwg = nM * nN; const long L = (long)i * G + c; if (L >= nwg) return false;
    int wgid = (int)L; { const int q = nwg / NXCD, r = nwg % NXCD, xcd = wgid % NXCD, off = wgid / NXCD; wgid = (xcd < r ? xcd * (q + 1) : r * (q + 1) + (xcd - r) * q) + off; }
    const int nig = WGM * nN, gid = wgid / nig, fm = gid * WGM, gsz = (nM - fm) < WGM ? (nM - fm) : WGM;
    pm = fm + ((wgid % nig) % gsz); pn = (wgid % nig) / gsz; return true;
}
struct Sched2D {
    int nM, nN, G, c, lda, ldb, skip_ctx, rep = 1;
    __device__ __forceinline__ bool next(int i, Unit& u) const {
        int pm, pn; if (!static_tile(rep == 2 ? (i >> 1) : i, G, c, nM, nN, pm, pn)) return false;
        if (skip_ctx) pm += (pm >= 16) ? 1 : 0;
        u.pm = pm; u.pn = pn; u.z = 0; u.aoff = (size_t)pm * BM * lda * 2; u.boff = (size_t)pn * BM * ldb * 2; return true;
    }
};

template <class Epi, class Sched, bool ALIGN_EPI>
__device__ __forceinline__ void gemm_phase(LAS unsigned char* lds, const Gemm g, const Sched& S, const Epi& E) {
    const int tid = threadIdx.x, wid = __builtin_amdgcn_readfirstlane(tid >> 6), lane = tid & 63, wr = wid >> 2, wc = wid & 3, fr = lane & 15, fq = lane >> 4;
    const int nt = g.K / BK;
    unsigned voffA[2], voffB[2];
#pragma unroll
    for (int i = 0; i < 2; ++i) { int R, C; stage_rc(tid * 16 + i * 8192, R, C); const int Rb = Epi::PERM ? ((R & ~31) + perm32(R & 31)) : R;
        voffA[i] = (unsigned)(R * g.lda + C) * 2u; voffB[i] = (unsigned)(Rb * g.ldb + C) * 2u; }
    const size_t kstep = (size_t)(BK * 2);
    const size_t hstepA = (size_t)HALF * g.lda * 2, hstepB = (size_t)HALF * g.ldb * 2;
    const unsigned ldsw = (unsigned)wid * 1024u;
    const int aoff = lds_byte(wr * 64 + fr, fq * 8), boff = lds_byte(wc * 32 + fr, fq * 8);
#define PG8_SA(b, h) (((b) * 2 + (h)) * HTB)
#define PG8_SB(b, h) ((4 + (b) * 2 + (h)) * HTB)
#define PG8_STAGE(bufoff, gbase, voff) do { _Pragma("unroll") for (int _i = 0; _i < 2; ++_i) \
        __builtin_amdgcn_global_load_lds((const unsigned*)((const char*)(gbase) + (voff)[_i]), (LAS unsigned*)(lds + (bufoff) + ldsw + _i * 8192), 16, 0, 0); } while (0)
#define PG8_LDA(dst, b, h) do { _Pragma("unroll") for (int m = 0; m < 4; ++m) _Pragma("unroll") for (int k = 0; k < 2; ++k) dst[m][k] = *(const LAS bf16x8*)(lds + PG8_SA(b, h) + aoff + m * 2048 + k * 1024); } while (0)
#define PG8_LDB(dst, b, h) do { _Pragma("unroll") for (int n = 0; n < 2; ++n) _Pragma("unroll") for (int k = 0; k < 2; ++k) dst[n][k] = *(const LAS bf16x8*)(lds + PG8_SB(b, h) + boff + n * 2048 + k * 1024); } while (0)
#define PG8_MMA(ai, bj, At, Bt) do { __builtin_amdgcn_s_setprio(1); _Pragma("unroll") for (int m = 0; m < 4; ++m) _Pragma("unroll") for (int n = 0; n < 2; ++n) _Pragma("unroll") for (int k = 0; k < 2; ++k) \
        acc[ai][bj][m][n] = __builtin_amdgcn_mfma_f32_16x16x32_bf16(Bt[n][k], At[m][k], acc[ai][bj][m][n], 0, 0, 0); __builtin_amdgcn_s_setprio(0); } while (0)
#define PG8_WAIT_V(n) asm volatile("s_waitcnt vmcnt(" #n ")" ::: "memory")
#define PG8_WAIT_L(n) asm volatile("s_waitcnt lgkmcnt(" #n ")" ::: "memory")
#define PG8_BAR __builtin_amdgcn_s_barrier()
#define PG8_SCHED __builtin_amdgcn_sched_barrier(0)
    Unit cur, nxt; int ui = 0;
    if (!S.next(0, cur)) return;
    f32x4 acc[2][2][4][2];
#pragma unroll
    for (int a = 0; a < 2; ++a)
#pragma unroll
        for (int b = 0; b < 2; ++b)
#pragma unroll
            for (int m = 0; m < 4; ++m)
#pragma unroll
                for (int n = 0; n < 2; ++n) acc[a][b][m][n] = (f32x4){0.f, 0.f, 0.f, 0.f};
    bf16x8 At[4][2], B0[2][2], B1[2][2];
    const char* cA = (const char*)g.A + cur.aoff; const char* cB = (const char*)g.Bt + cur.boff;
    PG8_STAGE(PG8_SB(0, 0), cB, voffB); PG8_STAGE(PG8_SB(0, 1), cB + hstepB, voffB); PG8_STAGE(PG8_SA(0, 0), cA, voffA); PG8_STAGE(PG8_SA(0, 1), cA + hstepA, voffA);
    if (wr == 1) PG8_BAR;
    PG8_WAIT_V(2); PG8_BAR;
    PG8_STAGE(PG8_SB(1, 0), cB + kstep, voffB); PG8_STAGE(PG8_SA(1, 0), cA + kstep, voffA); PG8_STAGE(PG8_SB(1, 1), cB + hstepB + kstep, voffB);
    PG8_WAIT_V(6); PG8_BAR;
    for (;;) {
        const bool has_next = S.next(ui + 1, nxt);
        const char* nA = has_next ? (const char*)g.A + nxt.aoff : cA; const char* nB = has_next ? (const char*)g.Bt + nxt.boff : cB;
        for (int t = 0; t < nt; t += 2) {
            const bool last = (t == nt - 2);
            const char* a1 = cA + (size_t)(t + 1) * kstep;
            const char* a2 = last ? nA : cA + (size_t)(t + 2) * kstep; const char* b2 = last ? nB : cB + (size_t)(t + 2) * kstep;
            const char* a3 = a2 + kstep; const char* b3 = b2 + kstep;
            PG8_LDB(B0, 0, 0); PG8_LDB(B1, 0, 1); PG8_SCHED; PG8_LDA(At, 0, 0); PG8_STAGE(PG8_SA(1, 1), a1 + hstepA, voffA);
            PG8_WAIT_V(8); PG8_WAIT_L(0); PG8_BAR; PG8_MMA(0, 0, At, B0); PG8_MMA(0, 1, At, B1); PG8_BAR; PG8_SCHED;
            PG8_LDA(At, 0, 1); PG8_STAGE(PG8_SB(0, 0), b2, voffB); PG8_STAGE(PG8_SB(0, 1), b2 + hstepB, voffB); PG8_STAGE(PG8_SA(0, 0), a2, voffA);
            PG8_WAIT_V(8); PG8_WAIT_L(0); PG8_BAR; PG8_MMA(1, 0, At, B0); PG8_MMA(1, 1, At, B1); PG8_BAR; PG8_SCHED;
            PG8_LDB(B0, 1, 0); PG8_LDB(B1, 1, 1); PG8_SCHED; PG8_LDA(At, 1, 0); PG8_STAGE(PG8_SA(0, 1), a2 + hstepA, voffA);
            PG8_WAIT_V(8); PG8_WAIT_L(0); PG8_BAR; PG8_MMA(0, 0, At, B0); PG8_MMA(0, 1, At, B1); PG8_BAR; PG8_SCHED;
            PG8_LDA(At, 1, 1); PG8_STAGE(PG8_SB(1, 0), b3, voffB); PG8_STAGE(PG8_SB(1, 1), b3 + hstepB, voffB); PG8_STAGE(PG8_SA(1, 0), a3, voffA);
            PG8_WAIT_V(8); PG8_WAIT_L(0); PG8_BAR; PG8_MMA(1, 0, At, B0); PG8_MMA(1, 1, At, B1); PG8_BAR; PG8_SCHED;
        }
        if constexpr (ALIGN_EPI) { if (wr == 0) PG8_BAR; }
        E(acc, cur, wr, wc, fr, fq);
        if (!has_next) break;
#pragma unroll
        for (int a = 0; a < 2; ++a)
#pragma unroll
            for (int b = 0; b < 2; ++b)
#pragma unroll
                for (int m = 0; m < 4; ++m)
#pragma unroll
                    for (int n = 0; n < 2; ++n) acc[a][b][m][n] = (f32x4){0.f, 0.f, 0.f, 0.f};
        cur = nxt; cA = nA; cB = nB; ++ui;
        if constexpr (ALIGN_EPI) { if (wr == 1) PG8_BAR; }
    }
    PG8_WAIT_V(0);
    if constexpr (!ALIGN_EPI) { if (wr == 0) PG8_BAR; }
    PG8_BAR;
#undef PG8_SA
#undef PG8_SB
#undef PG8_STAGE
#undef PG8_LDA
#undef PG8_LDB
#undef PG8_MMA
#undef PG8_WAIT_V
#undef PG8_WAIT_L
#undef PG8_BAR
#undef PG8_SCHED
}

__device__ __forceinline__ f32x2 gelu_pk(f32x2 v) {
    const f32x2 av = __builtin_elementwise_abs(v), d = av * 0.2316418882f + 1.0f;
    f32x2 t; t.x = __builtin_amdgcn_rcpf(d.x); t.y = __builtin_amdgcn_rcpf(d.y);
    f32x2 q = t * 0.5307027145f + (-0.7265760135f); q = q * t + 0.7107068705f; q = q * t + (-0.142248368f); q = q * t + 0.127414796f; q = q * t;
    const f32x2 s = (v * v) * (-0.72134752044f);
    f32x2 e; e.x = __builtin_amdgcn_exp2f(s.x); e.y = __builtin_amdgcn_exp2f(s.y);
    const f32x2 m = v * (q * e), r = v - m;
    f32x2 o; o.x = v.x < 0.f ? m.x : r.x; o.y = v.y < 0.f ? m.y : r.y; return o;
}
template <int ACT> struct EpiBf16 {
    static constexpr bool PERM = true;
    bf16_t* O; int ldc; float scale;
    __device__ __forceinline__ void operator()(const f32x4 (&acc)[2][2][4][2], const Unit& u, int wr, int wc, int fr, int fq) const {
        const int row0 = u.pm * BM + wr * 64 + fr, col0 = u.pn * BM + wc * 32 + 8 * fq;
#pragma unroll
        for (int ai = 0; ai < 2; ++ai)
#pragma unroll
            for (int m = 0; m < 4; ++m) { bf16_t* rowp = O + (size_t)(row0 + ai * HALF + m * 16) * ldc + col0;
#pragma unroll
                for (int bj = 0; bj < 2; ++bj) { f32x4 v0 = acc[ai][bj][m][0], v1 = acc[ai][bj][m][1];
                    if (ACT == 2) { v0 = __builtin_elementwise_max(v0, (f32x4){0.f, 0.f, 0.f, 0.f}); v1 = __builtin_elementwise_max(v1, (f32x4){0.f, 0.f, 0.f, 0.f}); v0 = v0 * v0; v1 = v1 * v1; }
                    else { v0 = v0 * scale; v1 = v1 * scale; }
                    u32x4 w; w.x = cvt_pk_bf16(v0[0], v0[1]); w.y = cvt_pk_bf16(v0[2], v0[3]); w.z = cvt_pk_bf16(v1[0], v1[1]); w.w = cvt_pk_bf16(v1[2], v1[3]);
                    *(u32x4*)(rowp + bj * HALF) = w; } }
    }
};
struct EpiResid {
    static constexpr bool PERM = false;
    float* X; const float* gate;
    __device__ __forceinline__ void operator()(const f32x4 (&acc)[2][2][4][2], const Unit& u, int wr, int wc, int fr, int fq) const {
        const int row0 = u.pm * BM + wr * 64 + fr, col0 = u.pn * BM + wc * 32 + 4 * fq;
        const float* gp = gate + (size_t)mrow_of_tile(u.pm) * NMOD + col0;
        f32x4 gv[2][2];
#pragma unroll
        for (int bj = 0; bj < 2; ++bj)
#pragma unroll
            for (int n = 0; n < 2; ++n) gv[bj][n] = *(const f32x4*)(gp + bj * HALF + n * 16);
#pragma unroll
        for (int ai = 0; ai < 2; ++ai)
#pragma unroll
            for (int m = 0; m < 4; ++m) { float* rowp = X + (size_t)(row0 + ai * HALF + m * 16) * D + col0;
#pragma unroll
                for (int bj = 0; bj < 2; ++bj)
#pragma unroll
                    for (int n = 0; n < 2; ++n) { f32x4* p = (f32x4*)(rowp + bj * HALF + n * 16); *p = *p + gv[bj][n] * acc[ai][bj][m][n]; } }
    }
};

template <bool STATS> struct EpiGeluStats {
    static constexpr bool PERM = true;
    bf16_t* O; int ldc; float* stats;
    __device__ __forceinline__ void operator()(const f32x4 (&acc)[2][2][4][2], const Unit& u, int wr, int wc, int fr, int fq) const {
        const int row0 = u.pm * BM + wr * 64 + fr, col0 = u.pn * BM + wc * 32 + 8 * fq;
        const bool st = STATS && (u.pn >= 8);
#pragma unroll
        for (int ai = 0; ai < 2; ++ai)
#pragma unroll
            for (int m = 0; m < 4; ++m) { const int row = row0 + ai * HALF + m * 16; bf16_t* rowp = O + (size_t)row * ldc + col0; float s = 0.f, q = 0.f;
#pragma unroll
                for (int bj = 0; bj < 2; ++bj) { f32x4 v0 = acc[ai][bj][m][0], v1 = acc[ai][bj][m][1];
                    f32x2 a = gelu_pk((f32x2){v0[0], v0[1]}), b = gelu_pk((f32x2){v0[2], v0[3]}), c = gelu_pk((f32x2){v1[0], v1[1]}), d = gelu_pk((f32x2){v1[2], v1[3]});
                    s += (a.x + a.y) + (b.x + b.y) + (c.x + c.y) + (d.x + d.y);
                    q += (a.x * a.x + a.y * a.y) + (b.x * b.x + b.y * b.y) + (c.x * c.x + c.y * c.y) + (d.x * d.x + d.y * d.y);
                    u32x4 w; w.x = cvt_pk_bf16(a.x, a.y); w.y = cvt_pk_bf16(b.x, b.y); w.z = cvt_pk_bf16(c.x, c.y); w.w = cvt_pk_bf16(d.x, d.y);
                    *(u32x4*)(rowp + bj * HALF) = w; }
                if (st) { s += __shfl_xor(s, 16); s += __shfl_xor(s, 32); q += __shfl_xor(q, 16); q += __shfl_xor(q, 32);
                    if (fq == 0) *(f32x2*)(stats + (((size_t)row * 8 + (u.pn - 8)) * 4 + wc) * 2) = (f32x2){s, q}; } }
    }
};
struct SchedChan {
    int G, c;
    __device__ __forceinline__ bool next(int i, Unit& u) const {
        const int L = i * G + c; if (L >= 544) return false;
        int b, g, pm, pn, ctx;
        if (L < 512) { ctx = 0; pn = L & 15; pm = (L >> 4) & 3; g = (L >> 6) & 3; b = L >> 8; }
        else { const int r = L - 512; ctx = 1; pn = 0; pm = r & 3; g = (r >> 2) & 3; b = r >> 4; }
        u.pm = pm; u.pn = pn; u.z = b | (g << 1) | (ctx << 3);
        u.aoff = (size_t)pm * BM * 512 * 2;
        u.boff = ((size_t)(b * RB + (ctx ? SEQ : pn * BM)) * D + g * 512) * 2;
        return true;
    }
};
struct EpiChan {
    static constexpr bool PERM = true;
    bf16_t* PB; bf16_t* PBc;
    __device__ __forceinline__ void operator()(const f32x4 (&acc)[2][2][4][2], const Unit& u, int wr, int wc, int fr, int fq) const {
        const int b = u.z & 1, g = (u.z >> 1) & 3, ctx = u.z >> 3;
        const int ldc = ctx ? 512 : LDH;
        bf16_t* base = (ctx ? PBc + (size_t)b * 2048 * 512 : PB + (size_t)b * 2048 * LDH) + (size_t)(g * 512 + (u.pm & 1) * 256) * ldc + (u.pm >> 1) * (ctx ? 256 : 4096) + u.pn * BM;
        const int row0 = wr * 64 + fr, col0 = wc * 32 + 8 * fq;
#pragma unroll
        for (int ai = 0; ai < 2; ++ai)
#pragma unroll
            for (int m = 0; m < 4; ++m) { bf16_t* rowp = base + (size_t)(row0 + ai * HALF + m * 16) * ldc + col0;
#pragma unroll
                for (int bj = 0; bj < 2; ++bj) { const f32x4 v0 = acc[ai][bj][m][0], v1 = acc[ai][bj][m][1];
                    u32x4 w; w.x = cvt_pk_bf16(v0[0], v0[1]); w.y = cvt_pk_bf16(v0[2], v0[3]); w.z = cvt_pk_bf16(v1[0], v1[1]); w.w = cvt_pk_bf16(v1[2], v1[3]);
                    *(u32x4*)(rowp + bj * HALF) = w; } }
    }
};
struct SchedPosL {
    int G, c, rep = 1;
    __device__ __forceinline__ bool next(int i, Unit& u) const {
        int pm, pn; if (!static_tile(rep == 2 ? (i >> 1) : i, G, c, 32, 8, pm, pn)) return false;
        const int b = pm >> 4; pm &= 15;
        u.pm = b * 17 + pm; u.pn = pn; u.z = b; u.aoff = (size_t)pm * BM * LDH * 2; u.boff = ((size_t)b * 2048 + pn * BM) * LDH * 2; return true;
    }
};
struct SchedPosC {
    int G, c;
    __device__ __forceinline__ bool next(int i, Unit& u) const {
        const int L = i * G + (G - 1 - c); if (L >= 16) return false;
        const int b = L >> 3, pn = L & 7;
        u.pm = b * 17 + 16; u.pn = pn; u.z = b; u.aoff = 0; u.boff = ((size_t)b * 2048 + pn * BM) * 512 * 2; return true;
    }
};

struct EpiQKV {
    static constexpr bool PERM = true;
    bf16_t* O; const float* rope;
    __device__ __forceinline__ void operator()(const f32x4 (&acc)[2][2][4][2], const Unit& u, int wr, int wc, int fr, int fq) const {
        const int rloc = wr * 64 + fr, col0 = u.pn * BM + wc * 32 + 8 * fq;
        const int mr = mrow_of_tile(u.pm); const bool dorope = (u.pn < 16) && (mr != 2);
        const int b = u.pm >= 17 ? 1 : 0, t0 = (u.pm - 17 * b) * BM; const int i0 = wc * 16 + 4 * fq;
        const float qs = (u.pn < 8) ? 0.12751743074602448f : 1.f;
#pragma unroll
        for (int ai = 0; ai < 2; ++ai)
#pragma unroll
            for (int m = 0; m < 4; ++m) { const int rl = rloc + ai * HALF + m * 16; bf16_t* rowp = O + (size_t)(u.pm * BM + rl) * 6144 + col0;
                f32x4 cs = {1.f, 1.f, 1.f, 1.f}, sn = {0.f, 0.f, 0.f, 0.f};
                if (dorope) { const int pos = t0 + rl; cs = *(const f32x4*)(rope + (size_t)pos * 64 + i0); sn = *(const f32x4*)(rope + (size_t)4096 * 64 + (size_t)pos * 64 + i0); }
                cs = cs * qs; sn = sn * qs;
#pragma unroll
                for (int bj = 0; bj < 2; ++bj) { const f32x4 v0 = acc[ai][bj][m][0], v1 = acc[ai][bj][m][1];
                    const float e0 = v0[0] * cs[0] - v0[1] * sn[0], o0 = v0[0] * sn[0] + v0[1] * cs[0];
                    const float e1 = v0[2] * cs[1] - v0[3] * sn[1], o1 = v0[2] * sn[1] + v0[3] * cs[1];
                    const float e2 = v1[0] * cs[2] - v1[1] * sn[2], o2 = v1[0] * sn[2] + v1[1] * cs[2];
                    const float e3 = v1[2] * cs[3] - v1[3] * sn[3], o3 = v1[2] * sn[3] + v1[3] * cs[3];
                    u32x4 w; w.x = cvt_pk_bf16(e0, o0); w.y = cvt_pk_bf16(e1, o1); w.z = cvt_pk_bf16(e2, o2); w.w = cvt_pk_bf16(e3, o3);
                    *(u32x4*)(rowp + bj * HALF) = w; } }
    }
};

struct EpiGla {
    static constexpr bool PERM = true;
    bf16_t* O; float* GD;
    __device__ __forceinline__ void operator()(const f32x4 (&acc)[2][2][4][2], const Unit& u, int wr, int wc, int fr, int fq) const {
        const int row0 = u.pm * BM + wr * 64 + fr, col0 = u.pn * BM + wc * 32 + 8 * fq;
        const bool gd = (u.pn == 24) && (wc == 0);
#pragma unroll
        for (int ai = 0; ai < 2; ++ai)
#pragma unroll
            for (int m = 0; m < 4; ++m) { const int row = row0 + ai * HALF + m * 16; bf16_t* rowp = O + (size_t)row * 6400 + col0;
#pragma unroll
                for (int bj = 0; bj < 2; ++bj) { const f32x4 v0 = acc[ai][bj][m][0], v1 = acc[ai][bj][m][1];
                    u32x4 w; w.x = cvt_pk_bf16(v0[0], v0[1]); w.y = cvt_pk_bf16(v0[2], v0[3]); w.z = cvt_pk_bf16(v1[0], v1[1]); w.w = cvt_pk_bf16(v1[2], v1[3]);
                    *(u32x4*)(rowp + bj * HALF) = w;
                    if (bj == 0 && gd) { *(f32x4*)(GD + (size_t)row * 32 + 8 * fq) = v0; *(f32x4*)(GD + (size_t)row * 32 + 8 * fq + 4) = v1; } } }
    }
};

struct SchedCtxSplit {
    int nN, KS, G, c, lda, ldb, kpiece;
    __device__ __forceinline__ bool next(int i, Unit& u) const {
        const int L = i * G + c; if (L >= 2 * nN * KS) return false;
        const int ks = L / (2 * nN), rem = L % (2 * nN), bt = rem / nN, pn = rem % nN;
        u.pm = bt ? 33 : 16; u.pn = pn; u.z = ks | (bt << 8);
        u.aoff = ((size_t)u.pm * BM * lda + (size_t)ks * kpiece) * 2; u.boff = ((size_t)pn * BM * ldb + (size_t)ks * kpiece) * 2; return true;
    }
};
struct EpiPartial {
    static constexpr bool PERM = false;
    float* PB;
    __device__ __forceinline__ void operator()(const f32x4 (&acc)[2][2][4][2], const Unit& u, int wr, int wc, int fr, int fq) const {
        const int ks = u.z & 255, bt = u.z >> 8;
        float* base = PB + ((size_t)ks * 512 + bt * 256 + wr * 64 + fr) * D + u.pn * BM + wc * 32 + 4 * fq;
#pragma unroll
        for (int ai = 0; ai < 2; ++ai)
#pragma unroll
            for (int m = 0; m < 4; ++m) { float* rowp = base + (size_t)(ai * HALF + m * 16) * D;
#pragma unroll
                for (int bj = 0; bj < 2; ++bj)
#pragma unroll
                    for (int n = 0; n < 2; ++n) *(f32x4*)(rowp + bj * HALF + n * 16) = acc[ai][bj][m][n]; }
    }
};
}

#define XB_TMO      128
#define XB_XCNT(j)  (256  + 64 * (j))
#define XB_XSUB(j)  (1280 + 64 * (j))
#define XB_XGEN(j)  (2304 + 64 * (j))
#define XB_TOP      3328
#define XB_TOPGEN   3392
#define XCD_BAR_WORDS 3456
#define XB_SPIN_CAP (1u << 18)
__device__ __forceinline__ unsigned xb_ld(unsigned* p)              { return __hip_atomic_load(p, __ATOMIC_RELAXED, __HIP_MEMORY_SCOPE_AGENT); }
__device__ __forceinline__ unsigned xb_add(unsigned* p, unsigned v) { return __hip_atomic_fetch_add(p, v, __ATOMIC_RELAXED, __HIP_MEMORY_SCOPE_AGENT); }
__device__ __forceinline__ unsigned xb_xcc_id() { return (unsigned)__builtin_amdgcn_s_getreg((3 << 11) | 20) & 0xFu; }
#define XB_SPIN(cond, bar) do { unsigned _sp = 0; while (cond) { __builtin_amdgcn_s_sleep(1); \
    if ((++_sp & 255u) == 0u) { if (xb_ld(&(bar)[XB_TMO])) break; if (_sp > XB_SPIN_CAP) { atomicAdd(&(bar)[XB_TMO], 1u); break; } } } } while (0)
struct XcdBarrier { unsigned* bar; unsigned x; volatile LAS unsigned* st; };
__device__ __forceinline__ XcdBarrier xcd_barrier_post(unsigned* bar, volatile LAS unsigned* st) {
    XcdBarrier b; b.bar = bar; b.x = xb_xcc_id(); b.st = st;
    if (threadIdx.x == 0) (void)xb_add(&bar[XB_XCNT(b.x)], 1u);
    return b;
}
__device__ __forceinline__ void xcd_barrier_complete(unsigned* bar, unsigned x, unsigned& nloc, unsigned& nx) {
    const unsigned G = gridDim.x * gridDim.y * gridDim.z;
    unsigned sum, cnt, mine, sp = 0u;
    for (;;) {
        sum = 0u; cnt = 0u; mine = 0u;
#pragma unroll
        for (unsigned j = 0; j < 16; ++j) { const unsigned c = xb_ld(&bar[XB_XCNT(j)]); sum += c; cnt += (c > 0u) ? 1u : 0u; mine = (j == x) ? c : mine; }
        if (sum == G) break;
        __builtin_amdgcn_s_sleep(1);
        if ((++sp & 255u) == 0u) { if (xb_ld(&bar[XB_TMO])) break; if (sp > XB_SPIN_CAP) { atomicAdd(&bar[XB_TMO], 1u); break; } }
    }
    nloc = mine > 0u ? mine : 1u; nx = cnt > 0u ? cnt : 1u;
}
__device__ __forceinline__ void xcd_barrier(const XcdBarrier& b) {
    asm volatile("s_waitcnt vmcnt(0)" ::: "memory");
    __syncthreads();
    if (threadIdx.x == 0) {
        unsigned* bar = b.bar;
        __builtin_amdgcn_s_waitcnt(0);
        unsigned nloc = b.st[0], nx = b.st[1];
        if (nloc == 0u) { xcd_barrier_complete(bar, b.x, nloc, nx); b.st[0] = nloc; b.st[1] = nx; }
        const unsigned old = xb_add(&bar[XB_XSUB(b.x)], 1u);
        const unsigned gen = old / nloc;
        if (old + 1u == (gen + 1u) * nloc) {
            __builtin_amdgcn_fence(__ATOMIC_RELEASE, "agent");
            asm volatile("s_waitcnt vmcnt(0)" ::: "memory");
            const unsigned og = xb_add(&bar[XB_TOP], 1u);
            const unsigned tg = og / nx;
            if (og + 1u == (tg + 1u) * nx) xb_add(&bar[XB_TOPGEN], 1u);
            else XB_SPIN(xb_ld(&bar[XB_TOPGEN]) == tg, bar);
            __builtin_amdgcn_fence(__ATOMIC_ACQUIRE, "agent");
            xb_add(&bar[XB_XGEN(b.x)], 1u);
            asm volatile("s_waitcnt vmcnt(0)" ::: "memory");
        } else {
            XB_SPIN(xb_ld(&bar[XB_XGEN(b.x)]) == gen, bar);
            __builtin_amdgcn_fence(__ATOMIC_ACQUIRE, "agent");
            asm volatile("s_waitcnt vmcnt(0)" ::: "memory");
        }
    }
    __syncthreads();
}
constexpr size_t MiB = 1u << 20;
constexpr size_t WS_CTL = 0, CTL_ZERO_BYTES = 4 * MiB;
constexpr size_t WS_MOD = 1 * MiB;
constexpr size_t WS_WIN_T = 4 * MiB;
constexpr size_t WS_WOUT_T = WS_WIN_T + 128 * MiB;
constexpr size_t WS_FNO_T = WS_WOUT_T + 130 * MiB;
constexpr size_t WS_GMIN_T = WS_FNO_T + 8 * MiB;
constexpr size_t WS_GMOUT_T = WS_GMIN_T + 16 * MiB;
constexpr size_t WS_DFIN_T = WS_GMOUT_T + 8 * MiB;
constexpr size_t WS_DFOUT_T = WS_DFIN_T + 24 * MiB;
constexpr size_t WS_GLIN_T = WS_DFOUT_T + 8 * MiB;
constexpr size_t WS_GLOUT_T = WS_GLIN_T + 25 * MiB;
constexpr size_t WS_TC = WS_GLOUT_T + 8 * MiB;
constexpr size_t WS_PT = WS_TC + 1 * MiB;
constexpr size_t WS_PC = WS_PT + 65 * MiB;
constexpr size_t WS_ROPE = WS_PC + 1 * MiB;
constexpr size_t WS_GMWS = WS_ROPE + 2 * MiB;
constexpr size_t WS_XR = WS_GMWS + 1 * MiB;
constexpr size_t WS_H = WS_XR + 68 * MiB;
constexpr size_t WS_BIG = WS_H + 34 * MiB;
constexpr size_t WS_A2 = WS_BIG + 138 * MiB;
constexpr size_t WS_F1 = WS_A2 + 34 * MiB;
constexpr size_t WS_F2 = WS_F1 + 68 * MiB;
constexpr size_t WS_LNS = WS_F1;
constexpr size_t WS_G1 = WS_F2 + 68 * MiB;
constexpr size_t WS_NAIVE = WS_G1 + 128 * MiB;
constexpr size_t WS_END_MK = WS_NAIVE;

constexpr int NWAVES = 8;
constexpr int RING_BYTES = 131072, LDS_BYTES = 163840, MISC_OFF = LDS_BYTES - 1024;

struct Args { const float* in[27]; float* out; unsigned char* ws; int ph_lo, ph_hi, li, pad; };

struct Frame {
    LAS unsigned char* lds; volatile LAS unsigned* MISC; unsigned* ctl;
    int tid, lane, wave, vcu, G;
};
__device__ __forceinline__ float wave_sum(float v) {
#pragma unroll
    for (int o = 1; o < 64; o <<= 1) v += __shfl_xor(v, o);
    return v;
}
__device__ __forceinline__ unsigned f2bf(float f) { unsigned u = __float_as_uint(f); return (u + 0x7fffu + ((u >> 16) & 1u)) >> 16; }
__device__ __forceinline__ unsigned pk2(float lo, float hi) { return f2bf(lo) | (f2bf(hi) << 16); }

template <int MAP>
__device__ __forceinline__ void transpose_item(const float* W, int K, int N, bf16_t* WT, int ldt, LAS float* scr, int item, int lane) {
    const int nblk = N / 32, kb = item / nblk, nb = item % nblk, k0 = 64 * kb, n0 = 32 * nb;
#pragma unroll 8
    for (int i = 0; i < 32; ++i) { const int kk = 2 * i + (lane >> 5); scr[kk * 33 + (lane & 31)] = W[(size_t)(k0 + kk) * N + n0 + (lane & 31)]; }
    LDS_WAIT(); asm volatile("" ::: "memory");
    const int c = lane & 7;
#pragma unroll
    for (int j = 0; j < 4; ++j) { const int n = (lane >> 3) + 8 * j; const LAS float* s = scr + (8 * c) * 33 + n;
        u32x4 o; o.x = pk2(s[0 * 33], s[1 * 33]); o.y = pk2(s[2 * 33], s[3 * 33]); o.z = pk2(s[4 * 33], s[5 * 33]); o.w = pk2(s[6 * 33], s[7 * 33]);
        int nn = n0 + n;
        if (MAP == 1) { if (nn < 4096) { const int blk = nn >> 7, w = nn & 127, sgn = w >> 6, i2 = w & 63; nn = blk * 128 + 2 * i2 + sgn; } }
        *(u32x4*)(WT + (size_t)nn * ldt + k0 + 8 * c) = o; }
    LDS_WAIT(); asm volatile("" ::: "memory");
}
template <int MAP>
__device__ __forceinline__ void transpose_all(Frame& F, const float* W, int K, int N, bf16_t* WT, int ldt = 0) {
    if (ldt == 0) ldt = K;
    LAS float* scr = (LAS float*)(F.lds + F.wave * 16384);
    const int gw = F.vcu * NWAVES + F.wave, NGW = F.G * NWAVES, nitems = (K / 64) * (N / 32);
    for (int it = gw; it < nitems; it += NGW) transpose_item<MAP>(W, K, N, WT, ldt, scr, it, F.lane);
}

__device__ __forceinline__ void phase_prologue(Frame& F, const Args& a) {
    unsigned char* ws = a.ws;
    const int gw = F.vcu * NWAVES + F.wave, NGW = F.G * NWAVES, lane = F.lane;
    {
        float* XR = (float*)(ws + WS_XR);
        for (int row = gw; row < M; row += NGW) {
            const int b = row >= RB ? 1 : 0, t = row - b * RB;
            const float* src = t < SEQ ? a.in[0] + (size_t)(b * SEQ + t) * D : a.in[2] + (size_t)(b * CTX + (t - SEQ)) * D;
            const f32x4* s4 = (const f32x4*)src + lane; f32x4* d4 = (f32x4*)(XR + (size_t)row * D) + lane;
#pragma unroll
            for (int j = 0; j < 8; ++j) d4[64 * j] = s4[64 * j];
        }
    }
    if (F.vcu < 192) {
        float* MOD = (float*)(ws + WS_MOD);
        const float* c = a.in[1]; const float* cc = a.in[3]; const float* wa = a.in[4]; const float* ba = a.in[5];
        const int l = F.vcu / 48, jg = F.vcu % 48, col = jg * 256 + 4 * lane, w = F.wave;
        const float* wp = wa + ((size_t)l * D + w * 256) * NMOD + col;
        f32x4 a0 = {0.f, 0.f, 0.f, 0.f}, a1 = a0, a2 = a0;
#pragma unroll 8
        for (int k = 0; k < 256; ++k) {
            const f32x4 wv = *(const f32x4*)(wp + (size_t)k * NMOD);
            const int kk = w * 256 + k;
            float c0 = c[kk], c1 = c[D + kk], c2 = cc[kk];
            c0 = c0 / (1.f + __expf(-c0)); c1 = c1 / (1.f + __expf(-c1)); c2 = c2 / (1.f + __expf(-c2));
            a0 = a0 + wv * c0; a1 = a1 + wv * c1; a2 = a2 + wv * c2;
        }
        LAS float* part = (LAS float*)F.lds;
        *(LAS f32x4*)(part + (w * 3 + 0) * 256 + 4 * lane) = a0; *(LAS f32x4*)(part + (w * 3 + 1) * 256 + 4 * lane) = a1; *(LAS f32x4*)(part + (w * 3 + 2) * 256 + 4 * lane) = a2;
        __syncthreads();
        for (int i = F.tid; i < 768; i += NWAVES * 64) { const int r = i >> 8, cj = i & 255; float sacc = ba[(size_t)l * NMOD + jg * 256 + cj];
#pragma unroll
            for (int ww = 0; ww < 8; ++ww) sacc += part[(ww * 3 + r) * 256 + cj];
            MOD[((size_t)l * 3 + r) * NMOD + jg * 256 + cj] = sacc; }
        __syncthreads();
    }
    for (int l = 0; l < 4; ++l) {
        transpose_all<0>(F, a.in[8] + (size_t)l * D * DFF, D, DFF, (bf16_t*)(ws + WS_WIN_T) + (size_t)l * DFF * D);
        transpose_all<0>(F, a.in[9] + (size_t)l * DFF * D, DFF, D, (bf16_t*)(ws + WS_WOUT_T) + (size_t)l * LDH * D, LDH);
    }
    transpose_all<0>(F, a.in[11], D, D, (bf16_t*)(ws + WS_FNO_T));
    transpose_all<0>(F, a.in[12], D, 4096, (bf16_t*)(ws + WS_GMIN_T));
    transpose_all<0>(F, a.in[17], D, D, (bf16_t*)(ws + WS_GMOUT_T));
    transpose_all<1>(F, a.in[18], D, 6144, (bf16_t*)(ws + WS_DFIN_T));
    transpose_all<0>(F, a.in[21], D, D, (bf16_t*)(ws + WS_DFOUT_T));
    transpose_all<0>(F, a.in[22], D, 6176, (bf16_t*)(ws + WS_GLIN_T));
    transpose_all<0>(F, a.in[26], D, D, (bf16_t*)(ws + WS_GLOUT_T));
    {
        u32x4* z = (u32x4*)((bf16_t*)(ws + WS_GLIN_T) + (size_t)6176 * D);
        const int n16 = 224 * D * 2 / 16;
        for (int i = gw * 64 + lane; i < n16; i += NGW * 64) z[i] = (u32x4){0u, 0u, 0u, 0u};
    }
    {
        bf16_t* TC = (bf16_t*)(ws + WS_TC); bf16_t* PT = (bf16_t*)(ws + WS_PT); bf16_t* PC = (bf16_t*)(ws + WS_PC);
        const int gt = gw * 64 + lane, NT = NGW * 64;
        for (int i = gt; i < 4096 * 8192 / 8; i += NT) {
            const int k = i >> 10, j0 = (i & 1023) * 8; const bool isn = j0 >= 4096; const int n0 = j0 & 4095; unsigned w[4];
#pragma unroll
            for (int e = 0; e < 8; e += 2) { float s0, c0, s1, c1; sincospif((float)((k * (n0 + e)) & 4095) * (1.f / 2048.f), &s0, &c0); sincospif((float)((k * (n0 + e + 1)) & 4095) * (1.f / 2048.f), &s1, &c1);
                w[e >> 1] = isn ? pk2(-s0, -s1) : pk2(c0, c1); }
            *(u32x4*)(PT + (size_t)k * LDH + j0) = (u32x4){w[0], w[1], w[2], w[3]};
        }
        for (int i = gt; i < 1024 * 512 / 8; i += NT) {
            const int r = i >> 6, c0 = (i & 63) * 8; const bool isn = r >= 512; const int rr = r & 511; unsigned w[4];
#pragma unroll
            for (int e = 0; e < 8; e += 2) { float s0, cc0, s1, cc1; sincospif((float)((rr * (c0 + e)) & 511) * (1.f / 256.f), &s0, &cc0); sincospif((float)((rr * (c0 + e + 1)) & 511) * (1.f / 256.f), &s1, &cc1);
                w[e >> 1] = isn ? pk2(s0, s1) : pk2(cc0, cc1); }
            *(u32x4*)(TC + (size_t)r * 512 + c0) = (u32x4){w[0], w[1], w[2], w[3]};
        }
        for (int i = gt; i < 256 * 512 / 8; i += NT) {
            const int k = i >> 6, j0 = (i & 63) * 8; const bool isn = j0 >= 256; const int n0 = j0 & 255; unsigned w[4];
#pragma unroll
            for (int e = 0; e < 8; e += 2) { float s0, c0, s1, c1; sincospif((float)((k * (n0 + e)) & 255) * (1.f / 128.f), &s0, &c0); sincospif((float)((k * (n0 + e + 1)) & 255) * (1.f / 128.f), &s1, &c1);
                w[e >> 1] = isn ? pk2(-s0, -s1) : pk2(c0, c1); }
            *(u32x4*)(PC + (size_t)k * 512 + j0) = (u32x4){w[0], w[1], w[2], w[3]};
        }
        {
            float* rc = (float*)(ws + WS_ROPE); float* rs = rc + 4096 * 64;
            for (int i = gt; i < 4096 * 64; i += NT) { const int pos = i >> 6, j = i & 63; const float inv = powf(10000.f, -(float)(j & 31) * (1.f / 32.f));
                const float ang = (float)(j < 32 ? (pos >> 6) : (pos & 63)) * inv; float sn, cs; sincosf(ang, &sn, &cs); rc[i] = cs; rs[i] = sn; }
        }
        const float* wsf = a.in[15]; bf16_t* wsb = (bf16_t*)(ws + WS_GMWS);
        for (int i = gt; i < 16 * 128 * 128 / 8; i += NT) { const f32x4 x0 = *(const f32x4*)(wsf + (size_t)i * 8), x1 = *(const f32x4*)(wsf + (size_t)i * 8 + 4);
            *(u32x4*)(wsb + (size_t)i * 8) = (u32x4){pk2(x0.x, x0.y), pk2(x0.z, x0.w), pk2(x1.x, x1.y), pk2(x1.z, x1.w)}; }
    }
}

__device__ __forceinline__ void phase_modulate(Frame& F, float* X, const float* g, const float* shift, const float* scale, bf16_t* H, bool skip_ctx, const float* pend = nullptr, int pend_ks = 0, const float* pgate = nullptr) {
    const int gw = F.vcu * NWAVES + F.wave, NGW = F.G * NWAVES, lane = F.lane;
    for (int row = gw; row < M; row += NGW) {
        const int mr = mrow_of_tile(row >> 8);
        if (skip_ctx && mr == 2) continue;
        f32x4* xr = (f32x4*)(X + (size_t)row * D) + lane;
        f32x4 v[8]; float s = 0.f;
#pragma unroll
        for (int j = 0; j < 8; ++j) v[j] = xr[64 * j];
        if (pend && mr == 2) {
            const int b = row >= RB ? 1 : 0, cr = b * 256 + (row - b * RB - SEQ);
            f32x4 ps[8];
#pragma unroll
            for (int j = 0; j < 8; ++j) ps[j] = (f32x4){0.f, 0.f, 0.f, 0.f};
            for (int ks = 0; ks < pend_ks; ++ks) { const f32x4* pp = (const f32x4*)(pend + ((size_t)ks * 512 + cr) * D) + lane;
#pragma unroll
                for (int j = 0; j < 8; ++j) ps[j] = ps[j] + pp[64 * j]; }
            const f32x4* pg4 = (const f32x4*)(pgate + (size_t)2 * NMOD) + lane;
#pragma unroll
            for (int j = 0; j < 8; ++j) { v[j] = v[j] + pg4[64 * j] * ps[j]; xr[64 * j] = v[j]; }
        }
#pragma unroll
        for (int j = 0; j < 8; ++j) s += (v[j].x * v[j].x + v[j].y * v[j].y) + (v[j].z * v[j].z + v[j].w * v[j].w);
        const float r = rsqrtf(wave_sum(s) * (1.f / D) + 1e-6f);
        const f32x4* g4 = (const f32x4*)g + lane; const f32x4* sc4 = (const f32x4*)(scale + (size_t)mr * NMOD) + lane; const f32x4* sh4 = (const f32x4*)(shift + (size_t)mr * NMOD) + lane;
        u32x2* o8 = (u32x2*)(H + (size_t)row * D) + lane;
#pragma unroll
        for (int j = 0; j < 8; ++j) { const f32x4 o = v[j] * r * g4[64 * j] * (sc4[64 * j] + 1.f) + sh4[64 * j];
            u32x2 w; w.x = cvt_pk_bf16(o.x, o.y); w.y = cvt_pk_bf16(o.z, o.w); o8[64 * j] = w; }
    }
}
__device__ __forceinline__ void phase_final(Frame& F, const float* X, const float* g, float* out) {
    const int gw = F.vcu * NWAVES + F.wave, NGW = F.G * NWAVES, lane = F.lane;
    for (int orow = gw; orow < BATCH * SEQ; orow += NGW) {
        const int b = orow >> 12, t = orow & 4095;
        const f32x4* xr = (const f32x4*)(X + (size_t)(b * RB + t) * D) + lane;
        f32x4 v[8]; float s = 0.f;
#pragma unroll
        for (int j = 0; j < 8; ++j) { v[j] = xr[64 * j]; s += (v[j].x * v[j].x + v[j].y * v[j].y) + (v[j].z * v[j].z + v[j].w * v[j].w); }
        const float r = rsqrtf(wave_sum(s) * (1.f / D) + 1e-6f);
        const f32x4* g4 = (const f32x4*)g + lane; f32x4* o4 = (f32x4*)(out + (size_t)orow * D) + lane;
#pragma unroll
        for (int j = 0; j < 8; ++j) o4[64 * j] = v[j] * r * g4[64 * j];
    }
}

__device__ __forceinline__ void phase_spatial(Frame& F, const bf16_t* Z, const float* LNS, const float* ln_g, const float* ln_b, const bf16_t* WsB, const float* b_s, bf16_t* OUT) {
    LAS bf16_t* VT = (LAS bf16_t*)(F.lds); LAS float* S = (LAS float*)(F.lds + 36864); LAS float* ST = (LAS float*)(F.lds + 104448);
    const int tid = F.tid, lane = F.lane, w = F.wave, l32 = lane & 31, hi = lane >> 5;
    for (int unit = F.vcu; unit < 68 * 16; unit += F.G) {
        const int chunk = unit >> 4, h = unit & 15; const int row0 = chunk * 128;
        if (tid < 128) { float sm = 0.f, sq = 0.f; const f32x2* pp = (const f32x2*)(LNS + (size_t)(row0 + tid) * 64);
#pragma unroll
            for (int j = 0; j < 32; ++j) { const f32x2 t = pp[j]; sm += t.x; sq += t.y; }
            const float mu = sm * (1.f / 2048.f); const float var = sq * (1.f / 2048.f) - mu * mu;
            ST[tid * 2] = mu; ST[tid * 2 + 1] = rsqrtf(fmaxf(var, 0.f) + 1e-5f); }
        __syncthreads();
#pragma unroll
        for (int i = 0; i < 4; ++i) { const int idx = tid + 512 * i, q = idx >> 4, e8 = (idx & 15) * 8;
            const u32x4 raw = *(const u32x4*)(Z + (size_t)(row0 + q) * 4096 + 2048 + h * 128 + e8);
            const float mu = ST[q * 2], rs = ST[q * 2 + 1];
            const f32x4 g0 = *(const f32x4*)(ln_g + h * 128 + e8), g1 = *(const f32x4*)(ln_g + h * 128 + e8 + 4), b0 = *(const f32x4*)(ln_b + h * 128 + e8), b1 = *(const f32x4*)(ln_b + h * 128 + e8 + 4);
            float v[8] = {bflo(raw.x), bfhi(raw.x), bflo(raw.y), bfhi(raw.y), bflo(raw.z), bfhi(raw.z), bflo(raw.w), bfhi(raw.w)};
            const float gg[8] = {g0.x, g0.y, g0.z, g0.w, g1.x, g1.y, g1.z, g1.w}, bb[8] = {b0.x, b0.y, b0.z, b0.w, b1.x, b1.y, b1.z, b1.w};
#pragma unroll
            for (int j = 0; j < 8; ++j) { const float o = (v[j] - mu) * rs * gg[j] + bb[j]; VT[(e8 + j) * 136 + q] = (bf16_t)f2bf(o); } }
        __syncthreads();
        const int pt = w >> 1, et0 = (w & 1) * 2;
        f32x16 acc0 = {}, acc1 = {};
        const bf16_t* Ap = WsB + ((size_t)h * 128 + pt * 32 + l32) * 128 + hi * 8;
#pragma unroll
        for (int ks = 0; ks < 8; ++ks) {
            const bf16x8 af = *(const bf16x8*)(Ap + ks * 16);
            const bf16x8 b0 = *(const LAS bf16x8*)(VT + (et0 * 32 + l32) * 136 + ks * 16 + hi * 8);
            const bf16x8 b1 = *(const LAS bf16x8*)(VT + ((et0 + 1) * 32 + l32) * 136 + ks * 16 + hi * 8);
            acc0 = __builtin_amdgcn_mfma_f32_32x32x16_bf16(af, b0, acc0, 0, 0, 0);
            acc1 = __builtin_amdgcn_mfma_f32_32x32x16_bf16(af, b1, acc1, 0, 0, 0);
        }
#pragma unroll
        for (int r = 0; r < 16; ++r) { const int p = pt * 32 + (r & 3) + 8 * (r >> 2) + 4 * hi; const float bs = b_s[h * 128 + p];
            S[p * 132 + et0 * 32 + l32] = acc0[r] + bs; S[p * 132 + (et0 + 1) * 32 + l32] = acc1[r] + bs; }
        __syncthreads();
#pragma unroll
        for (int i = 0; i < 4; ++i) { const int idx = tid + 512 * i, p = idx >> 4, e8 = (idx & 15) * 8;
            const u32x4 raw = *(const u32x4*)(Z + (size_t)(row0 + p) * 4096 + h * 128 + e8);
            const LAS float* sp = S + p * 132 + e8;
            u32x4 o; o.x = cvt_pk_bf16(bflo(raw.x) * sp[0], bfhi(raw.x) * sp[1]); o.y = cvt_pk_bf16(bflo(raw.y) * sp[2], bfhi(raw.y) * sp[3]);
            o.z = cvt_pk_bf16(bflo(raw.z) * sp[4], bfhi(raw.z) * sp[5]); o.w = cvt_pk_bf16(bflo(raw.w) * sp[6], bfhi(raw.w) * sp[7]);
            *(u32x4*)(OUT + (size_t)(row0 + p) * D + h * 128 + e8) = o; }
        __syncthreads();
    }
}

__device__ __forceinline__ void phase_lnstats(Frame& F, const bf16_t* Z, float* LNS) {
    const int gw = F.vcu * NWAVES + F.wave, NGW = F.G * NWAVES, lane = F.lane;
    for (int row = gw; row < M; row += NGW) {
        const u32x4* zr = (const u32x4*)(Z + (size_t)row * 4096 + 2048) + lane; float s = 0.f, q = 0.f;
#pragma unroll
        for (int j = 0; j < 4; ++j) { const u32x4 r = zr[64 * j]; const float v[8] = {bflo(r.x), bfhi(r.x), bflo(r.y), bfhi(r.y), bflo(r.z), bfhi(r.z), bflo(r.w), bfhi(r.w)};
#pragma unroll
            for (int e = 0; e < 8; ++e) { s += v[e]; q += v[e] * v[e]; } }
        s = wave_sum(s); q = wave_sum(q);
        if (lane < 32) *(f32x2*)(LNS + (size_t)row * 64 + lane * 2) = lane == 0 ? (f32x2){s, q} : (f32x2){0.f, 0.f};
    }
}
namespace attn2 {
using bf16 = unsigned short;
constexpr float THR2 = 11.5f;
#define KSWZ(row, colB) ((row) * 256 + ((colB) ^ (((row) & 7) << 4)))
#define SBAR() __builtin_amdgcn_sched_barrier(0)
__device__ __forceinline__ int crow(int r, int hi) { return (r & 3) + 8 * (r >> 2) + 4 * hi; }
__device__ __forceinline__ unsigned cvtpk(float lo, float hi) { unsigned r; asm volatile("v_cvt_pk_bf16_f32 %0, %1, %2" : "=v"(r) : "v"(lo), "v"(hi)); return r; }
__device__ __forceinline__ int v_rd_base(int lane) { return ((lane & 3) << 3) | (((lane >> 2) & 3) << 6) | (((lane >> 4) & 1) << 5) | (((lane >> 5) & 1) << 8); }
constexpr int v_rd_off(int d0, int ks, int half) { return (d0 >> 2) * 16384 + (d0 & 3) * 512 + ks * 4096 + half * 2048; }
template <int OFF> __device__ __forceinline__ s16x4 tr_read(int vb) {
  s16x4 r; asm volatile("ds_read_b64_tr_b16 %0, %1 offset:%2" : "=&v"(r) : "v"(vb), "i"(OFF) : "memory"); return r;
}
template <int D0, int HF> __device__ __forceinline__ void pv_half(f32x16& od, int vb, bf16x8 paA, bf16x8 paB) {
  const s16x4 l0 = tr_read<v_rd_off(D0, 2 * HF, 0)>(vb), h0 = tr_read<v_rd_off(D0, 2 * HF, 1)>(vb), l1 = tr_read<v_rd_off(D0, 2 * HF + 1, 0)>(vb), h1 = tr_read<v_rd_off(D0, 2 * HF + 1, 1)>(vb);
  asm volatile("s_waitcnt lgkmcnt(0)" ::: "memory"); SBAR();
#define PK(L, H) (bf16x8){L[0], L[1], L[2], L[3], H[0], H[1], H[2], H[3]}
  od = __builtin_amdgcn_mfma_f32_32x32x16_bf16(paA, PK(l0, h0), od, 0, 0, 0);
  od = __builtin_amdgcn_mfma_f32_32x32x16_bf16(paB, PK(l1, h1), od, 0, 0, 0);
#undef PK
}
__device__ __forceinline__ void unit(const bf16* __restrict__ Qb, const bf16* __restrict__ Kb, const bf16* __restrict__ Vb, bf16* __restrict__ Ob, int seq, float lam, const float* __restrict__ gsub, LAS unsigned char* lds) {
  const int tid = threadIdx.x, wid = __builtin_amdgcn_readfirstlane(tid >> 6), lane = tid & 63, r32 = lane & 31, hi = lane >> 5, comp = wid >> 2, wq = wid & 3;
  LAS float* wsf = (LAS float*)(lds + 131072) + wid * 64;
  float m_reg = -1e30f, l_reg = 0.f; f32x16 o[8] = {}; bf16x8 qr[8];
  { const bf16* Qw = Qb + (long)(wq * 32 + r32) * 6144 + comp * 128 + hi * 8;
#pragma unroll
    for (int d0 = 0; d0 < 8; ++d0) qr[d0] = *reinterpret_cast<const bf16x8*>(Qw + d0 * 16); }
  const int mat = wid >> 1; const bf16* sbase = (mat < 2) ? Kb + mat * 128 : Vb + (mat - 2) * 128;
  unsigned s0; int dodd;
  if (mat < 2) { const int ce = ((lane & 15) ^ (lane >> 4)) * 8; s0 = (unsigned)(((wid & 1) * 32 + (lane >> 4)) * 6144 + ce); dodd = (ce & 32) ? -32 : 32; }
  else { s0 = (unsigned)(((wid & 1) * 32 + ((lane >> 4) & 1) * 8 + ((lane >> 2) & 3)) * 6144 + (lane >> 5) * 32 + (lane & 3) * 8); dodd = 64; }
  const int rstep1 = (mat < 2) ? 4 * 6144 : 0, rstepV2 = (mat < 2) ? 0 : 4 * 6144, rstepV4 = (mat < 2) ? 0 : 16 * 6144;
#define SOFF(i) (s0 + (unsigned)((i) * rstep1 + (((i) >> 1) & 1) * rstepV2 + (((i) >> 2) & 1) * rstepV4 + ((i) & 1) * dodd))
#define ISSUE(t, buf) do { const bf16* _s = sbase + (long)(t) * 64 * 6144; _Pragma("unroll") for (int _i = 0; _i < 8; ++_i) \
    __builtin_amdgcn_global_load_lds((const unsigned*)(_s + SOFF(_i)), (LAS unsigned*)(lds + (buf) * 65536 + wid * 8192 + _i * 1024), 16, 0, 0); } while (0)
  int kbase[4];
#pragma unroll
  for (int q = 0; q < 4; ++q) kbase[q] = r32 * 256 + ((q * 32 + hi * 16) ^ ((r32 & 7) << 4));
  const int NT = seq >> 6;
  ISSUE(0, 0); asm volatile("s_waitcnt vmcnt(0)" ::: "memory"); __syncthreads();
  for (int j = 0; j < NT; ++j) {
    const int buf = j & 1;
    if (j + 1 < NT) ISSUE(j + 1, buf ^ 1);
    const LAS unsigned char* Ks = lds + buf * 65536 + comp * 16384;
    const int vb = (int)(uintptr_t)(lds + buf * 65536 + 32768) + v_rd_base(lane);
#pragma unroll
    for (int hf = 0; hf < 2; ++hf) {
      f32x16 p = {};
#pragma unroll
      for (int d0 = 0; d0 < 8; ++d0) { const bf16x8 b0 = *reinterpret_cast<const LAS bf16x8*>(Ks + kbase[d0 & 3] + (d0 >> 2) * 128 + hf * 8192);
        p = __builtin_amdgcn_mfma_f32_32x32x16_bf16(b0, qr[d0], p, 0, 0, 0); }
      float pmax = p[0];
#pragma unroll
      for (int r = 1; r < 16; ++r) pmax = fmaxf(pmax, p[r]);
      { auto rr = __builtin_amdgcn_permlane32_swap(__float_as_uint(pmax), __float_as_uint(pmax), false, false); pmax = fmaxf(__uint_as_float(rr[0]), __uint_as_float(rr[1])); }
      float mn, alpha;
      if (__builtin_expect(__all(pmax - m_reg <= THR2), 1)) { mn = m_reg; alpha = 1.f; }
      else { mn = fmaxf(m_reg, pmax); alpha = __builtin_amdgcn_exp2f(m_reg - mn); m_reg = mn; }
      float ps = 0.f;
#pragma unroll
      for (int r = 0; r < 16; ++r) { p[r] = __builtin_amdgcn_exp2f(p[r] - mn); ps += p[r]; }
      { auto rr = __builtin_amdgcn_permlane32_swap(__float_as_uint(ps), __float_as_uint(ps), false, false); ps = __uint_as_float(rr[0]) + __uint_as_float(rr[1]); }
      l_reg = l_reg * alpha + ps;
      bf16x8 paA, paB;
#define PK4(P, BASE, OUT) do { unsigned a0 = cvtpk(P[BASE + 0], P[BASE + 1]), a1 = cvtpk(P[BASE + 2], P[BASE + 3]);   \
      unsigned b0_ = cvtpk(P[BASE + 4], P[BASE + 5]), b1_ = cvtpk(P[BASE + 6], P[BASE + 7]);                              \
      auto r0 = __builtin_amdgcn_permlane32_swap(a0, b0_, false, false); auto r1 = __builtin_amdgcn_permlane32_swap(a1, b1_, false, false); \
      u32x4 w_ = {r0[0], r1[0], r0[1], r1[1]}; OUT = *reinterpret_cast<bf16x8*>(&w_); } while (0)
      PK4(p, 0, paA); PK4(p, 8, paB);
#undef PK4
      if (__any(alpha < 1.f)) { if (hi == 0) wsf[r32] = alpha; asm volatile("s_waitcnt lgkmcnt(0)" ::: "memory");
#pragma unroll
        for (int d = 0; d < 8; ++d)
#pragma unroll
          for (int r = 0; r < 16; ++r) o[d][r] *= wsf[crow(r, hi)]; }
      if (hf == 0) { pv_half<0, 0>(o[0], vb, paA, paB); pv_half<1, 0>(o[1], vb, paA, paB); pv_half<2, 0>(o[2], vb, paA, paB); pv_half<3, 0>(o[3], vb, paA, paB);
                     pv_half<4, 0>(o[4], vb, paA, paB); pv_half<5, 0>(o[5], vb, paA, paB); pv_half<6, 0>(o[6], vb, paA, paB); pv_half<7, 0>(o[7], vb, paA, paB); }
      else         { pv_half<0, 1>(o[0], vb, paA, paB); pv_half<1, 1>(o[1], vb, paA, paB); pv_half<2, 1>(o[2], vb, paA, paB); pv_half<3, 1>(o[3], vb, paA, paB);
                     pv_half<4, 1>(o[4], vb, paA, paB); pv_half<5, 1>(o[5], vb, paA, paB); pv_half<6, 1>(o[6], vb, paA, paB); pv_half<7, 1>(o[7], vb, paA, paB); }
    }
    asm volatile("s_waitcnt vmcnt(0)" ::: "memory"); __syncthreads();
  }
#undef ISSUE
#undef SOFF
  if (hi == 0) wsf[r32] = l_reg; asm volatile("s_waitcnt lgkmcnt(0)" ::: "memory");
  LAS float* X = (LAS float*)(lds + wq * 32768);
  if (comp == 1) {
#pragma unroll
    for (int r = 0; r < 16; ++r) { const float ri = __builtin_amdgcn_rcpf(wsf[crow(r, hi)]);
#pragma unroll
      for (int d = 0; d < 8; ++d) X[crow(r, hi) * 256 + d * 32 + r32] = o[d][r] * ri; }
  }
  __syncthreads();
  if (comp == 0) {
#pragma unroll
    for (int r = 0; r < 16; ++r) { const float ri = __builtin_amdgcn_rcpf(wsf[crow(r, hi)]);
#pragma unroll
      for (int d = 0; d < 8; ++d) { LAS float* xp = X + crow(r, hi) * 256 + d * 32 + r32; *xp = o[d][r] * ri - lam * (*xp); } }
    asm volatile("s_waitcnt lgkmcnt(0)" ::: "memory");
    const int row = lane >> 1, half = lane & 1; const LAS float* xr = X + row * 256 + half * 128; float ssq = 0.f;
#pragma unroll 8
    for (int i = 0; i < 32; ++i) { const f32x4 v = *(const LAS f32x4*)(xr + ((i + row) & 31) * 4); ssq += (v.x * v.x + v.y * v.y) + (v.z * v.z + v.w * v.w); }
    ssq += __shfl_xor(ssq, 1);
    const float sc = rsqrtf(ssq * (1.f / 256.f) + 1e-6f) * (1.f - 0.47071301834358414f);
    bf16* orow = Ob + (long)(wq * 32 + row) * 2048 + half * 128;
#pragma unroll 4
    for (int i = 0; i < 16; ++i) { const int c8 = ((i + row) & 15) * 8; const f32x4 v0 = *(const LAS f32x4*)(xr + c8), v1 = *(const LAS f32x4*)(xr + c8 + 4);
      const f32x4 g0 = *(const f32x4*)(gsub + half * 128 + c8), g1 = *(const f32x4*)(gsub + half * 128 + c8 + 4);
      *(u32x4*)(orow + c8) = (u32x4){cvtpk(v0.x * sc * g0.x, v0.y * sc * g0.y), cvtpk(v0.z * sc * g0.z, v0.w * sc * g0.w), cvtpk(v1.x * sc * g1.x, v1.y * sc * g1.y), cvtpk(v1.z * sc * g1.z, v1.w * sc * g1.w)}; }
  }
  __syncthreads();
}
#undef KSWZ
#undef SBAR
}

__device__ __forceinline__ void phase_attention2(Frame& F, const bf16_t* QKV, const float* lamv, const float* gsub, bf16_t* OUT, int rep = 1) {
    const int lane = F.lane;
    const float d0 = wave_sum(lamv[lane] * lamv[128 + lane] + lamv[64 + lane] * lamv[192 + lane]);
    const float d1 = wave_sum(lamv[256 + lane] * lamv[384 + lane] + lamv[320 + lane] * lamv[448 + lane]);
    const float lam = expf(d0) - expf(d1) + 0.47071301834358414f;
    for (int it = 0;; ++it) { const int L = (it / rep) * F.G + (int)blockIdx.x; if (L >= 544) break;
        int b, h, seq; long krow0, qrow0;
        if (L < 512) { const int qb = L & 31; h = (L >> 5) & 7; b = L >> 8; seq = RB; krow0 = (long)b * RB; qrow0 = krow0 + qb * 128; }
        else { const int r = L - 512; const int qb = r & 1; h = (r >> 1) & 7; b = r >> 4; seq = CTX; krow0 = (long)b * RB + SEQ; qrow0 = krow0 + qb * 128; }
        attn2::unit(QKV + qrow0 * 6144 + h * 256, QKV + krow0 * 6144 + 2048 + h * 256, QKV + krow0 * 6144 + 4096 + h * 256, OUT + qrow0 * 2048 + h * 256, seq, lam, gsub, F.lds);
    }
}
constexpr size_t G_QD = WS_G1, G_KT = WS_G1 + 34 * MiB, G_VT = WS_G1 + 68 * MiB, G_ATT = WS_G1 + 102 * MiB, G_DEC = WS_G1 + 111 * MiB, G_GD = WS_G1 + 113 * MiB;
__device__ __forceinline__ void phase_gla_pre(Frame& F, const bf16_t* P, const float* GD, const float* wup, const float* bgate, unsigned char* ws, int rep = 1) {
    LAS bf16_t* QDs = (LAS bf16_t*)(F.lds); LAS bf16_t* KIs = (LAS bf16_t*)(F.lds + 33792); LAS float* gds = (LAS float*)(F.lds + 67584); LAS float* tot = (LAS float*)(F.lds + 71680);
    bf16_t* QD = (bf16_t*)(ws + G_QD); bf16_t* KT = (bf16_t*)(ws + G_KT); bf16_t* VT = (bf16_t*)(ws + G_VT); bf16_t* ATT = (bf16_t*)(ws + G_ATT); float* DEC = (float*)(ws + G_DEC);
    const int tid = F.tid, lane = F.lane, w = F.wave, d = tid & 255, th = tid >> 8;
    for (int it = 0;; ++it) { const int unit = (it / rep) * F.G + F.vcu; if (unit >= 1088) break;
        const int dir = unit & 1, h = (unit >> 1) & 3, uidx = unit >> 3; const int b = uidx >= 68 ? 1 : 0, c = uidx - 68 * b; const bool isctx = c >= 64;
        const size_t row0 = (size_t)b * RB + (size_t)c * 64;
        { const int t = tid >> 3, r2 = (tid & 7) * 2; const f32x2 gv = *(const f32x2*)(GD + (row0 + t) * 32 + dir * 16 + r2); gds[t * 16 + r2] = gv.x; gds[t * 16 + r2 + 1] = gv.y; }
        float wu[16];
#pragma unroll
        for (int r = 0; r < 16; ++r) wu[r] = wup[(size_t)(dir * 16 + r) * 1024 + h * 256 + d];
        const float bgv = bgate[dir * 1024 + h * 256 + d];
        if (dir == 0) {
            u32x4 pk[8];
#pragma unroll
            for (int s8 = 0; s8 < 8; ++s8) { unsigned short e[8];
#pragma unroll
                for (int j = 0; j < 8; ++j) e[j] = P[(row0 + s8 * 8 + j) * 6400 + 2048 + h * 512 + tid];
                pk[s8] = (u32x4){(unsigned)e[0] | ((unsigned)e[1] << 16), (unsigned)e[2] | ((unsigned)e[3] << 16), (unsigned)e[4] | ((unsigned)e[5] << 16), (unsigned)e[6] | ((unsigned)e[7] << 16)}; }
            u32x4* dst = (u32x4*)(VT + ((size_t)uidx * 2048 + h * 512 + tid) * 64);
#pragma unroll
            for (int s8 = 0; s8 < 8; ++s8) dst[s8] = pk[s8];
        }
        __syncthreads();
        float bc[32]; float run = 0.f;
#pragma unroll
        for (int i = 0; i < 32; ++i) { const int t = th * 32 + i; float z = bgv;
#pragma unroll
            for (int r = 0; r < 16; ++r) z = fmaf(gds[t * 16 + r], wu[r], z);
            bc[i] = (fminf(z, 0.f) - log1pf(__expf(-fabsf(z)))) * 0.0625f; }
        if (dir == 0) {
#pragma unroll
            for (int i = 0; i < 32; ++i) { run += bc[i]; bc[i] = run; }
        } else {
#pragma unroll
            for (int i = 31; i >= 0; --i) { run += bc[i]; bc[i] = run; }
        }
        tot[th * 256 + d] = run;
        __syncthreads();
        const float t0v = tot[d], t1v = tot[256 + d]; const float blast = t0v + t1v;
        const float addv = (dir == 0) ? (th == 1 ? t0v : 0.f) : (th == 0 ? t1v : 0.f);
        unsigned ktp[16];
#pragma unroll
        for (int i = 0; i < 32; i += 2) {
            float kt2[2];
#pragma unroll
            for (int e = 0; e < 2; ++e) { const int t = th * 32 + i + e; const float bcum = bc[i + e] + addv;
                const float qv = bf2f(P[(row0 + t) * 6400 + h * 256 + d]), kv = bf2f(P[(row0 + t) * 6400 + 1024 + h * 256 + d]);
                const float ex = __expf(bcum); const float qd = qv * 0.0625f * ex, ki = kv * __expf(-bcum); kt2[e] = kv * __expf(blast - bcum);
                const bf16_t qb = (bf16_t)f2bf(qd);
                QDs[t * 264 + d] = qb; KIs[t * 264 + d] = (bf16_t)f2bf(ki);
                if (!isctx) QD[((size_t)dir * M + row0 + t) * 1024 + h * 256 + d] = qb; }
            ktp[i >> 1] = cvt_pk_bf16(kt2[0], kt2[1]);
        }
        { u32x4* dst = (u32x4*)(KT + ((((size_t)dir * 136 + uidx) * 4 + h) * 256 + d) * 64 + th * 32);
#pragma unroll
          for (int j = 0; j < 4; ++j) dst[j] = (u32x4){ktp[4 * j], ktp[4 * j + 1], ktp[4 * j + 2], ktp[4 * j + 3]}; }
        if (th == 0) DEC[(((size_t)dir * 136 + uidx) * 4 + h) * 256 + d] = __expf(blast);
        __syncthreads();
        if (!isctx) {
            const int fr = lane & 15, fq = lane >> 4;
#pragma unroll
            for (int tl = 0; tl < 2; ++tl) { const int tile = 2 * w + tl, ti = tile >> 2, si = tile & 3; f32x4 acc = {0.f, 0.f, 0.f, 0.f};
#pragma unroll
                for (int ks = 0; ks < 8; ++ks) { const bf16x8 af = *(const LAS bf16x8*)(QDs + (ti * 16 + fr) * 264 + ks * 32 + fq * 8), bfr = *(const LAS bf16x8*)(KIs + (si * 16 + fr) * 264 + ks * 32 + fq * 8);
                    acc = __builtin_amdgcn_mfma_f32_16x16x32_bf16(af, bfr, acc, 0, 0, 0); }
                bf16_t* ap = ATT + ((((size_t)dir * 136 + uidx) * 4 + h) * 64) * 64;
#pragma unroll
                for (int i = 0; i < 4; ++i) { const int t = ti * 16 + 4 * fq + i, s = si * 16 + fr; const bool keep = dir == 0 ? (s <= t) : (s >= t);
                    ap[t * 64 + s] = (bf16_t)f2bf(keep ? acc[i] : 0.f); } }
        }
        __syncthreads();
    }
}
__device__ __forceinline__ void phase_gla_scan(Frame& F, unsigned char* ws, float* O0, float* O1, int rep = 1) {
    LAS bf16_t* QDs = (LAS bf16_t*)(F.lds); LAS bf16_t* KTs = (LAS bf16_t*)(F.lds + 33792); LAS bf16_t* VTs = (LAS bf16_t*)(F.lds + 70656); LAS bf16_t* ATs = (LAS bf16_t*)(F.lds + 75264);
    LAS float* DECs = (LAS float*)(F.lds + 84480); LAS float* PART = (LAS float*)(F.lds + 85504);
    const bf16_t* QD = (const bf16_t*)(ws + G_QD); const bf16_t* KT = (const bf16_t*)(ws + G_KT); const bf16_t* VT = (const bf16_t*)(ws + G_VT); const bf16_t* ATT = (const bf16_t*)(ws + G_ATT); const float* DEC = (const float*)(ws + G_DEC);
    const int tid = F.tid, lane = F.lane, w = F.wave, l32 = lane & 31, hi = lane >> 5;
    for (int it = 0;; ++it) { const int L = (it / rep) * F.G + (int)blockIdx.x; if (L >= 256) break;
        const int slice = L & 15, combo = L >> 4, dir = combo & 1, h = (combo >> 1) & 3, b = combo >> 3;
        float* Od = dir ? O1 : O0;
        f32x16 S = {};
        u32x4 rq[4], rk[4], rv, ra, rd;
        rv = (u32x4){0u, 0u, 0u, 0u}; rd = rv;
#define GLA_LOAD(j) do { const int cc = dir == 0 ? ((j) < 4 ? 64 + (j) : (j) - 4) : 67 - (j); const int uidx = b * 68 + cc; const size_t row0 = (size_t)b * RB + (size_t)cc * 64; \
            const size_t kb = (((size_t)dir * 136 + uidx) * 4 + h); \
            _Pragma("unroll") for (int i = 0; i < 4; ++i) { const int idx = tid + 512 * i; rq[i] = *(const u32x4*)(QD + ((size_t)dir * M + row0 + (idx >> 5)) * 1024 + h * 256 + (idx & 31) * 8); \
                rk[i] = *(const u32x4*)(KT + kb * 16384 + (size_t)idx * 8); } \
            if (tid < 256) rv = *(const u32x4*)(VT + ((size_t)uidx * 2048 + h * 512 + slice * 32 + (tid >> 3)) * 64 + (tid & 7) * 8); \
            ra = *(const u32x4*)(ATT + kb * 4096 + (size_t)tid * 8); \
            if (tid < 64) rd = *(const u32x4*)(DEC + kb * 256 + tid * 4); } while (0)
        GLA_LOAD(0);
        for (int j = 0; j < 68; ++j) {
            const int cc = dir == 0 ? (j < 4 ? 64 + j : j - 4) : 67 - j; const bool isctx = cc >= 64; const size_t row0 = (size_t)b * RB + (size_t)cc * 64;
#pragma unroll
            for (int i = 0; i < 4; ++i) { const int idx = tid + 512 * i; *(LAS u32x4*)(QDs + (idx >> 5) * 264 + (idx & 31) * 8) = rq[i]; *(LAS u32x4*)(KTs + (idx >> 3) * 72 + (idx & 7) * 8) = rk[i]; }
            if (tid < 256) *(LAS u32x4*)(VTs + (tid >> 3) * 72 + (tid & 7) * 8) = rv;
            *(LAS u32x4*)(ATs + (tid >> 3) * 72 + (tid & 7) * 8) = ra;
            if (tid < 64) *(LAS u32x4*)(DECs + tid * 4) = rd;
            __syncthreads();
            if (j + 1 < 68) GLA_LOAD(j + 1);
            bf16x8 vb[4];
#pragma unroll
            for (int ks = 0; ks < 4; ++ks) vb[ks] = *(const LAS bf16x8*)(VTs + l32 * 72 + ks * 16 + hi * 8);
            if (!isctx) {
                bf16x8 sb[2];
#pragma unroll
                for (int jj = 0; jj < 2; ++jj) { u32x4 t4 = {cvt_pk_bf16(S[8 * jj + 0], S[8 * jj + 1]), cvt_pk_bf16(S[8 * jj + 2], S[8 * jj + 3]), cvt_pk_bf16(S[8 * jj + 4], S[8 * jj + 5]), cvt_pk_bf16(S[8 * jj + 6], S[8 * jj + 7])};
                    sb[jj] = *reinterpret_cast<bf16x8*>(&t4); }
                f32x16 ao[2] = {};
#pragma unroll
                for (int tt = 0; tt < 2; ++tt)
#pragma unroll
                    for (int jj = 0; jj < 2; ++jj) { const LAS bf16_t* qp = QDs + (tt * 32 + l32) * 264 + 32 * w + 16 * jj + 4 * hi;
                        const u32x2 lo = *(const LAS u32x2*)qp, hi2 = *(const LAS u32x2*)(qp + 8); u32x4 a4 = {lo.x, lo.y, hi2.x, hi2.y};
                        ao[tt] = __builtin_amdgcn_mfma_f32_32x32x16_bf16(*reinterpret_cast<bf16x8*>(&a4), sb[jj], ao[tt], 0, 0, 0); }
                if (w < 2) {
#pragma unroll
                    for (int ks = 0; ks < 4; ++ks) { const bf16x8 af = *(const LAS bf16x8*)(ATs + (w * 32 + l32) * 72 + ks * 16 + hi * 8);
                        if (w == 0) ao[0] = __builtin_amdgcn_mfma_f32_32x32x16_bf16(af, vb[ks], ao[0], 0, 0, 0); else ao[1] = __builtin_amdgcn_mfma_f32_32x32x16_bf16(af, vb[ks], ao[1], 0, 0, 0); }
                }
#pragma unroll
                for (int tt = 0; tt < 2; ++tt)
#pragma unroll
                    for (int r = 0; r < 16; ++r) PART[(w * 64 + tt * 32 + (r & 3) + 8 * (r >> 2) + 4 * hi) * 32 + l32] = ao[tt][r];
            }
#pragma unroll
            for (int r = 0; r < 16; ++r) S[r] *= DECs[32 * w + (r & 3) + 8 * (r >> 2) + 4 * hi];
#pragma unroll
            for (int ks = 0; ks < 4; ++ks) { const bf16x8 af = *(const LAS bf16x8*)(KTs + (32 * w + l32) * 72 + ks * 16 + hi * 8);
                S = __builtin_amdgcn_mfma_f32_32x32x16_bf16(af, vb[ks], S, 0, 0, 0); }
            __syncthreads();
            if (!isctx) { const int t = tid >> 3, v4 = (tid & 7) * 4; f32x4 acc = *(const LAS f32x4*)(PART + t * 32 + v4);
#pragma unroll
                for (int ww = 1; ww < 8; ++ww) acc = acc + *(const LAS f32x4*)(PART + (ww * 64 + t) * 32 + v4);
                *(f32x4*)(Od + (row0 + t) * D + h * 512 + slice * 32 + v4) = acc; }
        }
#undef GLA_LOAD
        __syncthreads();
    }
}
__device__ __forceinline__ void phase_gla_finish(Frame& F, const float* O0, const float* O1, const bf16_t* P, const float* g, bf16_t* OUT) {
    const int gw = F.vcu * NWAVES + F.wave, NGW = F.G * NWAVES, lane = F.lane;
    const f32x4 ga = *(const f32x4*)(g + 8 * lane), gb = *(const f32x4*)(g + 8 * lane + 4);
    for (int lr = gw; lr < BATCH * SEQ; lr += NGW) {
        const size_t row = (size_t)(lr >> 12) * RB + (lr & 4095);
#pragma unroll
        for (int h = 0; h < 4; ++h) {
            const size_t o = row * D + h * 512 + 8 * lane;
            const f32x4 a0 = *(const f32x4*)(O0 + o) + *(const f32x4*)(O1 + o), a1 = *(const f32x4*)(O0 + o + 4) + *(const f32x4*)(O1 + o + 4);
            const float ss = wave_sum((a0.x * a0.x + a0.y * a0.y) + (a0.z * a0.z + a0.w * a0.w) + (a1.x * a1.x + a1.y * a1.y) + (a1.z * a1.z + a1.w * a1.w));
            const float rn = rsqrtf(ss * (1.f / 512.f) + 1e-6f);
            const u32x4 rr = *(const u32x4*)(P + row * 6400 + 4096 + h * 512 + 8 * lane);
            const float rv[8] = {bflo(rr.x), bfhi(rr.x), bflo(rr.y), bfhi(rr.y), bflo(rr.z), bfhi(rr.z), bflo(rr.w), bfhi(rr.w)};
            float y[8] = {a0.x * ga.x, a0.y * ga.y, a0.z * ga.z, a0.w * ga.w, a1.x * gb.x, a1.y * gb.y, a1.z * gb.z, a1.w * gb.w};
#pragma unroll
            for (int e = 0; e < 8; ++e) y[e] = y[e] * rn * (rv[e] / (1.f + __expf(-rv[e])));
            *(u32x4*)(OUT + o) = (u32x4){cvt_pk_bf16(y[0], y[1]), cvt_pk_bf16(y[2], y[3]), cvt_pk_bf16(y[4], y[5]), cvt_pk_bf16(y[6], y[7])};
        }
    }
}
enum { PH_PRO = 0, L0_MOD = 1, L0_CH = 2, L0_POS = 3, L0_OUT = 4, L0_FMOD = 5, L0_FIN = 6, L0_FOUT = 7,
       L1_MOD = 8, L1_IN = 9, L1_SP = 10, L1_OUT = 11, L1_FMOD = 12, L1_FIN = 13, L1_FOUT = 14,
       L2_MOD = 15, L2_QKV = 16, L2_ATT = 17, L2_CMB = 18, L2_OUT = 19, L2_FMOD = 20, L2_FIN = 21, L2_FOUT = 22,
       L3_MOD = 23, L3_IN = 24, L3_G1 = 25, L3_G2 = 26, L3_FSH = 27, L3_OUT = 28, L3_FMOD = 29, L3_FIN = 30, L3_FOUT = 31, PH_FINAL = 32, NPH = 33 };

__global__ void __launch_bounds__(NWAVES * 64, 2) mk_fwd(Args args) {
    extern __shared__ __attribute__((aligned(16))) unsigned char lds_raw[];
    Frame F;
    F.lds = (LAS unsigned char*)lds_raw; F.MISC = (volatile LAS unsigned*)(F.lds + MISC_OFF);
    F.tid = threadIdx.x; F.lane = F.tid & 63; F.wave = __builtin_amdgcn_readfirstlane(F.tid >> 6);
    F.G = gridDim.x; { const int bx = blockIdx.x; F.vcu = (F.G % 8 == 0) ? (bx % 8) * (F.G / 8) + bx / 8 : bx; }
    unsigned char* ws = args.ws; F.ctl = (unsigned*)(ws + WS_CTL);
    for (int u = F.tid; u < (LDS_BYTES - MISC_OFF) / 4; u += NWAVES * 64) ((LAS unsigned*)(F.lds + MISC_OFF))[u] = 0u;
    __syncthreads();
    const int lo = args.ph_lo, hi = args.ph_hi;
    XcdBarrier bar; bar.bar = F.ctl + args.li * XCD_BAR_WORDS; bar.x = 0; bar.st = F.MISC + 8;
    if (hi - lo > 1) bar = xcd_barrier_post(F.ctl + args.li * XCD_BAR_WORDS, F.MISC + 8);
#define IN(k) (lo <= (k) && (k) < hi)
#ifndef REP_BAR
#define REP_BAR 1
#endif
#define SEAM(k) do { if (IN(k) && IN((k) + 1)) { xcd_barrier(bar); if (REP_BAR == 2) xcd_barrier(bar); } } while (0)
#ifndef REP_POS
#define REP_POS 1
#endif
#ifndef REP_FIN
#define REP_FIN 1
#endif
#ifndef REP_MIXIN
#define REP_MIXIN 1
#endif
#ifndef REP_ATT
#define REP_ATT 1
#endif
#ifndef REP_G1
#define REP_G1 1
#endif
#ifndef REP_G2
#define REP_G2 1
#endif
#ifndef REP_PRO
#define REP_PRO 1
#endif
#ifndef REP_THIN
#define REP_THIN 1
#endif
    float* XR = (float*)(ws + WS_XR); const float* MOD = (const float*)(ws + WS_MOD);
    bf16_t* H = (bf16_t*)(ws + WS_H); bf16_t* BIG = (bf16_t*)(ws + WS_BIG);
    const int cu = (int)blockIdx.x;

    if (IN(PH_PRO)) { phase_prologue(F, args); if (REP_PRO == 2) { VM_WAIT(); __syncthreads(); phase_prologue(F, args); } SEAM(PH_PRO); }

#define KS_OUT 8
#define KS_FOUT 16
    float* PEND = (float*)(ws + WS_F1);
#define RESID_GEMM(Aptr, Btptr, KK, LD, GATE, KS, SKIPC) do { \
        { pg8::Gemm g{Aptr, Btptr, LD, LD, KK}; pg8::Sched2D S{32, D / 256, F.G, cu, LD, LD, 1}; pg8::EpiResid E{XR, GATE}; pg8::gemm_phase<pg8::EpiResid, pg8::Sched2D, true>(F.lds, g, S, E); } \
        if (!(SKIPC)) { pg8::Gemm g{Aptr, Btptr, LD, LD, (KK) / (KS)}; pg8::SchedCtxSplit S{D / 256, KS, F.G, (F.G - 1 - cu), LD, LD, (KK) / (KS)}; pg8::EpiPartial E{PEND}; pg8::gemm_phase<pg8::EpiPartial, pg8::SchedCtxSplit, true>(F.lds, g, S, E); } } while (0)
#define FFN_PHASES(l, P_FMOD, P_FIN, P_FOUT, SKIPC) \
    if (IN(P_FMOD)) { const float* mod = MOD + (size_t)(l) * 3 * NMOD; phase_modulate(F, XR, args.in[7] + (l) * D, mod + 3 * D, mod + 4 * D, H, SKIPC, (SKIPC) ? nullptr : PEND, KS_OUT, mod + 2 * D); if (REP_THIN == 2) { VM_WAIT(); __syncthreads(); phase_modulate(F, XR, args.in[7] + (l) * D, mod + 3 * D, mod + 4 * D, H, SKIPC); } SEAM(P_FMOD); } \
    if (IN(P_FIN)) { pg8::Gemm g{H, (const bf16_t*)(ws + WS_WIN_T) + (size_t)(l) * DFF * D, D, D, D}; pg8::Sched2D S{(SKIPC) ? 32 : 34, DFF / 256, F.G, cu, D, D, SKIPC, REP_FIN}; \
        pg8::EpiBf16<2> E{BIG, LDH, 1.f}; pg8::gemm_phase<pg8::EpiBf16<2>, pg8::Sched2D, true>(F.lds, g, S, E); SEAM(P_FIN); } \
    if (IN(P_FOUT)) { const float* mod = MOD + (size_t)(l) * 3 * NMOD; RESID_GEMM(BIG, (const bf16_t*)(ws + WS_WOUT_T) + (size_t)(l) * LDH * D, DFF, LDH, mod + 5 * D, KS_FOUT, SKIPC); SEAM(P_FOUT); }

    bf16_t* A2 = (bf16_t*)(ws + WS_A2);
    if (IN(L0_MOD)) { phase_modulate(F, XR, args.in[6] + 0 * D, MOD + 0 * D, MOD + 1 * D, H, false); SEAM(L0_MOD); }
    if (IN(L0_CH)) { pg8::Gemm g{(const bf16_t*)(ws + WS_TC), H, 512, D, 512}; pg8::SchedChan S{F.G, cu}; pg8::EpiChan E{BIG, BIG + (size_t)2 * 2048 * LDH};
        pg8::gemm_phase<pg8::EpiChan, pg8::SchedChan, true>(F.lds, g, S, E); SEAM(L0_CH); }
    if (IN(L0_POS)) {
        { pg8::Gemm g{(const bf16_t*)(ws + WS_PT), BIG, LDH, LDH, 8192}; pg8::SchedPosL S{F.G, cu, REP_POS}; pg8::EpiBf16<0> E{A2, D, 0.00069053396600248786f};
          pg8::gemm_phase<pg8::EpiBf16<0>, pg8::SchedPosL, true>(F.lds, g, S, E); }
        { pg8::Gemm g{(const bf16_t*)(ws + WS_PC), BIG + (size_t)2 * 2048 * LDH, 512, 512, 512}; pg8::SchedPosC S{F.G, cu}; pg8::EpiBf16<0> E{A2, D, 0.0027621358640099515f};
          pg8::gemm_phase<pg8::EpiBf16<0>, pg8::SchedPosC, true>(F.lds, g, S, E); }
        SEAM(L0_POS); }
    if (IN(L0_OUT)) { RESID_GEMM(A2, (const bf16_t*)(ws + WS_FNO_T), D, D, MOD + 2 * D, KS_OUT, 0); SEAM(L0_OUT); }
    FFN_PHASES(0, L0_FMOD, L0_FIN, L0_FOUT, 0)

    if (IN(L1_MOD)) { const float* mod = MOD + (size_t)1 * 3 * NMOD; phase_modulate(F, XR, args.in[6] + 1 * D, mod + 0 * D, mod + 1 * D, H, false, PEND, KS_FOUT, MOD + (size_t)0 * 3 * NMOD + 5 * D); SEAM(L1_MOD); }
    if (IN(L1_IN)) { pg8::Gemm g{H, (const bf16_t*)(ws + WS_GMIN_T), D, D, D}; pg8::Sched2D S{34, 16, F.G, cu, D, D, 0, REP_MIXIN}; pg8::EpiGeluStats<true> E{BIG, 4096, (float*)(ws + WS_LNS)};
        pg8::gemm_phase<pg8::EpiGeluStats<true>, pg8::Sched2D, true>(F.lds, g, S, E); SEAM(L1_IN); }
    if (IN(L1_SP)) { phase_spatial(F, BIG, (const float*)(ws + WS_LNS), args.in[13], args.in[14], (const bf16_t*)(ws + WS_GMWS), args.in[16], A2); if (REP_THIN == 2) phase_spatial(F, BIG, (const float*)(ws + WS_LNS), args.in[13], args.in[14], (const bf16_t*)(ws + WS_GMWS), args.in[16], A2); SEAM(L1_SP); }
    if (IN(L1_OUT)) { const float* mod = MOD + (size_t)1 * 3 * NMOD; RESID_GEMM(A2, (const bf16_t*)(ws + WS_GMOUT_T), D, D, mod + 2 * D, KS_OUT, 0); SEAM(L1_OUT); }
    FFN_PHASES(1, L1_FMOD, L1_FIN, L1_FOUT, 0)

    float* F1 = (float*)(ws + WS_F1); float* F2 = (float*)(ws + WS_F2);
    if (IN(L2_MOD)) { const float* mod = MOD + (size_t)2 * 3 * NMOD; phase_modulate(F, XR, args.in[6] + 2 * D, mod + 0 * D, mod + 1 * D, H, false, PEND, KS_FOUT, MOD + (size_t)1 * 3 * NMOD + 5 * D); SEAM(L2_MOD); }
    if (IN(L2_QKV)) { pg8::Gemm g{H, (const bf16_t*)(ws + WS_DFIN_T), D, D, D}; pg8::Sched2D S{34, 24, F.G, cu, D, D, 0, REP_MIXIN}; pg8::EpiQKV E{BIG, (const float*)(ws + WS_ROPE)};
        pg8::gemm_phase<pg8::EpiQKV, pg8::Sched2D, true>(F.lds, g, S, E); SEAM(L2_QKV); }
    if (IN(L2_ATT)) { phase_attention2(F, BIG, args.in[19], args.in[20], A2, REP_ATT); SEAM(L2_ATT); }
    if (IN(L2_OUT)) { const float* mod = MOD + (size_t)2 * 3 * NMOD; RESID_GEMM(A2, (const bf16_t*)(ws + WS_DFOUT_T), D, D, mod + 2 * D, KS_OUT, 0); SEAM(L2_OUT); }
    FFN_PHASES(2, L2_FMOD, L2_FIN, L2_FOUT, 0)

    if (IN(L3_MOD)) { const float* mod = MOD + (size_t)3 * 3 * NMOD; phase_modulate(F, XR, args.in[6] + 3 * D, mod + 0 * D, mod + 1 * D, H, false, PEND, KS_FOUT, MOD + (size_t)2 * 3 * NMOD + 5 * D); SEAM(L3_MOD); }
    if (IN(L3_IN)) { pg8::Gemm g{H, (const bf16_t*)(ws + WS_GLIN_T), D, D, D}; pg8::Sched2D S{34, 25, F.G, cu, D, D, 0, REP_MIXIN}; pg8::EpiGla E{BIG, (float*)(ws + G_GD)};
        pg8::gemm_phase<pg8::EpiGla, pg8::Sched2D, true>(F.lds, g, S, E); SEAM(L3_IN); }
    if (IN(L3_G1)) { phase_gla_pre(F, BIG, (const float*)(ws + G_GD), args.in[23], args.in[24], ws, REP_G1); SEAM(L3_G1); }
    if (IN(L3_G2)) { phase_gla_scan(F, ws, F1, F2, REP_G2); SEAM(L3_G2); }
    if (IN(L3_FSH)) { phase_gla_finish(F, F1, F2, BIG, args.in[25], A2); if (REP_THIN == 2) phase_gla_finish(F, F1, F2, BIG, args.in[25], A2); SEAM(L3_FSH); }
    if (IN(L3_OUT)) { const float* mod = MOD + (size_t)3 * 3 * NMOD; pg8::Gemm g{A2, (const bf16_t*)(ws + WS_GLOUT_T), D, D, D}; pg8::Sched2D S{32, D / 256, F.G, cu, D, D, 1}; pg8::EpiResid E{XR, mod + 2 * D};
        pg8::gemm_phase<pg8::EpiResid, pg8::Sched2D, true>(F.lds, g, S, E); SEAM(L3_OUT); }
    FFN_PHASES(3, L3_FMOD, L3_FIN, L3_FOUT, 1)

    if (IN(PH_FINAL)) { phase_final(F, XR, args.in[10], args.out); }
#undef IN
#undef SEAM
}
#ifndef MK_ONE_LAUNCH
#define MK_ONE_LAUNCH 1
#endif
extern "C" void kernel_launch(void* const* d_in, const int* in_sizes, int n_in, void* d_out, int out_size, void* d_ws, size_t ws_size, hipStream_t st) {
    static int grid = 0;
    if (grid == 0) {
        int dev = 0, cus = 0;
        if (hipGetDevice(&dev) != hipSuccess || hipDeviceGetAttribute(&cus, hipDeviceAttributeMultiprocessorCount, dev) != hipSuccess) { fprintf(stderr, "device query failed\n"); grid = -1; return; }
        if (hipFuncSetAttribute((const void*)mk_fwd, hipFuncAttributeMaxDynamicSharedMemorySize, LDS_BYTES) != hipSuccess) { fprintf(stderr, "hipFuncSetAttribute failed\n"); grid = -1; return; }
        if (WS_END_MK > ws_size) { fprintf(stderr, "ws too small: need %zu have %zu\n", (size_t)WS_END_MK, ws_size); grid = -1; return; }
        grid = cus;
    }
    if (grid < 0) return;
    unsigned char* wsb = (unsigned char*)d_ws;
    (void)hipMemsetAsync(wsb + WS_CTL, 0, CTL_ZERO_BYTES, st);
    Args a{};
    for (int i = 0; i < 27; ++i) a.in[i] = (const float*)d_in[i];
    a.out = (float*)d_out; a.ws = wsb;
    if (MK_ONE_LAUNCH) { a.ph_lo = 0; a.ph_hi = NPH; a.li = 0; hipLaunchKernelGGL(mk_fwd, dim3(grid), dim3(NWAVES * 64), LDS_BYTES, st, a); }
    else for (int p = 0; p < NPH; ++p) { a.ph_lo = p; a.ph_hi = p + 1; a.li = p; hipLaunchKernelGGL(mk_fwd, dim3(grid), dim3(NWAVES * 64), LDS_BYTES, st, a); }
}
```

```cpp
#include <hip/hip_runtime.h>
#include <math.h>
#include <stdio.h>
#include <stdint.h>
constexpr int D = 2048, BATCH = 2, SEQ = 4096, CTX = 256, RB = SEQ + CTX, M = BATCH * RB, DFF = 8192;
constexpr int NMOD = 6 * D;
constexpr int LDH = DFF + 64;
#define LAS __attribute__((address_space(3)))
#define GAS __attribute__((address_space(1)))
typedef unsigned short bf16_t;
typedef short bf16x8 __attribute__((ext_vector_type(8)));
typedef float f32x4 __attribute__((ext_vector_type(4)));
typedef float f32x2 __attribute__((ext_vector_type(2)));
typedef float f32x16 __attribute__((ext_vector_type(16)));
typedef unsigned u32x4 __attribute__((ext_vector_type(4)));
typedef unsigned u32x2 __attribute__((ext_vector_type(2)));
typedef short s16x4 __attribute__((ext_vector_type(4)));

__device__ __forceinline__ unsigned cvt_pk_bf16(float lo, float hi) { unsigned r; asm volatile("v_cvt_pk_bf16_f32 %0, %1, %2" : "=v"(r) : "v"(lo), "v"(hi)); return r; }
__device__ __forceinline__ float bf2f(unsigned short h) { return __uint_as_float((unsigned)h << 16); }
__device__ __forceinline__ float bflo(unsigned w) { return __uint_as_float(w << 16); }
__device__ __forceinline__ float bfhi(unsigned w) { return __uint_as_float(w & 0xffff0000u); }
#define LDS_WAIT() asm volatile("s_waitcnt lgkmcnt(0)" ::: "memory")
#define VM_WAIT() asm volatile("s_waitcnt vmcnt(0)" ::: "memory")

__device__ __forceinline__ int fresh_tid() { int t = threadIdx.x; asm volatile("" : "+v"(t)); return t; }
__device__ __forceinline__ int mrow_of_tile(int pm) { const int b = pm >= 17 ? 1 : 0; const int t = pm - 17 * b; return t == 16 ? 2 : b; }

namespace pg8 {
constexpr int BM = 256, BK = 64, HALF = 128, HTB = HALF * BK * 2, STAGE_BYTES = 8 * HTB, NXCD = 8, WGM = 8;
__host__ __device__ __forceinline__ int lds_byte(int r, int c) { const int st = (r >> 4) * 2 + (c >> 5), rr = r & 15, cc = c & 31, ob = rr * 64 + cc * 2; return st * 1024 + (ob ^ (((ob >> 9) & 1) << 5)); }
__host__ __device__ __forceinline__ void stage_rc(int b, int& R, int& C) { const int st = b / 1024, sb = b % 1024, swz = sb ^ (((sb >> 9) & 1) << 5); R = (st >> 1) * 16 + swz / 64; C = (st & 1) * 32 + (swz % 64) / 2; }
__host__ __device__ __forceinline__ int perm32(int rho) { const int n = rho >> 4, i = rho & 15; return 8 * (i >> 2) + 4 * n + (i & 3); }

struct Unit { int pm, pn, z; size_t aoff, boff; };
struct Gemm { const bf16_t* A; const bf16_t* Bt; int lda, ldb, K; };

__device__ __forceinline__ bool static_tile(int i, int G, int c, int nM, int nN, int& pm, int& pn) {
    const int nwg = nM * nN; const long L = (long)i * G + c; if (L >= nwg) return false;
    int wgid = (int)L; { const int q = nwg / NXCD, r = nwg % NXCD, xcd = wgid % NXCD, off = wgid / NXCD; wgid = (xcd < r ? xcd * (q + 1) : r * (q + 1) + (xcd - r) * q) + off; }
    const int nig = WGM * nN, gid = wgid / nig, fm = gid * WGM, gsz = (nM - fm) < WGM ? (nM - fm) : WGM;
    pm = fm + ((wgid % nig) % gsz); pn = (wgid % nig) / gsz; return true;
}
struct Sched2D {
    int nM, nN, G, c, lda, ldb, skip_ctx, rep = 1;
    __device__ __forceinline__ bool next(int i, Unit& u) const {
        int pm, pn; if (!static_tile(rep == 2 ? (i >> 1) : i, G, c, nM, nN, pm, pn)) return false;
        if (skip_ctx) pm += (pm >= 16) ? 1 : 0;
        u.pm = pm; u.pn = pn; u.z = (rep == 2) ? (i & 1) : 0; u.aoff = (size_t)pm * BM * lda * 2; u.boff = (size_t)pn * BM * ldb * 2; return true;
    }
};

template <class Epi, class Sched, bool ALIGN_EPI>
__device__ __forceinline__ void gemm_phase(LAS unsigned char* lds, const Gemm g, const Sched& S, const Epi& E) {
    const int tid = fresh_tid(), wid = __builtin_amdgcn_readfirstlane(tid >> 6), lane = tid & 63, wr = wid >> 2, wc = wid & 3, fr = lane & 15, fq = lane >> 4;
    const int nt = g.K / BK;
    unsigned voffA[2], voffB[2];
#pragma unroll
    for (int i = 0; i < 2; ++i) { int R, C; stage_rc(tid * 16 + i * 8192, R, C); const int Rb = Epi::PERM ? ((R & ~31) + perm32(R & 31)) : R;
        voffA[i] = (unsigned)(R * g.lda + C) * 2u; voffB[i] = (unsigned)(Rb * g.ldb + C) * 2u; }
    const size_t kstep = (size_t)(BK * 2);
    const size_t hstepA = (size_t)HALF * g.lda * 2, hstepB = (size_t)HALF * g.ldb * 2;
    const unsigned ldsw = (unsigned)wid * 1024u;
    const int aoff = lds_byte(wr * 64 + fr, fq * 8), boff = lds_byte(wc * 32 + fr, fq * 8);
#define PG8_SA(b, h) (((b) * 2 + (h)) * HTB)
#define PG8_SB(b, h) ((4 + (b) * 2 + (h)) * HTB)
#define PG8_STAGE(bufoff, gbase, voff) do { _Pragma("unroll") for (int _i = 0; _i < 2; ++_i) \
        __builtin_amdgcn_global_load_lds((const unsigned*)((const char*)(gbase) + (voff)[_i]), (LAS unsigned*)(lds + (bufoff) + ldsw + _i * 8192), 16, 0, 0); } while (0)
#define PG8_LDA(dst, b, h) do { _Pragma("unroll") for (int m = 0; m < 4; ++m) _Pragma("unroll") for (int k = 0; k < 2; ++k) dst[m][k] = *(const LAS bf16x8*)(lds + PG8_SA(b, h) + aoff + m * 2048 + k * 1024); } while (0)
#define PG8_LDB(dst, b, h) do { _Pragma("unroll") for (int n = 0; n < 2; ++n) _Pragma("unroll") for (int k = 0; k < 2; ++k) dst[n][k] = *(const LAS bf16x8*)(lds + PG8_SB(b, h) + boff + n * 2048 + k * 1024); } while (0)
#define PG8_MMA(ai, bj, At, Bt) do { __builtin_amdgcn_s_setprio(1); _Pragma("unroll") for (int m = 0; m < 4; ++m) _Pragma("unroll") for (int n = 0; n < 2; ++n) _Pragma("unroll") for (int k = 0; k < 2; ++k) \
        acc[ai][bj][m][n] = __builtin_amdgcn_mfma_f32_16x16x32_bf16(Bt[n][k], At[m][k], acc[ai][bj][m][n], 0, 0, 0); __builtin_amdgcn_s_setprio(0); } while (0)
#define PG8_WAIT_V(n) asm volatile("s_waitcnt vmcnt(" #n ")" ::: "memory")
#define PG8_WAIT_L(n) asm volatile("s_waitcnt lgkmcnt(" #n ")" ::: "memory")
#define PG8_BAR __builtin_amdgcn_s_barrier()
#define PG8_SCHED __builtin_amdgcn_sched_barrier(0)
    Unit cur, nxt; int ui = 0;
    if (!S.next(0, cur)) return;
    f32x4 acc[2][2][4][2];
#pragma unroll
    for (int a = 0; a < 2; ++a)
#pragma unroll
        for (int b = 0; b < 2; ++b)
#pragma unroll
            for (int m = 0; m < 4; ++m)
#pragma unroll
                for (int n = 0; n < 2; ++n) acc[a][b][m][n] = (f32x4){0.f, 0.f, 0.f, 0.f};
    bf16x8 At[4][2], B0[2][2], B1[2][2];
    const char* cA = (const char*)g.A + cur.aoff; const char* cB = (const char*)g.Bt + cur.boff;
    PG8_STAGE(PG8_SB(0, 0), cB, voffB); PG8_STAGE(PG8_SB(0, 1), cB + hstepB, voffB); PG8_STAGE(PG8_SA(0, 0), cA, voffA); PG8_STAGE(PG8_SA(0, 1), cA + hstepA, voffA);
    if (wr == 1) PG8_BAR;
    PG8_WAIT_V(2); PG8_BAR;
    PG8_STAGE(PG8_SB(1, 0), cB + kstep, voffB); PG8_STAGE(PG8_SA(1, 0), cA + kstep, voffA); PG8_STAGE(PG8_SB(1, 1), cB + hstepB + kstep, voffB);
    PG8_WAIT_V(6); PG8_BAR;
    for (;;) {
        const bool has_next = S.next(ui + 1, nxt);
        const char* nA = has_next ? (const char*)g.A + nxt.aoff : cA; const char* nB = has_next ? (const char*)g.Bt + nxt.boff : cB;
        for (int t = 0; t < nt; t += 2) {
            const bool last = (t == nt - 2);
            const char* a1 = cA + (size_t)(t + 1) * kstep;
            const char* a2 = last ? nA : cA + (size_t)(t + 2) * kstep; const char* b2 = last ? nB : cB + (size_t)(t + 2) * kstep;
            const char* a3 = a2 + kstep; const char* b3 = b2 + kstep;
            PG8_LDB(B0, 0, 0); PG8_LDB(B1, 0, 1); PG8_SCHED; PG8_LDA(At, 0, 0); PG8_STAGE(PG8_SA(1, 1), a1 + hstepA, voffA);
            PG8_WAIT_V(8); PG8_WAIT_L(0); PG8_BAR; PG8_MMA(0, 0, At, B0); PG8_MMA(0, 1, At, B1); PG8_BAR; PG8_SCHED;
            PG8_LDA(At, 0, 1); PG8_STAGE(PG8_SB(0, 0), b2, voffB); PG8_STAGE(PG8_SB(0, 1), b2 + hstepB, voffB); PG8_STAGE(PG8_SA(0, 0), a2, voffA);
            PG8_WAIT_V(8); PG8_WAIT_L(0); PG8_BAR; PG8_MMA(1, 0, At, B0); PG8_MMA(1, 1, At, B1); PG8_BAR; PG8_SCHED;
            PG8_LDB(B0, 1, 0); PG8_LDB(B1, 1, 1); PG8_SCHED; PG8_LDA(At, 1, 0); PG8_STAGE(PG8_SA(0, 1), a2 + hstepA, voffA);
            PG8_WAIT_V(8); PG8_WAIT_L(0); PG8_BAR; PG8_MMA(0, 0, At, B0); PG8_MMA(0, 1, At, B1); PG8_BAR; PG8_SCHED;
            PG8_LDA(At, 1, 1); PG8_STAGE(PG8_SB(1, 0), b3, voffB); PG8_STAGE(PG8_SB(1, 1), b3 + hstepB, voffB); PG8_STAGE(PG8_SA(1, 0), a3, voffA);
            PG8_WAIT_V(8); PG8_WAIT_L(0); PG8_BAR; PG8_MMA(1, 0, At, B0); PG8_MMA(1, 1, At, B1); PG8_BAR; PG8_SCHED;
        }
        if constexpr (ALIGN_EPI) { if (wr == 0) PG8_BAR; }
        E(acc, cur, wr, wc, fr, fq);
        if (!has_next) break;
#pragma unroll
        for (int a = 0; a < 2; ++a)
#pragma unroll
            for (int b = 0; b < 2; ++b)
#pragma unroll
                for (int m = 0; m < 4; ++m)
#pragma unroll
                    for (int n = 0; n < 2; ++n) acc[a][b][m][n] = (f32x4){0.f, 0.f, 0.f, 0.f};
        cur = nxt; cA = nA; cB = nB; ++ui;
        if constexpr (ALIGN_EPI) { if (wr == 1) PG8_BAR; }
    }
    PG8_WAIT_V(0);
    if constexpr (!ALIGN_EPI) { if (wr == 0) PG8_BAR; }
    PG8_BAR;
#undef PG8_SA
#undef PG8_SB
#undef PG8_STAGE
#undef PG8_LDA
#undef PG8_LDB
#undef PG8_MMA
#undef PG8_WAIT_V
#undef PG8_WAIT_L
#undef PG8_BAR
#undef PG8_SCHED
}

__device__ __forceinline__ f32x2 gelu_pk(f32x2 v) {
    const f32x2 av = __builtin_elementwise_abs(v), d = av * 0.2316418882f + 1.0f;
    f32x2 t; t.x = __builtin_amdgcn_rcpf(d.x); t.y = __builtin_amdgcn_rcpf(d.y);
    f32x2 q = t * 0.5307027145f + (-0.7265760135f); q = q * t + 0.7107068705f; q = q * t + (-0.142248368f); q = q * t + 0.127414796f; q = q * t;
    const f32x2 s = (v * v) * (-0.72134752044f);
    f32x2 e; e.x = __builtin_amdgcn_exp2f(s.x); e.y = __builtin_amdgcn_exp2f(s.y);
    const f32x2 m = v * (q * e), r = v - m;
    f32x2 o; o.x = v.x < 0.f ? m.x : r.x; o.y = v.y < 0.f ? m.y : r.y; return o;
}
template <int ACT> struct EpiBf16 {
    static constexpr bool PERM = true;
    bf16_t* O; int ldc; float scale;
    __device__ __forceinline__ void operator()(const f32x4 (&acc)[2][2][4][2], const Unit& u, int wr, int wc, int fr, int fq) const {
        const int row0 = u.pm * BM + wr * 64 + fr, col0 = u.pn * BM + wc * 32 + 8 * fq;
#pragma unroll
        for (int ai = 0; ai < 2; ++ai)
#pragma unroll
            for (int m = 0; m < 4; ++m) { bf16_t* rowp = O + (size_t)(row0 + ai * HALF + m * 16) * ldc + col0;
#pragma unroll
                for (int bj = 0; bj < 2; ++bj) { f32x4 v0 = acc[ai][bj][m][0], v1 = acc[ai][bj][m][1];
                    if (ACT == 2) { v0 = __builtin_elementwise_max(v0, (f32x4){0.f, 0.f, 0.f, 0.f}); v1 = __builtin_elementwise_max(v1, (f32x4){0.f, 0.f, 0.f, 0.f}); v0 = v0 * v0; v1 = v1 * v1; }
                    else { v0 = v0 * scale; v1 = v1 * scale; }
                    u32x4 w; w.x = cvt_pk_bf16(v0[0], v0[1]); w.y = cvt_pk_bf16(v0[2], v0[3]); w.z = cvt_pk_bf16(v1[0], v1[1]); w.w = cvt_pk_bf16(v1[2], v1[3]);
                    *(u32x4*)(rowp + bj * HALF) = w; } }
    }
};
struct EpiResid {
    static constexpr bool PERM = false;
    float* X; const float* gate;
    __device__ __forceinline__ void operator()(const f32x4 (&acc)[2][2][4][2], const Unit& u, int wr, int wc, int fr, int fq) const {
        const int row0 = u.pm * BM + wr * 64 + fr, col0 = u.pn * BM + wc * 32 + 4 * fq;
        const float* gp = gate + (size_t)mrow_of_tile(u.pm) * NMOD + col0; const float msk = u.z ? 0.f : 1.f;
        f32x4 gv[2][2];
#pragma unroll
        for (int bj = 0; bj < 2; ++bj)
#pragma unroll
            for (int n = 0; n < 2; ++n) gv[bj][n] = *(const f32x4*)(gp + bj * HALF + n * 16);
#pragma unroll
        for (int ai = 0; ai < 2; ++ai)
#pragma unroll
            for (int m = 0; m < 4; ++m) { float* rowp = X + (size_t)(row0 + ai * HALF + m * 16) * D + col0;
#pragma unroll
                for (int bj = 0; bj < 2; ++bj)
#pragma unroll
                    for (int n = 0; n < 2; ++n) { f32x4* p = (f32x4*)(rowp + bj * HALF + n * 16); *p = *p + gv[bj][n] * acc[ai][bj][m][n] * msk; } }
    }
};

template <bool STATS> struct EpiGeluStats {
    static constexpr bool PERM = true;
    bf16_t* O; int ldc; float* stats;
    __device__ __forceinline__ void operator()(const f32x4 (&acc)[2][2][4][2], const Unit& u, int wr, int wc, int fr, int fq) const {
        const int row0 = u.pm * BM + wr * 64 + fr, col0 = u.pn * BM + wc * 32 + 8 * fq;
        const bool st = STATS && (u.pn >= 8);
#pragma unroll
        for (int ai = 0; ai < 2; ++ai)
#pragma unroll
            for (int m = 0; m < 4; ++m) { const int row = row0 + ai * HALF + m * 16; bf16_t* rowp = O + (size_t)row * ldc + col0; float s = 0.f, q = 0.f;
#pragma unroll
                for (int bj = 0; bj < 2; ++bj) { f32x4 v0 = acc[ai][bj][m][0], v1 = acc[ai][bj][m][1];
                    f32x2 a = gelu_pk((f32x2){v0[0], v0[1]}), b = gelu_pk((f32x2){v0[2], v0[3]}), c = gelu_pk((f32x2){v1[0], v1[1]}), d = gelu_pk((f32x2){v1[2], v1[3]});
                    s += (a.x + a.y) + (b.x + b.y) + (c.x + c.y) + (d.x + d.y);
                    q += (a.x * a.x + a.y * a.y) + (b.x * b.x + b.y * b.y) + (c.x * c.x + c.y * c.y) + (d.x * d.x + d.y * d.y);
                    u32x4 w; w.x = cvt_pk_bf16(a.x, a.y); w.y = cvt_pk_bf16(b.x, b.y); w.z = cvt_pk_bf16(c.x, c.y); w.w = cvt_pk_bf16(d.x, d.y);
                    *(u32x4*)(rowp + bj * HALF) = w; }
                if (st) { s += __shfl_xor(s, 16); s += __shfl_xor(s, 32); q += __shfl_xor(q, 16); q += __shfl_xor(q, 32);
                    if (fq == 0) *(f32x2*)(stats + (((size_t)row * 8 + (u.pn - 8)) * 4 + wc) * 2) = (f32x2){s, q}; } }
    }
};
struct SchedChan {
    int G, c;
    __device__ __forceinline__ bool next(int i, Unit& u) const {
        const int L = i * G + c; if (L >= 544) return false;
        int b, g, pm, pn, ctx;
        if (L < 512) { ctx = 0; pn = L & 15; pm = (L >> 4) & 3; g = (L >> 6) & 3; b = L >> 8; }
        else { const int r = L - 512; ctx = 1; pn = 0; pm = r & 3; g = (r >> 2) & 3; b = r >> 4; }
        u.pm = pm; u.pn = pn; u.z = b | (g << 1) | (ctx << 3);
        u.aoff = (size_t)pm * BM * 512 * 2;
        u.boff = ((size_t)(b * RB + (ctx ? SEQ : pn * BM)) * D + g * 512) * 2;
        return true;
    }
};
struct EpiChan {
    static constexpr bool PERM = true;
    bf16_t* PB; bf16_t* PBc;
    __device__ __forceinline__ void operator()(const f32x4 (&acc)[2][2][4][2], const Unit& u, int wr, int wc, int fr, int fq) const {
        const int b = u.z & 1, g = (u.z >> 1) & 3, ctx = u.z >> 3;
        const int ldc = ctx ? 512 : LDH;
        bf16_t* base = (ctx ? PBc + (size_t)b * 2048 * 512 : PB + (size_t)b * 2048 * LDH) + (size_t)(g * 512 + (u.pm & 1) * 256) * ldc + (u.pm >> 1) * (ctx ? 256 : 4096) + u.pn * BM;
        const int row0 = wr * 64 + fr, col0 = wc * 32 + 8 * fq;
#pragma unroll
        for (int ai = 0; ai < 2; ++ai)
#pragma unroll
            for (int m = 0; m < 4; ++m) { bf16_t* rowp = base + (size_t)(row0 + ai * HALF + m * 16) * ldc + col0;
#pragma unroll
                for (int bj = 0; bj < 2; ++bj) { const f32x4 v0 = acc[ai][bj][m][0], v1 = acc[ai][bj][m][1];
                    u32x4 w; w.x = cvt_pk_bf16(v0[0], v0[1]); w.y = cvt_pk_bf16(v0[2], v0[3]); w.z = cvt_pk_bf16(v1[0], v1[1]); w.w = cvt_pk_bf16(v1[2], v1[3]);
                    *(u32x4*)(rowp + bj * HALF) = w; } }
    }
};
struct SchedPosL {
    int G, c, rep = 1;
    __device__ __forceinline__ bool next(int i, Unit& u) const {
        int pm, pn; if (!static_tile(rep == 2 ? (i >> 1) : i, G, c, 32, 8, pm, pn)) return false;
        const int b = pm >> 4; pm &= 15;
        u.pm = b * 17 + pm; u.pn = pn; u.z = b; u.aoff = (size_t)pm * BM * LDH * 2; u.boff = ((size_t)b * 2048 + pn * BM) * LDH * 2; return true;
    }
};
struct SchedPosC {
    int G, c;
    __device__ __forceinline__ bool next(int i, Unit& u) const {
        const int L = i * G + (G - 1 - c); if (L >= 16) return false;
        const int b = L >> 3, pn = L & 7;
        u.pm = b * 17 + 16; u.pn = pn; u.z = b; u.aoff = 0; u.boff = ((size_t)b * 2048 + pn * BM) * 512 * 2; return true;
    }
};

struct EpiQKV {
    static constexpr bool PERM = true;
    bf16_t* O; const float* rope;
    __device__ __forceinline__ void operator()(const f32x4 (&acc)[2][2][4][2], const Unit& u, int wr, int wc, int fr, int fq) const {
        const int rloc = wr * 64 + fr, col0 = u.pn * BM + wc * 32 + 8 * fq;
        const int mr = mrow_of_tile(u.pm); const bool dorope = (u.pn < 16) && (mr != 2);
        const int b = u.pm >= 17 ? 1 : 0, t0 = (u.pm - 17 * b) * BM; const int i0 = wc * 16 + 4 * fq;
        const float qs = (u.pn < 8) ? 0.12751743074602448f : 1.f;
#pragma unroll
        for (int ai = 0; ai < 2; ++ai)
#pragma unroll
            for (int m = 0; m < 4; ++m) { const int rl = rloc + ai * HALF + m * 16; bf16_t* rowp = O + (size_t)(u.pm * BM + rl) * 6144 + col0;
                f32x4 cs = {1.f, 1.f, 1.f, 1.f}, sn = {0.f, 0.f, 0.f, 0.f};
                if (dorope) { const int pos = t0 + rl; cs = *(const f32x4*)(rope + (size_t)pos * 64 + i0); sn = *(const f32x4*)(rope + (size_t)4096 * 64 + (size_t)pos * 64 + i0); }
                cs = cs * qs; sn = sn * qs;
#pragma unroll
                for (int bj = 0; bj < 2; ++bj) { const f32x4 v0 = acc[ai][bj][m][0], v1 = acc[ai][bj][m][1];
                    const float e0 = v0[0] * cs[0] - v0[1] * sn[0], o0 = v0[0] * sn[0] + v0[1] * cs[0];
                    const float e1 = v0[2] * cs[1] - v0[3] * sn[1], o1 = v0[2] * sn[1] + v0[3] * cs[1];
                    const float e2 = v1[0] * cs[2] - v1[1] * sn[2], o2 = v1[0] * sn[2] + v1[1] * cs[2];
                    const float e3 = v1[2] * cs[3] - v1[3] * sn[3], o3 = v1[2] * sn[3] + v1[3] * cs[3];
                    u32x4 w; w.x = cvt_pk_bf16(e0, o0); w.y = cvt_pk_bf16(e1, o1); w.z = cvt_pk_bf16(e2, o2); w.w = cvt_pk_bf16(e3, o3);
                    *(u32x4*)(rowp + bj * HALF) = w; } }
    }
};

struct EpiGla {
    static constexpr bool PERM = true;
    bf16_t* O; float* GD;
    __device__ __forceinline__ void operator()(const f32x4 (&acc)[2][2][4][2], const Unit& u, int wr, int wc, int fr, int fq) const {
        const int row0 = u.pm * BM + wr * 64 + fr, col0 = u.pn * BM + wc * 32 + 8 * fq;
        const bool gd = (u.pn == 24) && (wc == 0);
#pragma unroll
        for (int ai = 0; ai < 2; ++ai)
#pragma unroll
            for (int m = 0; m < 4; ++m) { const int row = row0 + ai * HALF + m * 16; bf16_t* rowp = O + (size_t)row * 6400 + col0;
#pragma unroll
                for (int bj = 0; bj < 2; ++bj) { const f32x4 v0 = acc[ai][bj][m][0], v1 = acc[ai][bj][m][1];
                    u32x4 w; w.x = cvt_pk_bf16(v0[0], v0[1]); w.y = cvt_pk_bf16(v0[2], v0[3]); w.z = cvt_pk_bf16(v1[0], v1[1]); w.w = cvt_pk_bf16(v1[2], v1[3]);
                    *(u32x4*)(rowp + bj * HALF) = w;
                    if (bj == 0 && gd) { *(f32x4*)(GD + (size_t)row * 32 + 8 * fq) = v0; *(f32x4*)(GD + (size_t)row * 32 + 8 * fq + 4) = v1; } } }
    }
};

struct SchedCtxSplit {
    int nN, KS, G, c, lda, ldb, kpiece;
    __device__ __forceinline__ bool next(int i, Unit& u) const {
        const int L = i * G + c; if (L >= 2 * nN * KS) return false;
        const int ks = L / (2 * nN), rem = L % (2 * nN), bt = rem / nN, pn = rem % nN;
        u.pm = bt ? 33 : 16; u.pn = pn; u.z = ks | (bt << 8);
        u.aoff = ((size_t)u.pm * BM * lda + (size_t)ks * kpiece) * 2; u.boff = ((size_t)pn * BM * ldb + (size_t)ks * kpiece) * 2; return true;
    }
};
struct EpiPartial {
    static constexpr bool PERM = false;
    float* PB;
    __device__ __forceinline__ void operator()(const f32x4 (&acc)[2][2][4][2], const Unit& u, int wr, int wc, int fr, int fq) const {
        const int ks = u.z & 255, bt = u.z >> 8;
        float* base = PB + ((size_t)ks * 512 + bt * 256 + wr * 64 + fr) * D + u.pn * BM + wc * 32 + 4 * fq;
#pragma unroll
        for (int ai = 0; ai < 2; ++ai)
#pragma unroll
            for (int m = 0; m < 4; ++m) { float* rowp = base + (size_t)(ai * HALF + m * 16) * D;
#pragma unroll
                for (int bj = 0; bj < 2; ++bj)
#pragma unroll
                    for (int n = 0; n < 2; ++n) *(f32x4*)(rowp + bj * HALF + n * 16) = acc[ai][bj][m][n]; }
    }
};
}

#define XB_TMO      128
#define XB_XCNT(j)  (256  + 64 * (j))
#define XB_XSUB(j)  (1280 + 64 * (j))
#define XB_XGEN(j)  (2304 + 64 * (j))
#define XB_TOP      3328
#define XB_TOPGEN   3392
#define XCD_BAR_WORDS 3456
#define XB_SPIN_CAP (1u << 18)
__device__ __forceinline__ unsigned xb_ld(unsigned* p)              { return __hip_atomic_load(p, __ATOMIC_RELAXED, __HIP_MEMORY_SCOPE_AGENT); }
__device__ __forceinline__ unsigned xb_add(unsigned* p, unsigned v) { return __hip_atomic_fetch_add(p, v, __ATOMIC_RELAXED, __HIP_MEMORY_SCOPE_AGENT); }
__device__ __forceinline__ unsigned xb_xcc_id() { return (unsigned)__builtin_amdgcn_s_getreg((3 << 11) | 20) & 0xFu; }
#define XB_SPIN(cond, bar) do { unsigned _sp = 0; while (cond) { __builtin_amdgcn_s_sleep(1); \
    if ((++_sp & 255u) == 0u) { if (xb_ld(&(bar)[XB_TMO])) break; if (_sp > XB_SPIN_CAP) { atomicAdd(&(bar)[XB_TMO], 1u); break; } } } } while (0)
struct XcdBarrier { unsigned* bar; unsigned x; volatile LAS unsigned* st; };
__device__ __forceinline__ XcdBarrier xcd_barrier_post(unsigned* bar, volatile LAS unsigned* st) {
    XcdBarrier b; b.bar = bar; b.x = xb_xcc_id(); b.st = st;
    if (threadIdx.x == 0) (void)xb_add(&bar[XB_XCNT(b.x)], 1u);
    return b;
}
__device__ __forceinline__ void xcd_barrier_complete(unsigned* bar, unsigned x, unsigned& nloc, unsigned& nx) {
    const unsigned G = gridDim.x * gridDim.y * gridDim.z;
    unsigned sum, cnt, mine, sp = 0u;
    for (;;) {
        sum = 0u; cnt = 0u; mine = 0u;
#pragma unroll
        for (unsigned j = 0; j < 16; ++j) { const unsigned c = xb_ld(&bar[XB_XCNT(j)]); sum += c; cnt += (c > 0u) ? 1u : 0u; mine = (j == x) ? c : mine; }
        if (sum == G) break;
        __builtin_amdgcn_s_sleep(1);
        if ((++sp & 255u) == 0u) { if (xb_ld(&bar[XB_TMO])) break; if (sp > XB_SPIN_CAP) { atomicAdd(&bar[XB_TMO], 1u); break; } }
    }
    nloc = mine > 0u ? mine : 1u; nx = cnt > 0u ? cnt : 1u;
}
__device__ __forceinline__ void xcd_barrier(const XcdBarrier& b) {
    asm volatile("s_waitcnt vmcnt(0)" ::: "memory");
    __syncthreads();
    if (threadIdx.x == 0) {
        unsigned* bar = b.bar;
        __builtin_amdgcn_s_waitcnt(0);
        unsigned nloc = b.st[0], nx = b.st[1];
        if (nloc == 0u) { xcd_barrier_complete(bar, b.x, nloc, nx); b.st[0] = nloc; b.st[1] = nx; }
        const unsigned old = xb_add(&bar[XB_XSUB(b.x)], 1u);
        const unsigned gen = old / nloc;
        if (old + 1u == (gen + 1u) * nloc) {
            __builtin_amdgcn_fence(__ATOMIC_RELEASE, "agent");
            asm volatile("s_waitcnt vmcnt(0)" ::: "memory");
            const unsigned og = xb_add(&bar[XB_TOP], 1u);
            const unsigned tg = og / nx;
            if (og + 1u == (tg + 1u) * nx) xb_add(&bar[XB_TOPGEN], 1u);
            else XB_SPIN(xb_ld(&bar[XB_TOPGEN]) == tg, bar);
            __builtin_amdgcn_fence(__ATOMIC_ACQUIRE, "agent");
            xb_add(&bar[XB_XGEN(b.x)], 1u);
            asm volatile("s_waitcnt vmcnt(0)" ::: "memory");
        } else {
            XB_SPIN(xb_ld(&bar[XB_XGEN(b.x)]) == gen, bar);
            __builtin_amdgcn_fence(__ATOMIC_ACQUIRE, "agent");
            asm volatile("s_waitcnt vmcnt(0)" ::: "memory");
        }
    }
    __syncthreads();
}
constexpr size_t MiB = 1u << 20;
constexpr size_t WS_CTL = 0, CTL_ZERO_BYTES = 4 * MiB;
constexpr size_t WS_MOD = 1 * MiB;
constexpr size_t WS_WIN_T = 4 * MiB;
constexpr size_t WS_WOUT_T = WS_WIN_T + 128 * MiB;
constexpr size_t WS_FNO_T = WS_WOUT_T + 130 * MiB;
constexpr size_t WS_GMIN_T = WS_FNO_T + 8 * MiB;
constexpr size_t WS_GMOUT_T = WS_GMIN_T + 16 * MiB;
constexpr size_t WS_DFIN_T = WS_GMOUT_T + 8 * MiB;
constexpr size_t WS_DFOUT_T = WS_DFIN_T + 24 * MiB;
constexpr size_t WS_GLIN_T = WS_DFOUT_T + 8 * MiB;
constexpr size_t WS_GLOUT_T = WS_GLIN_T + 25 * MiB;
constexpr size_t WS_TC = WS_GLOUT_T + 8 * MiB;
constexpr size_t WS_PT = WS_TC + 1 * MiB;
constexpr size_t WS_PC = WS_PT + 65 * MiB;
constexpr size_t WS_ROPE = WS_PC + 1 * MiB;
constexpr size_t WS_GMWS = WS_ROPE + 2 * MiB;
constexpr size_t WS_XR = WS_GMWS + 1 * MiB;
constexpr size_t WS_H = WS_XR + 68 * MiB;
constexpr size_t WS_BIG = WS_H + 34 * MiB;
constexpr size_t WS_A2 = WS_BIG + 138 * MiB;
constexpr size_t WS_F1 = WS_A2 + 34 * MiB;
constexpr size_t WS_F2 = WS_F1 + 68 * MiB;
constexpr size_t WS_LNS = WS_F1;
constexpr size_t WS_G1 = WS_F2 + 68 * MiB;
constexpr size_t WS_NAIVE = WS_G1 + 128 * MiB;
constexpr size_t WS_END_MK = WS_NAIVE;

constexpr int NWAVES = 8;
constexpr int RING_BYTES = 131072, LDS_BYTES = 163840, MISC_OFF = LDS_BYTES - 1024;

struct Args { const float* in[27]; float* out; unsigned char* ws; int ph_lo, ph_hi, li, pad; };

struct Frame {
    LAS unsigned char* lds; volatile LAS unsigned* MISC; unsigned* ctl;
    int tid, lane, wave, vcu, G;
};
__device__ __forceinline__ float wave_sum(float v) {
#pragma unroll
    for (int o = 1; o < 64; o <<= 1) v += __shfl_xor(v, o);
    return v;
}
__device__ __forceinline__ unsigned f2bf(float f) { unsigned u = __float_as_uint(f); return (u + 0x7fffu + ((u >> 16) & 1u)) >> 16; }
__device__ __forceinline__ unsigned pk2(float lo, float hi) { return f2bf(lo) | (f2bf(hi) << 16); }

template <int MAP>
__device__ __forceinline__ void transpose_item(const float* W, int K, int N, bf16_t* WT, int ldt, LAS float* scr, int item, int lane) {
    const int nblk = (N + 63) / 64, kb = item / nblk, nb = item % nblk, k0 = 64 * kb, n0 = 64 * nb;
    const int c4 = (lane & 15) * 4; const bool cok = n0 + c4 < N;
#pragma unroll 8
    for (int i = 0; i < 16; ++i) { const int kk = 4 * i + (lane >> 4); f32x4 v = {0.f, 0.f, 0.f, 0.f}; if (cok) v = *(const f32x4*)(W + (size_t)(k0 + kk) * N + n0 + c4);
        LAS float* d = scr + kk * 65 + c4; d[0] = v.x; d[1] = v.y; d[2] = v.z; d[3] = v.w; }
    LDS_WAIT(); asm volatile("" ::: "memory");
    const int c = lane & 7;
#pragma unroll
    for (int j = 0; j < 8; ++j) { const int n = (lane >> 3) + 8 * j; const LAS float* s = scr + (8 * c) * 65 + n;
        u32x4 o; o.x = pk2(s[0 * 65], s[1 * 65]); o.y = pk2(s[2 * 65], s[3 * 65]); o.z = pk2(s[4 * 65], s[5 * 65]); o.w = pk2(s[6 * 65], s[7 * 65]);
        int nn = n0 + n;
        if (nn < N) {
            if (MAP == 1) { if (nn < 4096) { const int blk = nn >> 7, w = nn & 127, sgn = w >> 6, i2 = w & 63; nn = blk * 128 + 2 * i2 + sgn; } }
            *(u32x4*)(WT + (size_t)nn * ldt + k0 + 8 * c) = o; } }
    LDS_WAIT(); asm volatile("" ::: "memory");
}
template <int MAP>
__device__ __forceinline__ void transpose_all(Frame& F, const float* W, int K, int N, bf16_t* WT, int ldt = 0) {
    const int f_tid = fresh_tid(), f_lane = f_tid & 63, f_wave = __builtin_amdgcn_readfirstlane(f_tid >> 6); (void)f_lane; (void)f_wave;
    if (ldt == 0) ldt = K;
    LAS float* scr = (LAS float*)(F.lds + f_wave * 16896);
    const int gw = F.vcu * NWAVES + f_wave, NGW = F.G * NWAVES, nitems = (K / 64) * ((N + 63) / 64);
    for (int it = gw; it < nitems; it += NGW) transpose_item<MAP>(W, K, N, WT, ldt, scr, it, f_lane);
}

template <int MAP = 0>
__device__ __forceinline__ void transpose_part(Frame& F, const float* W, int K, int N, bf16_t* WT, int ldt, int part, int nparts) {
    const int f_tid = fresh_tid(), f_lane = f_tid & 63, f_wave = __builtin_amdgcn_readfirstlane(f_tid >> 6);
    LAS float* scr = (LAS float*)(F.lds + f_wave * 16896);
    const int nitems = (K / 64) * ((N + 63) / 64);
    for (int it = part * NWAVES + f_wave; it < nitems; it += nparts * NWAVES) transpose_item<MAP>(W, K, N, WT, ldt, scr, it, f_lane);
}

__device__ __forceinline__ void phase_prologue(Frame& F, const Args& a) {
    const int f_tid = fresh_tid(), f_lane = f_tid & 63, f_wave = __builtin_amdgcn_readfirstlane(f_tid >> 6); (void)f_lane; (void)f_wave;
    unsigned char* ws = a.ws;
    const int gw = F.vcu * NWAVES + f_wave, NGW = F.G * NWAVES, lane = f_lane;
    {
        float* XR = (float*)(ws + WS_XR);
        for (int row = gw; row < M; row += NGW) {
            const int b = row >= RB ? 1 : 0, t = row - b * RB;
            const float* src = t < SEQ ? a.in[0] + (size_t)(b * SEQ + t) * D : a.in[2] + (size_t)(b * CTX + (t - SEQ)) * D;
            const f32x4* s4 = (const f32x4*)src + lane; f32x4* d4 = (f32x4*)(XR + (size_t)row * D) + lane;
#pragma unroll
            for (int j = 0; j < 8; ++j) d4[64 * j] = s4[64 * j];
        }
    }
    if (F.vcu < 192) {
        float* MOD = (float*)(ws + WS_MOD);
        const float* c = a.in[1]; const float* cc = a.in[3]; const float* wa = a.in[4]; const float* ba = a.in[5];
        const int l = F.vcu / 48, jg = F.vcu % 48, col = jg * 256 + 4 * lane, w = f_wave;
        const float* wp = wa + ((size_t)l * D + w * 256) * NMOD + col;
        f32x4 a0 = {0.f, 0.f, 0.f, 0.f}, a1 = a0, a2 = a0;
#pragma unroll 8
        for (int k = 0; k < 256; ++k) {
            const f32x4 wv = *(const f32x4*)(wp + (size_t)k * NMOD);
            const int kk = w * 256 + k;
            float c0 = c[kk], c1 = c[D + kk], c2 = cc[kk];
            c0 = c0 / (1.f + __expf(-c0)); c1 = c1 / (1.f + __expf(-c1)); c2 = c2 / (1.f + __expf(-c2));
            a0 = a0 + wv * c0; a1 = a1 + wv * c1; a2 = a2 + wv * c2;
        }
        LAS float* part = (LAS float*)F.lds;
        *(LAS f32x4*)(part + (w * 3 + 0) * 256 + 4 * lane) = a0; *(LAS f32x4*)(part + (w * 3 + 1) * 256 + 4 * lane) = a1; *(LAS f32x4*)(part + (w * 3 + 2) * 256 + 4 * lane) = a2;
        __syncthreads();
        for (int i = f_tid; i < 768; i += NWAVES * 64) { const int r = i >> 8, cj = i & 255; float sacc = ba[(size_t)l * NMOD + jg * 256 + cj];
#pragma unroll
            for (int ww = 0; ww < 8; ++ww) sacc += part[(ww * 3 + r) * 256 + cj];
            MOD[((size_t)l * 3 + r) * NMOD + jg * 256 + cj] = sacc; }
        __syncthreads();
    }
    transpose_all<0>(F, a.in[8], D, DFF, (bf16_t*)(ws + WS_WIN_T));
    transpose_all<0>(F, a.in[9], DFF, D, (bf16_t*)(ws + WS_WOUT_T), LDH);
    transpose_all<0>(F, a.in[11], D, D, (bf16_t*)(ws + WS_FNO_T));
    transpose_all<0>(F, a.in[12], D, 4096, (bf16_t*)(ws + WS_GMIN_T));
    transpose_all<1>(F, a.in[18], D, 6144, (bf16_t*)(ws + WS_DFIN_T));
    transpose_all<0>(F, a.in[21], D, D, (bf16_t*)(ws + WS_DFOUT_T));
    transpose_all<0>(F, a.in[22], D, 6176, (bf16_t*)(ws + WS_GLIN_T));
    transpose_all<0>(F, a.in[26], D, D, (bf16_t*)(ws + WS_GLOUT_T));
    {
        u32x4* z = (u32x4*)((bf16_t*)(ws + WS_GLIN_T) + (size_t)6176 * D);
        const int n16 = 224 * D * 2 / 16;
        for (int i = gw * 64 + lane; i < n16; i += NGW * 64) z[i] = (u32x4){0u, 0u, 0u, 0u};
    }
    {
        bf16_t* TC = (bf16_t*)(ws + WS_TC); bf16_t* PT = (bf16_t*)(ws + WS_PT); bf16_t* PC = (bf16_t*)(ws + WS_PC);
        const int gt = gw * 64 + lane, NT = NGW * 64;
        for (int i = gt; i < 4096 * 8192 / 8; i += NT) {
            const int k = i >> 10, j0 = (i & 1023) * 8; const bool isn = j0 >= 4096; const int n0 = j0 & 4095; unsigned w[4];
#pragma unroll
            for (int e = 0; e < 8; e += 2) { float s0, c0, s1, c1; sincospif((float)((k * (n0 + e)) & 4095) * (1.f / 2048.f), &s0, &c0); sincospif((float)((k * (n0 + e + 1)) & 4095) * (1.f / 2048.f), &s1, &c1);
                w[e >> 1] = isn ? pk2(-s0, -s1) : pk2(c0, c1); }
            *(u32x4*)(PT + (size_t)k * LDH + j0) = (u32x4){w[0], w[1], w[2], w[3]};
        }
        for (int i = gt; i < 1024 * 512 / 8; i += NT) {
            const int r = i >> 6, c0 = (i & 63) * 8; const bool isn = r >= 512; const int rr = r & 511; unsigned w[4];
#pragma unroll
            for (int e = 0; e < 8; e += 2) { float s0, cc0, s1, cc1; sincospif((float)((rr * (c0 + e)) & 511) * (1.f / 256.f), &s0, &cc0); sincospif((float)((rr * (c0 + e + 1)) & 511) * (1.f / 256.f), &s1, &cc1);
                w[e >> 1] = isn ? pk2(s0, s1) : pk2(cc0, cc1); }
            *(u32x4*)(TC + (size_t)r * 512 + c0) = (u32x4){w[0], w[1], w[2], w[3]};
        }
        for (int i = gt; i < 256 * 512 / 8; i += NT) {
            const int k = i >> 6, j0 = (i & 63) * 8; const bool isn = j0 >= 256; const int n0 = j0 & 255; unsigned w[4];
#pragma unroll
            for (int e = 0; e < 8; e += 2) { float s0, c0, s1, c1; sincospif((float)((k * (n0 + e)) & 255) * (1.f / 128.f), &s0, &c0); sincospif((float)((k * (n0 + e + 1)) & 255) * (1.f / 128.f), &s1, &c1);
                w[e >> 1] = isn ? pk2(-s0, -s1) : pk2(c0, c1); }
            *(u32x4*)(PC + (size_t)k * 512 + j0) = (u32x4){w[0], w[1], w[2], w[3]};
        }
        {
            float* rc = (float*)(ws + WS_ROPE); float* rs = rc + 4096 * 64;
            for (int i = gt; i < 4096 * 64; i += NT) { const int pos = i >> 6, j = i & 63; const float inv = powf(10000.f, -(float)(j & 31) * (1.f / 32.f));
                const float ang = (float)(j < 32 ? (pos >> 6) : (pos & 63)) * inv; float sn, cs; sincosf(ang, &sn, &cs); rc[i] = cs; rs[i] = sn; }
        }
        const float* wsf = a.in[15]; bf16_t* wsb = (bf16_t*)(ws + WS_GMWS);
        for (int i = gt; i < 16 * 128 * 128 / 8; i += NT) { const f32x4 x0 = *(const f32x4*)(wsf + (size_t)i * 8), x1 = *(const f32x4*)(wsf + (size_t)i * 8 + 4);
            *(u32x4*)(wsb + (size_t)i * 8) = (u32x4){pk2(x0.x, x0.y), pk2(x0.z, x0.w), pk2(x1.x, x1.y), pk2(x1.z, x1.w)}; }
    }
}

__device__ __forceinline__ void phase_modulate(Frame& F, float* X, const float* g, const float* shift, const float* scale, bf16_t* H, bool skip_ctx, const float* pend = nullptr, int pend_ks = 0, const float* pgate = nullptr) {
    const int f_tid = fresh_tid(), f_lane = f_tid & 63, f_wave = __builtin_amdgcn_readfirstlane(f_tid >> 6); (void)f_lane; (void)f_wave;
    const int gw = F.vcu * NWAVES + f_wave, NGW = F.G * NWAVES, lane = f_lane;
    for (int row = gw; row < M; row += NGW) {
        const int mr = mrow_of_tile(row >> 8);
        if (skip_ctx && mr == 2) continue;
        f32x4* xr = (f32x4*)(X + (size_t)row * D) + lane;
        f32x4 v[8]; float s = 0.f;
#pragma unroll
        for (int j = 0; j < 8; ++j) v[j] = xr[64 * j];
        if (pend && mr == 2) {
            const int b = row >= RB ? 1 : 0, cr = b * 256 + (row - b * RB - SEQ);
            f32x4 ps[8];
#pragma unroll
            for (int j = 0; j < 8; ++j) ps[j] = (f32x4){0.f, 0.f, 0.f, 0.f};
            for (int ks = 0; ks < pend_ks; ++ks) { const f32x4* pp = (const f32x4*)(pend + ((size_t)ks * 512 + cr) * D) + lane;
#pragma unroll
                for (int j = 0; j < 8; ++j) ps[j] = ps[j] + pp[64 * j]; }
            const f32x4* pg4 = (const f32x4*)(pgate + (size_t)2 * NMOD) + lane;
#pragma unroll
            for (int j = 0; j < 8; ++j) { v[j] = v[j] + pg4[64 * j] * ps[j]; xr[64 * j] = v[j]; }
        }
#pragma unroll
        for (int j = 0; j < 8; ++j) s += (v[j].x * v[j].x + v[j].y * v[j].y) + (v[j].z * v[j].z + v[j].w * v[j].w);
        const float r = rsqrtf(wave_sum(s) * (1.f / D) + 1e-6f);
        const f32x4* g4 = (const f32x4*)g + lane; const f32x4* sc4 = (const f32x4*)(scale + (size_t)mr * NMOD) + lane; const f32x4* sh4 = (const f32x4*)(shift + (size_t)mr * NMOD) + lane;
        u32x2* o8 = (u32x2*)(H + (size_t)row * D) + lane;
#pragma unroll
        for (int j = 0; j < 8; ++j) { const f32x4 o = v[j] * r * g4[64 * j] * (sc4[64 * j] + 1.f) + sh4[64 * j];
            u32x2 w; w.x = cvt_pk_bf16(o.x, o.y); w.y = cvt_pk_bf16(o.z, o.w); o8[64 * j] = w; }
    }
}
__device__ __forceinline__ void phase_final(Frame& F, const float* X, const float* g, float* out) {
    const int f_tid = fresh_tid(), f_lane = f_tid & 63, f_wave = __builtin_amdgcn_readfirstlane(f_tid >> 6); (void)f_lane; (void)f_wave;
    const int gw = F.vcu * NWAVES + f_wave, NGW = F.G * NWAVES, lane = f_lane;
    for (int orow = gw; orow < BATCH * SEQ; orow += NGW) {
        const int b = orow >> 12, t = orow & 4095;
        const f32x4* xr = (const f32x4*)(X + (size_t)(b * RB + t) * D) + lane;
        f32x4 v[8]; float s = 0.f;
#pragma unroll
        for (int j = 0; j < 8; ++j) { v[j] = xr[64 * j]; s += (v[j].x * v[j].x + v[j].y * v[j].y) + (v[j].z * v[j].z + v[j].w * v[j].w); }
        const float r = rsqrtf(wave_sum(s) * (1.f / D) + 1e-6f);
        const f32x4* g4 = (const f32x4*)g + lane; f32x4* o4 = (f32x4*)(out + (size_t)orow * D) + lane;
#pragma unroll
        for (int j = 0; j < 8; ++j) o4[64 * j] = v[j] * r * g4[64 * j];
    }
}

__device__ __forceinline__ void phase_spatial(Frame& F, const bf16_t* Z, const float* LNS, const float* ln_g, const float* ln_b, const bf16_t* WsB, const float* b_s, bf16_t* OUT) {
    const int f_tid = fresh_tid(), f_lane = f_tid & 63, f_wave = __builtin_amdgcn_readfirstlane(f_tid >> 6); (void)f_lane; (void)f_wave;
    LAS bf16_t* VT = (LAS bf16_t*)(F.lds); LAS float* S = (LAS float*)(F.lds + 36864); LAS float* ST = (LAS float*)(F.lds + 104448);
    const int tid = f_tid, lane = f_lane, w = f_wave, l32 = lane & 31, hi = lane >> 5;
    for (int unit = F.vcu; unit < 68 * 16; unit += F.G) {
        const int chunk = unit >> 4, h = unit & 15; const int row0 = chunk * 128;
        if (tid < 128) { float sm = 0.f, sq = 0.f; const f32x2* pp = (const f32x2*)(LNS + (size_t)(row0 + tid) * 64);
#pragma unroll
            for (int j = 0; j < 32; ++j) { const f32x2 t = pp[j]; sm += t.x; sq += t.y; }
            const float mu = sm * (1.f / 2048.f); const float var = sq * (1.f / 2048.f) - mu * mu;
            ST[tid * 2] = mu; ST[tid * 2 + 1] = rsqrtf(fmaxf(var, 0.f) + 1e-5f); }
        __syncthreads();
#pragma unroll
        for (int i = 0; i < 4; ++i) { const int idx = tid + 512 * i, q = idx >> 4, e8 = (idx & 15) * 8;
            const u32x4 raw = *(const u32x4*)(Z + (size_t)(row0 + q) * 4096 + 2048 + h * 128 + e8);
            const float mu = ST[q * 2], rs = ST[q * 2 + 1];
            const f32x4 g0 = *(const f32x4*)(ln_g + h * 128 + e8), g1 = *(const f32x4*)(ln_g + h * 128 + e8 + 4), b0 = *(const f32x4*)(ln_b + h * 128 + e8), b1 = *(const f32x4*)(ln_b + h * 128 + e8 + 4);
            float v[8] = {bflo(raw.x), bfhi(raw.x), bflo(raw.y), bfhi(raw.y), bflo(raw.z), bfhi(raw.z), bflo(raw.w), bfhi(raw.w)};
            const float gg[8] = {g0.x, g0.y, g0.z, g0.w, g1.x, g1.y, g1.z, g1.w}, bb[8] = {b0.x, b0.y, b0.z, b0.w, b1.x, b1.y, b1.z, b1.w};
#pragma unroll
            for (int j = 0; j < 8; ++j) { const float o = (v[j] - mu) * rs * gg[j] + bb[j]; VT[(e8 + j) * 136 + q] = (bf16_t)f2bf(o); } }
        __syncthreads();
        const int pt = w >> 1, et0 = (w & 1) * 2;
        f32x16 acc0 = {}, acc1 = {};
        const bf16_t* Ap = WsB + ((size_t)h * 128 + pt * 32 + l32) * 128 + hi * 8;
#pragma unroll
        for (int ks = 0; ks < 8; ++ks) {
            const bf16x8 af = *(const bf16x8*)(Ap + ks * 16);
            const bf16x8 b0 = *(const LAS bf16x8*)(VT + (et0 * 32 + l32) * 136 + ks * 16 + hi * 8);
            const bf16x8 b1 = *(const LAS bf16x8*)(VT + ((et0 + 1) * 32 + l32) * 136 + ks * 16 + hi * 8);
            acc0 = __builtin_amdgcn_mfma_f32_32x32x16_bf16(af, b0, acc0, 0, 0, 0);
            acc1 = __builtin_amdgcn_mfma_f32_32x32x16_bf16(af, b1, acc1, 0, 0, 0);
        }
#pragma unroll
        for (int r = 0; r < 16; ++r) { const int p = pt * 32 + (r & 3) + 8 * (r >> 2) + 4 * hi; const float bs = b_s[h * 128 + p];
            S[p * 132 + et0 * 32 + l32] = acc0[r] + bs; S[p * 132 + (et0 + 1) * 32 + l32] = acc1[r] + bs; }
        __syncthreads();
#pragma unroll
        for (int i = 0; i < 4; ++i) { const int idx = tid + 512 * i, p = idx >> 4, e8 = (idx & 15) * 8;
            const u32x4 raw = *(const u32x4*)(Z + (size_t)(row0 + p) * 4096 + h * 128 + e8);
            const LAS float* sp = S + p * 132 + e8;
            u32x4 o; o.x = cvt_pk_bf16(bflo(raw.x) * sp[0], bfhi(raw.x) * sp[1]); o.y = cvt_pk_bf16(bflo(raw.y) * sp[2], bfhi(raw.y) * sp[3]);
            o.z = cvt_pk_bf16(bflo(raw.z) * sp[4], bfhi(raw.z) * sp[5]); o.w = cvt_pk_bf16(bflo(raw.w) * sp[6], bfhi(raw.w) * sp[7]);
            *(u32x4*)(OUT + (size_t)(row0 + p) * D + h * 128 + e8) = o; }
        __syncthreads();
    }
}

__device__ __forceinline__ void phase_lnstats(Frame& F, const bf16_t* Z, float* LNS) {
    const int f_tid = fresh_tid(), f_lane = f_tid & 63, f_wave = __builtin_amdgcn_readfirstlane(f_tid >> 6); (void)f_lane; (void)f_wave;
    const int gw = F.vcu * NWAVES + f_wave, NGW = F.G * NWAVES, lane = f_lane;
    for (int row = gw; row < M; row += NGW) {
        const u32x4* zr = (const u32x4*)(Z + (size_t)row * 4096 + 2048) + lane; float s = 0.f, q = 0.f;
#pragma unroll
        for (int j = 0; j < 4; ++j) { const u32x4 r = zr[64 * j]; const float v[8] = {bflo(r.x), bfhi(r.x), bflo(r.y), bfhi(r.y), bflo(r.z), bfhi(r.z), bflo(r.w), bfhi(r.w)};
#pragma unroll
            for (int e = 0; e < 8; ++e) { s += v[e]; q += v[e] * v[e]; } }
        s = wave_sum(s); q = wave_sum(q);
        if (lane < 32) *(f32x2*)(LNS + (size_t)row * 64 + lane * 2) = lane == 0 ? (f32x2){s, q} : (f32x2){0.f, 0.f};
    }
}
namespace attn2 {
using bf16 = unsigned short;
constexpr float THR2 = 11.5f;
#define KSWZ(row, colB) ((row) * 256 + ((colB) ^ (((row) & 7) << 4)))
#define SBAR() __builtin_amdgcn_sched_barrier(0)
__device__ __forceinline__ int crow(int r, int hi) { return (r & 3) + 8 * (r >> 2) + 4 * hi; }
__device__ __forceinline__ unsigned cvtpk(float lo, float hi) { unsigned r; asm volatile("v_cvt_pk_bf16_f32 %0, %1, %2" : "=v"(r) : "v"(lo), "v"(hi)); return r; }
__device__ __forceinline__ int v_rd_base(int lane) { return ((lane & 3) << 3) | (((lane >> 2) & 3) << 6) | (((lane >> 4) & 1) << 5) | (((lane >> 5) & 1) << 8); }
constexpr int v_rd_off(int d0, int ks, int half) { return (d0 >> 2) * 16384 + (d0 & 3) * 512 + ks * 4096 + half * 2048; }
template <int OFF> __device__ __forceinline__ s16x4 tr_read(int vb) {
  s16x4 r; asm volatile("ds_read_b64_tr_b16 %0, %1 offset:%2" : "=&v"(r) : "v"(vb), "i"(OFF) : "memory"); return r;
}
#define TRD(D0, HF, A0, A1, A2, A3) do { A0 = tr_read<v_rd_off(D0, 2 * HF, 0)>(vb); A1 = tr_read<v_rd_off(D0, 2 * HF, 1)>(vb); A2 = tr_read<v_rd_off(D0, 2 * HF + 1, 0)>(vb); A3 = tr_read<v_rd_off(D0, 2 * HF + 1, 1)>(vb); } while (0)
#define PVM(OD, A0, A1, A2, A3) do { OD = __builtin_amdgcn_mfma_f32_32x32x16_bf16(paA, (bf16x8){A0[0], A0[1], A0[2], A0[3], A1[0], A1[1], A1[2], A1[3]}, OD, 0, 0, 0); \
    OD = __builtin_amdgcn_mfma_f32_32x32x16_bf16(paB, (bf16x8){A2[0], A2[1], A2[2], A2[3], A3[0], A3[1], A3[2], A3[3]}, OD, 0, 0, 0); } while (0)
#define LW(n) do { asm volatile("s_waitcnt lgkmcnt(" #n ")" ::: "memory"); SBAR(); } while (0)
template <int HF> __device__ __forceinline__ void pv_all(f32x16* o, int vb, bf16x8 paA, bf16x8 paB) {
  s16x4 a0, a1, a2, a3, b0, b1, b2, b3;
  TRD(0, HF, a0, a1, a2, a3); TRD(1, HF, b0, b1, b2, b3); LW(4); PVM(o[0], a0, a1, a2, a3); SBAR();
  TRD(2, HF, a0, a1, a2, a3); LW(4); PVM(o[1], b0, b1, b2, b3); SBAR();
  TRD(3, HF, b0, b1, b2, b3); LW(4); PVM(o[2], a0, a1, a2, a3); SBAR();
  TRD(4, HF, a0, a1, a2, a3); LW(4); PVM(o[3], b0, b1, b2, b3); SBAR();
  TRD(5, HF, b0, b1, b2, b3); LW(4); PVM(o[4], a0, a1, a2, a3); SBAR();
  TRD(6, HF, a0, a1, a2, a3); LW(4); PVM(o[5], b0, b1, b2, b3); SBAR();
  TRD(7, HF, b0, b1, b2, b3); LW(4); PVM(o[6], a0, a1, a2, a3); SBAR();
  LW(0); PVM(o[7], b0, b1, b2, b3); SBAR();
}
#undef TRD
#undef PVM
#undef LW
__device__ __forceinline__ void unit(const bf16* __restrict__ Qb, const bf16* __restrict__ Kb, const bf16* __restrict__ Vb, bf16* __restrict__ Ob, int seq, float lam, const float* __restrict__ gsub, LAS unsigned char* lds) {
  const int tid = fresh_tid(), wid = __builtin_amdgcn_readfirstlane(tid >> 6), lane = tid & 63, r32 = lane & 31, hi = lane >> 5, comp = wid >> 2, wq = wid & 3;
  lam = __int_as_float(__builtin_amdgcn_readfirstlane(__float_as_int(lam)));
  LAS float* wsf = (LAS float*)(lds + 131072) + wid * 64;
  float m_reg = -1e30f, l_reg = 0.f; f32x16 o[8] = {}; bf16x8 qr[8];
  { const bf16* Qw = Qb + (long)(wq * 32 + r32) * 6144 + comp * 128 + hi * 8;
#pragma unroll
    for (int d0 = 0; d0 < 8; ++d0) qr[d0] = *reinterpret_cast<const bf16x8*>(Qw + d0 * 16); }
  const int mat = wid >> 1; const bf16* sbase = (mat < 2) ? Kb + mat * 128 : Vb + (mat - 2) * 128;
  const int rstep1 = (mat < 2) ? 4 * 6144 : 0, rstepV2 = (mat < 2) ? 0 : 4 * 6144, rstepV4 = (mat < 2) ? 0 : 16 * 6144;
#define SOFF(i) (s0 + (unsigned)((i) * rstep1 + (((i) >> 1) & 1) * rstepV2 + (((i) >> 2) & 1) * rstepV4 + ((i) & 1) * dodd))
#define ISSUE(t, buf) do { const int ln_ = fresh_tid() & 63; unsigned s0; int dodd;     \
    if (mat < 2) { const int ce = ((ln_ & 15) ^ (ln_ >> 4)) * 8; s0 = (unsigned)(((wid & 1) * 32 + (ln_ >> 4)) * 6144 + ce); dodd = (ce & 32) ? -32 : 32; } \
    else { s0 = (unsigned)(((wid & 1) * 32 + ((ln_ >> 4) & 1) * 8 + ((ln_ >> 2) & 3)) * 6144 + (ln_ >> 5) * 32 + (ln_ & 3) * 8); dodd = 64; } \
    const bf16* _s = sbase + (long)(t) * 64 * 6144; _Pragma("unroll") for (int _i = 0; _i < 8; ++_i) \
    __builtin_amdgcn_global_load_lds((const unsigned*)(_s + SOFF(_i)), (LAS unsigned*)(lds + (buf) * 65536 + wid * 8192 + _i * 1024), 16, 0, 0); } while (0)
  int kbase[4];
#pragma unroll
  for (int q = 0; q < 4; ++q) kbase[q] = r32 * 256 + ((q * 32 + hi * 16) ^ ((r32 & 7) << 4));
  const int NT = seq >> 6;
  ISSUE(0, 0); asm volatile("s_waitcnt vmcnt(0)" ::: "memory"); __syncthreads();
  if (comp == 0) {
  for (int j = 0; j < NT; ++j) {
    const int buf = j & 1;
    if (j + 1 < NT) ISSUE(j + 1, buf ^ 1);
    const LAS unsigned char* Ks = lds + buf * 65536 + comp * 16384;
    const int vb = (int)(uintptr_t)(lds + buf * 65536 + 32768) + v_rd_base(lane);
#pragma unroll
    for (int hf = 0; hf < 2; ++hf) {
      f32x16 p = {};
#pragma unroll
      for (int d0 = 0; d0 < 8; ++d0) { const bf16x8 b0 = *reinterpret_cast<const LAS bf16x8*>(Ks + kbase[d0 & 3] + (d0 >> 2) * 128 + hf * 8192);
        p = __builtin_amdgcn_mfma_f32_32x32x16_bf16(b0, qr[d0], p, 0, 0, 0); }
      float pmax = p[0];
#pragma unroll
      for (int r = 1; r < 16; ++r) pmax = fmaxf(pmax, p[r]);
      { auto rr = __builtin_amdgcn_permlane32_swap(__float_as_uint(pmax), __float_as_uint(pmax), false, false); pmax = fmaxf(__uint_as_float(rr[0]), __uint_as_float(rr[1])); }
      float mn, alpha;
      if (__builtin_expect(__all(pmax - m_reg <= THR2), 1)) { mn = m_reg; alpha = 1.f; }
      else { mn = fmaxf(m_reg, pmax); alpha = __builtin_amdgcn_exp2f(m_reg - mn); m_reg = mn; }
      float ps = 0.f;
#pragma unroll
      for (int r = 0; r < 16; ++r) { p[r] = __builtin_amdgcn_exp2f(p[r] - mn); ps += p[r]; }
      { auto rr = __builtin_amdgcn_permlane32_swap(__float_as_uint(ps), __float_as_uint(ps), false, false); ps = __uint_as_float(rr[0]) + __uint_as_float(rr[1]); }
      l_reg = l_reg * alpha + ps;
      bf16x8 paA, paB;
#define PK4(P, BASE, OUT) do { unsigned a0 = cvtpk(P[BASE + 0], P[BASE + 1]), a1 = cvtpk(P[BASE + 2], P[BASE + 3]);   \
      unsigned b0_ = cvtpk(P[BASE + 4], P[BASE + 5]), b1_ = cvtpk(P[BASE + 6], P[BASE + 7]);                              \
      auto r0 = __builtin_amdgcn_permlane32_swap(a0, b0_, false, false); auto r1 = __builtin_amdgcn_permlane32_swap(a1, b1_, false, false); \
      u32x4 w_ = {r0[0], r1[0], r0[1], r1[1]}; OUT = *reinterpret_cast<bf16x8*>(&w_); } while (0)
      PK4(p, 0, paA); PK4(p, 8, paB);
#undef PK4
      if (__any(alpha < 1.f)) { if (hi == 0) wsf[r32] = alpha; asm volatile("s_waitcnt lgkmcnt(0)" ::: "memory");
#pragma unroll
        for (int d = 0; d < 8; ++d)
#pragma unroll
          for (int r = 0; r < 16; ++r) o[d][r] *= wsf[crow(r, hi)]; }
      if (hf == 0) pv_all<0>(o, vb, paA, paB); else pv_all<1>(o, vb, paA, paB);
    }
    asm volatile("s_waitcnt vmcnt(0)" ::: "memory"); __syncthreads();
  }
  } else {
  for (int j = 0; j < NT; ++j) {
    const int buf = j & 1;
    if (j + 1 < NT) ISSUE(j + 1, buf ^ 1);
    const LAS unsigned char* Ks = lds + buf * 65536 + comp * 16384;
    const int vb = (int)(uintptr_t)(lds + buf * 65536 + 32768) + v_rd_base(lane);
    {
      f32x16 p0 = {}, p1 = {};
#pragma unroll
      for (int d0 = 0; d0 < 8; ++d0) { const bf16x8 b0 = *reinterpret_cast<const LAS bf16x8*>(Ks + kbase[d0 & 3] + (d0 >> 2) * 128), b1 = *reinterpret_cast<const LAS bf16x8*>(Ks + kbase[d0 & 3] + (d0 >> 2) * 128 + 8192);
        p0 = __builtin_amdgcn_mfma_f32_32x32x16_bf16(b0, qr[d0], p0, 0, 0, 0); p1 = __builtin_amdgcn_mfma_f32_32x32x16_bf16(b1, qr[d0], p1, 0, 0, 0); }
      float pmax = p0[0];
#pragma unroll
      for (int r = 1; r < 16; ++r) pmax = fmaxf(pmax, p0[r]);
#pragma unroll
      for (int r = 0; r < 16; ++r) pmax = fmaxf(pmax, p1[r]);
      { auto rr = __builtin_amdgcn_permlane32_swap(__float_as_uint(pmax), __float_as_uint(pmax), false, false); pmax = fmaxf(__uint_as_float(rr[0]), __uint_as_float(rr[1])); }
      float mn, alpha;
      if (__builtin_expect(__all(pmax - m_reg <= THR2), 1)) { mn = m_reg; alpha = 1.f; }
      else { mn = fmaxf(m_reg, pmax); alpha = __builtin_amdgcn_exp2f(m_reg - mn); m_reg = mn; }
#define PK4(P, BASE, OUT) do { unsigned a0 = cvtpk(P[BASE + 0], P[BASE + 1]), a1 = cvtpk(P[BASE + 2], P[BASE + 3]);   \
      unsigned b0_ = cvtpk(P[BASE + 4], P[BASE + 5]), b1_ = cvtpk(P[BASE + 6], P[BASE + 7]);                              \
      auto r0 = __builtin_amdgcn_permlane32_swap(a0, b0_, false, false); auto r1 = __builtin_amdgcn_permlane32_swap(a1, b1_, false, false); \
      u32x4 w_ = {r0[0], r1[0], r0[1], r1[1]}; OUT = *reinterpret_cast<bf16x8*>(&w_); } while (0)
      float ps = 0.f; bf16x8 pa0, pa1, pa2, pa3;
#pragma unroll
      for (int r = 0; r < 16; ++r) { p0[r] = __builtin_amdgcn_exp2f(p0[r] - mn); ps += p0[r]; }
      PK4(p0, 0, pa0); PK4(p0, 8, pa1); SBAR();
#pragma unroll
      for (int r = 0; r < 16; ++r) { p1[r] = __builtin_amdgcn_exp2f(p1[r] - mn); ps += p1[r]; }
      PK4(p1, 0, pa2); PK4(p1, 8, pa3);
      { auto rr = __builtin_amdgcn_permlane32_swap(__float_as_uint(ps), __float_as_uint(ps), false, false); ps = __uint_as_float(rr[0]) + __uint_as_float(rr[1]); }
      l_reg = l_reg * alpha + ps;
#undef PK4
      if (__any(alpha < 1.f)) { if (hi == 0) wsf[r32] = alpha; asm volatile("s_waitcnt lgkmcnt(0)" ::: "memory");
#pragma unroll
        for (int d = 0; d < 8; ++d)
#pragma unroll
          for (int r = 0; r < 16; ++r) o[d][r] *= wsf[crow(r, hi)]; }
      pv_all<0>(o, vb, pa0, pa1); pv_all<1>(o, vb, pa2, pa3);
    }
    asm volatile("s_waitcnt vmcnt(0)" ::: "memory"); __syncthreads();
  }
  }
#undef ISSUE
#undef SOFF
  if (hi == 0) wsf[r32] = l_reg; asm volatile("s_waitcnt lgkmcnt(0)" ::: "memory");
  LAS float* X = (LAS float*)(lds + wq * 32768);
  if (comp == 1) {
#pragma unroll
    for (int r = 0; r < 16; ++r) { const float ri = __builtin_amdgcn_rcpf(wsf[crow(r, hi)]);
#pragma unroll
      for (int d = 0; d < 8; ++d) X[crow(r, hi) * 256 + d * 32 + r32] = o[d][r] * ri; }
  }
  __syncthreads();
  if (comp == 0) {
#pragma unroll
    for (int r = 0; r < 16; ++r) { const float ri = __builtin_amdgcn_rcpf(wsf[crow(r, hi)]);
#pragma unroll
      for (int d = 0; d < 8; ++d) { LAS float* xp = X + crow(r, hi) * 256 + d * 32 + r32; *xp = o[d][r] * ri - lam * (*xp); } }
    asm volatile("s_waitcnt lgkmcnt(0)" ::: "memory");
    const int row = lane >> 1, half = lane & 1; const LAS float* xr = X + row * 256 + half * 128; float ssq = 0.f;
#pragma unroll 8
    for (int i = 0; i < 32; ++i) { const f32x4 v = *(const LAS f32x4*)(xr + ((i + row) & 31) * 4); ssq += (v.x * v.x + v.y * v.y) + (v.z * v.z + v.w * v.w); }
    ssq += __shfl_xor(ssq, 1);
    const float sc = rsqrtf(ssq * (1.f / 256.f) + 1e-6f) * (1.f - 0.47071301834358414f);
    bf16* orow = Ob + (long)(wq * 32 + row) * 2048 + half * 128;
#pragma unroll 4
    for (int i = 0; i < 16; ++i) { const int c8 = ((i + row) & 15) * 8; const f32x4 v0 = *(const LAS f32x4*)(xr + c8), v1 = *(const LAS f32x4*)(xr + c8 + 4);
      const f32x4 g0 = *(const f32x4*)(gsub + half * 128 + c8), g1 = *(const f32x4*)(gsub + half * 128 + c8 + 4);
      *(u32x4*)(orow + c8) = (u32x4){cvtpk(v0.x * sc * g0.x, v0.y * sc * g0.y), cvtpk(v0.z * sc * g0.z, v0.w * sc * g0.w), cvtpk(v1.x * sc * g1.x, v1.y * sc * g1.y), cvtpk(v1.z * sc * g1.z, v1.w * sc * g1.w)}; }
  }
  __syncthreads();
}
#undef KSWZ
#undef SBAR
}

__device__ __forceinline__ void phase_attention2(Frame& F, const bf16_t* QKV, const float* lamv, const float* gsub, bf16_t* OUT, int rep = 1) {
    const int lane = fresh_tid() & 63;
    const float d0 = wave_sum(lamv[lane] * lamv[128 + lane] + lamv[64 + lane] * lamv[192 + lane]);
    const float d1 = wave_sum(lamv[256 + lane] * lamv[384 + lane] + lamv[320 + lane] * lamv[448 + lane]);
    const float lam = expf(d0) - expf(d1) + 0.47071301834358414f;
    for (int it = 0;; ++it) { const int L = (it / rep) * F.G + (int)blockIdx.x; if (L >= 544) break;
        int b, h, seq; long krow0, qrow0;
        if (L < 512) { const int qb = L & 31; h = (L >> 5) & 7; b = L >> 8; seq = RB; krow0 = (long)b * RB; qrow0 = krow0 + qb * 128; }
        else { const int r = L - 512; const int qb = r & 1; h = (r >> 1) & 7; b = r >> 4; seq = CTX; krow0 = (long)b * RB + SEQ; qrow0 = krow0 + qb * 128; }
        attn2::unit(QKV + qrow0 * 6144 + h * 256, QKV + krow0 * 6144 + 2048 + h * 256, QKV + krow0 * 6144 + 4096 + h * 256, OUT + qrow0 * 2048 + h * 256, seq, lam, gsub, F.lds);
    }
}
constexpr size_t G_QD = WS_G1, G_KT = WS_G1 + 34 * MiB, G_VT = WS_G1 + 68 * MiB, G_ATT = WS_G1 + 102 * MiB, G_DEC = WS_G1 + 111 * MiB, G_GD = WS_G1 + 113 * MiB;
__device__ __forceinline__ void phase_gla_pre(Frame& F, const bf16_t* P, const float* GD, const float* wup, const float* bgate, unsigned char* ws, int rep = 1) {
    const int f_tid = fresh_tid(), f_lane = f_tid & 63, f_wave = __builtin_amdgcn_readfirstlane(f_tid >> 6); (void)f_lane; (void)f_wave;
    LAS bf16_t* QDs = (LAS bf16_t*)(F.lds); LAS bf16_t* KIs = (LAS bf16_t*)(F.lds + 33792); LAS float* gds = (LAS float*)(F.lds + 67584); LAS float* tot = (LAS float*)(F.lds + 71680); LAS bf16_t* VS = (LAS bf16_t*)(F.lds + 73728);
    bf16_t* QD = (bf16_t*)(ws + G_QD); bf16_t* KT = (bf16_t*)(ws + G_KT); bf16_t* VT = (bf16_t*)(ws + G_VT); bf16_t* ATT = (bf16_t*)(ws + G_ATT); float* DEC = (float*)(ws + G_DEC);
    const int tid = f_tid, lane = f_lane, w = f_wave, d = tid & 255, th = tid >> 8;
    for (int it = 0;; ++it) { const int unit = (it / rep) * F.G + F.vcu; if (unit >= 1088) break;
        const int dir = unit & 1, h = (unit >> 1) & 3, uidx = unit >> 3; const int b = uidx >= 68 ? 1 : 0, c = uidx - 68 * b; const bool isctx = c >= 64;
        const size_t row0 = (size_t)b * RB + (size_t)c * 64;
        { const int t = tid >> 3, r2 = (tid & 7) * 2; const f32x2 gv = *(const f32x2*)(GD + (row0 + t) * 32 + dir * 16 + r2); gds[t * 16 + r2] = gv.x; gds[t * 16 + r2 + 1] = gv.y; }
#pragma unroll
        for (int i = 0; i < 4; ++i) { const int idx = tid + 512 * i, t = idx >> 5, c8 = (idx & 31) * 8; const bf16_t* src = P + (row0 + t) * 6400 + h * 256 + c8;
            *(LAS u32x4*)(QDs + t * 264 + c8) = *(const u32x4*)src; *(LAS u32x4*)(KIs + t * 264 + c8) = *(const u32x4*)(src + 1024); }
        if (dir == 0) {
#pragma unroll
            for (int i = 0; i < 8; ++i) { const int idx = tid + 512 * i, sx = idx >> 6, c8 = (idx & 63) * 8; *(LAS u32x4*)(VS + sx * 520 + c8) = *(const u32x4*)(P + (row0 + sx) * 6400 + 2048 + h * 512 + c8); }
        }
        float wu[16];
#pragma unroll
        for (int r = 0; r < 16; ++r) wu[r] = wup[(size_t)(dir * 16 + r) * 1024 + h * 256 + d];
        const float bgv = bgate[dir * 1024 + h * 256 + d];
        __syncthreads();
        if (dir == 0) {
            u32x4* dst = (u32x4*)(VT + ((size_t)uidx * 2048 + h * 512 + tid) * 64);
#pragma unroll
            for (int s8 = 0; s8 < 8; ++s8) { unsigned e[8];
#pragma unroll
                for (int j = 0; j < 8; ++j) e[j] = VS[(s8 * 8 + j) * 520 + tid];
                dst[s8] = (u32x4){e[0] | (e[1] << 16), e[2] | (e[3] << 16), e[4] | (e[5] << 16), e[6] | (e[7] << 16)}; }
        }
        float bc[32]; float run = 0.f;
#pragma unroll
        for (int i = 0; i < 32; ++i) { const int t = th * 32 + i; float z = bgv;
#pragma unroll
            for (int r = 0; r < 16; ++r) z = fmaf(gds[t * 16 + r], wu[r], z);
            bc[i] = (fminf(z, 0.f) - __logf(1.f + __expf(-fabsf(z)))) * 0.0625f; }
        if (dir == 0) {
#pragma unroll
            for (int i = 0; i < 32; ++i) { run += bc[i]; bc[i] = run; }
        } else {
#pragma unroll
            for (int i = 31; i >= 0; --i) { run += bc[i]; bc[i] = run; }
        }
        tot[th * 256 + d] = run;
        __syncthreads();
        const float t0v = tot[d], t1v = tot[256 + d]; const float blast = t0v + t1v;
        const float addv = (dir == 0) ? (th == 1 ? t0v : 0.f) : (th == 0 ? t1v : 0.f);
        unsigned ktp[16];
#pragma unroll
        for (int i = 0; i < 32; i += 2) {
            float kt2[2];
#pragma unroll
            for (int e = 0; e < 2; ++e) { const int t = th * 32 + i + e; const float bcum = bc[i + e] + addv;
                const float qv = bf2f(QDs[t * 264 + d]), kv = bf2f(KIs[t * 264 + d]);
                const float ex = __expf(bcum); const float qd = qv * 0.0625f * ex, ki = kv * __expf(-bcum); kt2[e] = kv * __expf(blast - bcum);
                QDs[t * 264 + d] = (bf16_t)f2bf(qd); KIs[t * 264 + d] = (bf16_t)f2bf(ki); }
            ktp[i >> 1] = cvt_pk_bf16(kt2[0], kt2[1]);
        }
        { u32x4* dst = (u32x4*)(KT + ((((size_t)dir * 136 + uidx) * 4 + h) * 256 + d) * 64 + th * 32);
#pragma unroll
          for (int j = 0; j < 4; ++j) dst[j] = (u32x4){ktp[4 * j], ktp[4 * j + 1], ktp[4 * j + 2], ktp[4 * j + 3]}; }
        if (th == 0) DEC[(((size_t)dir * 136 + uidx) * 4 + h) * 256 + d] = __expf(blast);
        __syncthreads();
        if (!isctx) {
#pragma unroll
            for (int i = 0; i < 4; ++i) { const int idx = tid + 512 * i, t = idx >> 5, c8 = (idx & 31) * 8;
                *(u32x4*)(QD + ((size_t)dir * M + row0 + t) * 1024 + h * 256 + c8) = *(const LAS u32x4*)(QDs + t * 264 + c8); }
        }
        if (!isctx) {
            const int fr = lane & 15, fq = lane >> 4;
#pragma unroll
            for (int tl = 0; tl < 2; ++tl) { const int tile = 2 * w + tl, ti = tile >> 2, si = tile & 3; f32x4 acc = {0.f, 0.f, 0.f, 0.f};
#pragma unroll
                for (int ks = 0; ks < 8; ++ks) { const bf16x8 af = *(const LAS bf16x8*)(QDs + (ti * 16 + fr) * 264 + ks * 32 + fq * 8), bfr = *(const LAS bf16x8*)(KIs + (si * 16 + fr) * 264 + ks * 32 + fq * 8);
                    acc = __builtin_amdgcn_mfma_f32_16x16x32_bf16(af, bfr, acc, 0, 0, 0); }
                bf16_t* ap = ATT + ((((size_t)dir * 136 + uidx) * 4 + h) * 64) * 64;
#pragma unroll
                for (int i = 0; i < 4; ++i) { const int t = ti * 16 + 4 * fq + i, s = si * 16 + fr; const bool keep = dir == 0 ? (s <= t) : (s >= t);
                    ap[t * 64 + s] = (bf16_t)f2bf(keep ? acc[i] : 0.f); } }
        }
        __syncthreads();
    }
}
__device__ __forceinline__ void phase_gla_scan(Frame& F, unsigned char* ws, float* O0, float* O1, int rep = 1) {
    const int f_tid = fresh_tid(), f_lane = f_tid & 63, f_wave = __builtin_amdgcn_readfirstlane(f_tid >> 6); (void)f_lane; (void)f_wave;
    LAS bf16_t* QDs = (LAS bf16_t*)(F.lds); LAS bf16_t* KTs = (LAS bf16_t*)(F.lds + 33792); LAS bf16_t* VTs = (LAS bf16_t*)(F.lds + 70656); LAS bf16_t* ATs = (LAS bf16_t*)(F.lds + 75264);
    LAS float* DECs = (LAS float*)(F.lds + 84480); LAS float* PART = (LAS float*)(F.lds + 85504);
    const bf16_t* QD = (const bf16_t*)(ws + G_QD); const bf16_t* KT = (const bf16_t*)(ws + G_KT); const bf16_t* VT = (const bf16_t*)(ws + G_VT); const bf16_t* ATT = (const bf16_t*)(ws + G_ATT); const float* DEC = (const float*)(ws + G_DEC);
    const int tid = f_tid, lane = f_lane, w = f_wave, l32 = lane & 31, hi = lane >> 5;
    for (int it = 0;; ++it) { const int L = (it / rep) * F.G + (int)blockIdx.x; if (L >= 256) break;
        const int slice = L & 15, combo = L >> 4, dir = combo & 1, h = (combo >> 1) & 3, b = combo >> 3;
        float* Od = dir ? O1 : O0;
        f32x16 S = {};
        u32x4 rq[4], rk[4], rv, ra, rd;
        rv = (u32x4){0u, 0u, 0u, 0u}; rd = rv;
#define GLA_LOAD(j) do { const int cc = dir == 0 ? ((j) < 4 ? 64 + (j) : (j) - 4) : 67 - (j); const int uidx = b * 68 + cc; const size_t row0 = (size_t)b * RB + (size_t)cc * 64; \
            const size_t kb = (((size_t)dir * 136 + uidx) * 4 + h); \
            _Pragma("unroll") for (int i = 0; i < 4; ++i) { const int idx = tid + 512 * i; rq[i] = *(const u32x4*)(QD + ((size_t)dir * M + row0 + (idx >> 5)) * 1024 + h * 256 + (idx & 31) * 8); \
                rk[i] = *(const u32x4*)(KT + kb * 16384 + (size_t)idx * 8); } \
            if (tid < 256) rv = *(const u32x4*)(VT + ((size_t)uidx * 2048 + h * 512 + slice * 32 + (tid >> 3)) * 64 + (tid & 7) * 8); \
            ra = *(const u32x4*)(ATT + kb * 4096 + (size_t)tid * 8); \
            if (tid < 64) rd = *(const u32x4*)(DEC + kb * 256 + tid * 4); } while (0)
        GLA_LOAD(0);
        for (int j = 0; j < 68; ++j) {
            const int cc = dir == 0 ? (j < 4 ? 64 + j : j - 4) : 67 - j; const bool isctx = cc >= 64; const size_t row0 = (size_t)b * RB + (size_t)cc * 64;
#pragma unroll
            for (int i = 0; i < 4; ++i) { const int idx = tid + 512 * i; *(LAS u32x4*)(QDs + (idx >> 5) * 264 + (idx & 31) * 8) = rq[i]; *(LAS u32x4*)(KTs + (idx >> 3) * 72 + (idx & 7) * 8) = rk[i]; }
            if (tid < 256) *(LAS u32x4*)(VTs + (tid >> 3) * 72 + (tid & 7) * 8) = rv;
            *(LAS u32x4*)(ATs + (tid >> 3) * 72 + (tid & 7) * 8) = ra;
            if (tid < 64) *(LAS u32x4*)(DECs + tid * 4) = rd;
            __syncthreads();
            if (j + 1 < 68) GLA_LOAD(j + 1);
            bf16x8 vb[4];
#pragma unroll
            for (int ks = 0; ks < 4; ++ks) vb[ks] = *(const LAS bf16x8*)(VTs + l32 * 72 + ks * 16 + hi * 8);
            if (!isctx) {
                bf16x8 sb[2];
#pragma unroll
                for (int jj = 0; jj < 2; ++jj) { u32x4 t4 = {cvt_pk_bf16(S[8 * jj + 0], S[8 * jj + 1]), cvt_pk_bf16(S[8 * jj + 2], S[8 * jj + 3]), cvt_pk_bf16(S[8 * jj + 4], S[8 * jj + 5]), cvt_pk_bf16(S[8 * jj + 6], S[8 * jj + 7])};
                    sb[jj] = *reinterpret_cast<bf16x8*>(&t4); }
                f32x16 ao[2] = {};
#pragma unroll
                for (int tt = 0; tt < 2; ++tt)
#pragma unroll
                    for (int jj = 0; jj < 2; ++jj) { const LAS bf16_t* qp = QDs + (tt * 32 + l32) * 264 + 32 * w + 16 * jj + 4 * hi;
                        const u32x2 lo = *(const LAS u32x2*)qp, hi2 = *(const LAS u32x2*)(qp + 8); u32x4 a4 = {lo.x, lo.y, hi2.x, hi2.y};
                        ao[tt] = __builtin_amdgcn_mfma_f32_32x32x16_bf16(*reinterpret_cast<bf16x8*>(&a4), sb[jj], ao[tt], 0, 0, 0); }
                if (w < 2) {
#pragma unroll
                    for (int ks = 0; ks < 4; ++ks) { const bf16x8 af = *(const LAS bf16x8*)(ATs + (w * 32 + l32) * 72 + ks * 16 + hi * 8);
                        if (w == 0) ao[0] = __builtin_amdgcn_mfma_f32_32x32x16_bf16(af, vb[ks], ao[0], 0, 0, 0); else ao[1] = __builtin_amdgcn_mfma_f32_32x32x16_bf16(af, vb[ks], ao[1], 0, 0, 0); }
                }
#pragma unroll
                for (int tt = 0; tt < 2; ++tt)
#pragma unroll
                    for (int r = 0; r < 16; ++r) PART[(w * 64 + tt * 32 + (r & 3) + 8 * (r >> 2) + 4 * hi) * 32 + l32] = ao[tt][r];
            }
#pragma unroll
            for (int r = 0; r < 16; ++r) S[r] *= DECs[32 * w + (r & 3) + 8 * (r >> 2) + 4 * hi];
#pragma unroll
            for (int ks = 0; ks < 4; ++ks) { const bf16x8 af = *(const LAS bf16x8*)(KTs + (32 * w + l32) * 72 + ks * 16 + hi * 8);
                S = __builtin_amdgcn_mfma_f32_32x32x16_bf16(af, vb[ks], S, 0, 0, 0); }
            __syncthreads();
            if (!isctx) { const int t = tid >> 3, v4 = (tid & 7) * 4; f32x4 acc = *(const LAS f32x4*)(PART + t * 32 + v4);
#pragma unroll
                for (int ww = 1; ww < 8; ++ww) acc = acc + *(const LAS f32x4*)(PART + (ww * 64 + t) * 32 + v4);
                *(f32x4*)(Od + (row0 + t) * D + h * 512 + slice * 32 + v4) = acc; }
        }
#undef GLA_LOAD
        __syncthreads();
    }
}
__device__ __forceinline__ void phase_gla_finish(Frame& F, const float* O0, const float* O1, const bf16_t* P, const float* g, bf16_t* OUT) {
    const int f_tid = fresh_tid(), f_lane = f_tid & 63, f_wave = __builtin_amdgcn_readfirstlane(f_tid >> 6); (void)f_lane; (void)f_wave;
    const int gw = F.vcu * NWAVES + f_wave, NGW = F.G * NWAVES, lane = f_lane;
    const f32x4 ga = *(const f32x4*)(g + 8 * lane), gb = *(const f32x4*)(g + 8 * lane + 4);
    for (int lr = gw; lr < BATCH * SEQ; lr += NGW) {
        const size_t row = (size_t)(lr >> 12) * RB + (lr & 4095);
#pragma unroll
        for (int h = 0; h < 4; ++h) {
            const size_t o = row * D + h * 512 + 8 * lane;
            const f32x4 a0 = *(const f32x4*)(O0 + o) + *(const f32x4*)(O1 + o), a1 = *(const f32x4*)(O0 + o + 4) + *(const f32x4*)(O1 + o + 4);
            const float ss = wave_sum((a0.x * a0.x + a0.y * a0.y) + (a0.z * a0.z + a0.w * a0.w) + (a1.x * a1.x + a1.y * a1.y) + (a1.z * a1.z + a1.w * a1.w));
            const float rn = rsqrtf(ss * (1.f / 512.f) + 1e-6f);
            const u32x4 rr = *(const u32x4*)(P + row * 6400 + 4096 + h * 512 + 8 * lane);
            const float rv[8] = {bflo(rr.x), bfhi(rr.x), bflo(rr.y), bfhi(rr.y), bflo(rr.z), bfhi(rr.z), bflo(rr.w), bfhi(rr.w)};
            float y[8] = {a0.x * ga.x, a0.y * ga.y, a0.z * ga.z, a0.w * ga.w, a1.x * gb.x, a1.y * gb.y, a1.z * gb.z, a1.w * gb.w};
#pragma unroll
            for (int e = 0; e < 8; ++e) y[e] = y[e] * rn * (rv[e] / (1.f + __expf(-rv[e])));
            *(u32x4*)(OUT + o) = (u32x4){cvt_pk_bf16(y[0], y[1]), cvt_pk_bf16(y[2], y[3]), cvt_pk_bf16(y[4], y[5]), cvt_pk_bf16(y[6], y[7])};
        }
    }
}
enum { PH_PRO = 0, L0_MOD = 1, L0_CH = 2, L0_POS = 3, L0_OUT = 4, L0_FMOD = 5, L0_FIN = 6, L0_FOUT = 7,
       L1_MOD = 8, L1_IN = 9, L1_SP = 10, L1_OUT = 11, L1_FMOD = 12, L1_FIN = 13, L1_FOUT = 14,
       L2_MOD = 15, L2_QKV = 16, L2_ATT = 17, L2_CMB = 18, L2_OUT = 19, L2_FMOD = 20, L2_FIN = 21, L2_FOUT = 22,
       L3_MOD = 23, L3_IN = 24, L3_G1 = 25, L3_G2 = 26, L3_FSH = 27, L3_OUT = 28, L3_FMOD = 29, L3_FIN = 30, L3_FOUT = 31, PH_FINAL = 32, NPH = 33 };

__global__ void __launch_bounds__(NWAVES * 64, 2) mk_fwd(Args args) {
    extern __shared__ __attribute__((aligned(16))) unsigned char lds_raw[];
    Frame F;
    F.lds = (LAS unsigned char*)lds_raw; F.MISC = (volatile LAS unsigned*)(F.lds + MISC_OFF);
    F.tid = threadIdx.x; F.lane = F.tid & 63; F.wave = __builtin_amdgcn_readfirstlane(F.tid >> 6);
    F.G = gridDim.x; { const int bx = blockIdx.x; F.vcu = (F.G % 8 == 0) ? (bx % 8) * (F.G / 8) + bx / 8 : bx; }
    unsigned char* ws = args.ws; F.ctl = (unsigned*)(ws + WS_CTL);
    for (int u = F.tid; u < (LDS_BYTES - MISC_OFF) / 4; u += NWAVES * 64) ((LAS unsigned*)(F.lds + MISC_OFF))[u] = 0u;
    __syncthreads();
    const int lo = args.ph_lo, hi = args.ph_hi;
    XcdBarrier bar; bar.bar = F.ctl + args.li * XCD_BAR_WORDS; bar.x = 0; bar.st = F.MISC + 8;
    if (hi - lo > 1) bar = xcd_barrier_post(F.ctl + args.li * XCD_BAR_WORDS, F.MISC + 8);
#define IN(k) (lo <= (k) && (k) < hi)
#ifndef REP_BAR
#define REP_BAR 1
#endif
#define SEAM(k) do { if (IN(k) && IN((k) + 1)) { xcd_barrier(bar); if (REP_BAR == 2) xcd_barrier(bar); } } while (0)
#ifndef REP_FOUT
#define REP_FOUT 1
#endif
#ifndef REP_OUT
#define REP_OUT 1
#endif
#ifndef REP_POS
#define REP_POS 1
#endif
#ifndef REP_FIN
#define REP_FIN 1
#endif
#ifndef REP_MIXIN
#define REP_MIXIN 1
#endif
#ifndef REP_ATT
#define REP_ATT 1
#endif
#ifndef REP_G1
#define REP_G1 1
#endif
#ifndef REP_G2
#define REP_G2 1
#endif
#ifndef REP_PRO
#define REP_PRO 1
#endif
#ifndef REP_THIN
#define REP_THIN 1
#endif
    float* XR = (float*)(ws + WS_XR); const float* MOD = (const float*)(ws + WS_MOD);
    bf16_t* H = (bf16_t*)(ws + WS_H); bf16_t* BIG = (bf16_t*)(ws + WS_BIG);
    const int cu = (int)blockIdx.x;

    if (IN(PH_PRO)) { phase_prologue(F, args); if (REP_PRO == 2) { VM_WAIT(); __syncthreads(); phase_prologue(F, args); } SEAM(PH_PRO); }

#define BG_WIN(l, part, nparts)  transpose_part(F, args.in[8] + (size_t)(l) * D * DFF, D, DFF, (bf16_t*)(ws + WS_WIN_T) + (size_t)(l) * DFF * D, D, part, nparts)
#define BG_WOUT(l, part, nparts) transpose_part(F, args.in[9] + (size_t)(l) * DFF * D, DFF, D, (bf16_t*)(ws + WS_WOUT_T) + (size_t)(l) * LDH * D, LDH, part, nparts)
#define KS_OUT 8
#define KS_FOUT 16
    float* PEND = (float*)(ws + WS_F1);
#define RESID_GEMM(Aptr, Btptr, KK, LD, GATE, KS, SKIPC) do { \
        { pg8::Gemm g{Aptr, Btptr, LD, LD, KK}; pg8::Sched2D S{32, D / 256, F.G, cu, LD, LD, 1, ((KK) == DFF) ? REP_FOUT : REP_OUT}; pg8::EpiResid E{XR, GATE}; pg8::gemm_phase<pg8::EpiResid, pg8::Sched2D, true>(F.lds, g, S, E); } \
        if (!(SKIPC)) { pg8::Gemm g{Aptr, Btptr, LD, LD, (KK) / (KS)}; pg8::SchedCtxSplit S{D / 256, KS, F.G, (F.G - 1 - cu), LD, LD, (KK) / (KS)}; pg8::EpiPartial E{PEND}; pg8::gemm_phase<pg8::EpiPartial, pg8::SchedCtxSplit, true>(F.lds, g, S, E); } } while (0)
#define FFN_PHASES(l, P_FMOD, P_FIN, P_FOUT, SKIPC) \
    if (IN(P_FMOD)) { const float* mod = MOD + (size_t)(l) * 3 * NMOD; phase_modulate(F, XR, args.in[7] + (l) * D, mod + 3 * D, mod + 4 * D, H, SKIPC, (SKIPC) ? nullptr : PEND, KS_OUT, mod + 2 * D); if (REP_THIN == 2) { VM_WAIT(); __syncthreads(); phase_modulate(F, XR, args.in[7] + (l) * D, mod + 3 * D, mod + 4 * D, H, SKIPC); } SEAM(P_FMOD); } \
    if (IN(P_FIN)) { pg8::Gemm g{H, (const bf16_t*)(ws + WS_WIN_T) + (size_t)(l) * DFF * D, D, D, D}; pg8::Sched2D S{(SKIPC) ? 32 : 34, DFF / 256, F.G, cu, D, D, SKIPC, REP_FIN}; \
        pg8::EpiBf16<2> E{BIG, LDH, 1.f}; pg8::gemm_phase<pg8::EpiBf16<2>, pg8::Sched2D, true>(F.lds, g, S, E); \
        if (!(SKIPC)) { const int part_ = F.G == 256 ? cu - 64 : cu, np_ = F.G == 256 ? 192 : F.G; if (part_ >= 0) { BG_WIN((l) + 1, part_, np_); \
            } } SEAM(P_FIN); } \
    if (IN(P_FOUT)) { const float* mod = MOD + (size_t)(l) * 3 * NMOD; RESID_GEMM(BIG, (const bf16_t*)(ws + WS_WOUT_T) + (size_t)(l) * LDH * D, DFF, LDH, mod + 5 * D, KS_FOUT, SKIPC); SEAM(P_FOUT); }

    bf16_t* A2 = (bf16_t*)(ws + WS_A2);
    if (IN(L0_MOD)) { phase_modulate(F, XR, args.in[6] + 0 * D, MOD + 0 * D, MOD + 1 * D, H, false); SEAM(L0_MOD); }
    if (IN(L0_CH)) { pg8::Gemm g{(const bf16_t*)(ws + WS_TC), H, 512, D, 512}; pg8::SchedChan S{F.G, cu}; pg8::EpiChan E{BIG, BIG + (size_t)2 * 2048 * LDH};
        pg8::gemm_phase<pg8::EpiChan, pg8::SchedChan, true>(F.lds, g, S, E);
        if (F.G == 256 && cu >= 32) transpose_part(F, args.in[17], D, D, (bf16_t*)(ws + WS_GMOUT_T), D, cu - 32, 224); else if (F.G != 256) transpose_part(F, args.in[17], D, D, (bf16_t*)(ws + WS_GMOUT_T), D, cu, F.G); SEAM(L0_CH); }
    if (IN(L0_POS)) {
        { pg8::Gemm g{(const bf16_t*)(ws + WS_PT), BIG, LDH, LDH, 8192}; pg8::SchedPosL S{F.G, cu, REP_POS}; pg8::EpiBf16<0> E{A2, D, 0.00069053396600248786f};
          pg8::gemm_phase<pg8::EpiBf16<0>, pg8::SchedPosL, true>(F.lds, g, S, E); }
        { pg8::Gemm g{(const bf16_t*)(ws + WS_PC), BIG + (size_t)2 * 2048 * LDH, 512, 512, 512}; pg8::SchedPosC S{F.G, cu}; pg8::EpiBf16<0> E{A2, D, 0.0027621358640099515f};
          pg8::gemm_phase<pg8::EpiBf16<0>, pg8::SchedPosC, true>(F.lds, g, S, E); }
        SEAM(L0_POS); }
    if (IN(L0_OUT)) { RESID_GEMM(A2, (const bf16_t*)(ws + WS_FNO_T), D, D, MOD + 2 * D, KS_OUT, 0); SEAM(L0_OUT); }
    FFN_PHASES(0, L0_FMOD, L0_FIN, L0_FOUT, 0)

    if (IN(L1_MOD)) { const float* mod = MOD + (size_t)1 * 3 * NMOD; phase_modulate(F, XR, args.in[6] + 1 * D, mod + 0 * D, mod + 1 * D, H, false, PEND, KS_FOUT, MOD + (size_t)0 * 3 * NMOD + 5 * D); SEAM(L1_MOD); }
    if (IN(L1_IN)) { pg8::Gemm g{H, (const bf16_t*)(ws + WS_GMIN_T), D, D, D}; pg8::Sched2D S{34, 16, F.G, cu, D, D, 0, REP_MIXIN}; pg8::EpiGeluStats<true> E{BIG, 4096, (float*)(ws + WS_LNS)};
        pg8::gemm_phase<pg8::EpiGeluStats<true>, pg8::Sched2D, true>(F.lds, g, S, E);
        { const int part_ = F.G == 256 ? cu - 32 : cu, np_ = F.G == 256 ? 224 : F.G; if (part_ >= 0) { BG_WOUT(1, part_, np_); } } SEAM(L1_IN); }
    if (IN(L1_SP)) { phase_spatial(F, BIG, (const float*)(ws + WS_LNS), args.in[13], args.in[14], (const bf16_t*)(ws + WS_GMWS), args.in[16], A2); if (REP_THIN == 2) phase_spatial(F, BIG, (const float*)(ws + WS_LNS), args.in[13], args.in[14], (const bf16_t*)(ws + WS_GMWS), args.in[16], A2); SEAM(L1_SP); }
    if (IN(L1_OUT)) { const float* mod = MOD + (size_t)1 * 3 * NMOD; RESID_GEMM(A2, (const bf16_t*)(ws + WS_GMOUT_T), D, D, mod + 2 * D, KS_OUT, 0); SEAM(L1_OUT); }
    FFN_PHASES(1, L1_FMOD, L1_FIN, L1_FOUT, 0)

    float* F1 = (float*)(ws + WS_F1); float* F2 = (float*)(ws + WS_F2);
    if (IN(L2_MOD)) { const float* mod = MOD + (size_t)2 * 3 * NMOD; phase_modulate(F, XR, args.in[6] + 2 * D, mod + 0 * D, mod + 1 * D, H, false, PEND, KS_FOUT, MOD + (size_t)1 * 3 * NMOD + 5 * D); SEAM(L2_MOD); }
    if (IN(L2_QKV)) { pg8::Gemm g{H, (const bf16_t*)(ws + WS_DFIN_T), D, D, D}; pg8::Sched2D S{34, 24, F.G, cu, D, D, 0, REP_MIXIN}; pg8::EpiQKV E{BIG, (const float*)(ws + WS_ROPE)};
        pg8::gemm_phase<pg8::EpiQKV, pg8::Sched2D, true>(F.lds, g, S, E);
        { const int part_ = F.G == 256 ? cu - 48 : cu, np_ = F.G == 256 ? 208 : F.G; if (part_ >= 0) { BG_WOUT(2, part_, np_); } } SEAM(L2_QKV); }
    if (IN(L2_ATT)) { phase_attention2(F, BIG, args.in[19], args.in[20], A2, REP_ATT); SEAM(L2_ATT); }
    if (IN(L2_OUT)) { const float* mod = MOD + (size_t)2 * 3 * NMOD; RESID_GEMM(A2, (const bf16_t*)(ws + WS_DFOUT_T), D, D, mod + 2 * D, KS_OUT, 0); SEAM(L2_OUT); }
    FFN_PHASES(2, L2_FMOD, L2_FIN, L2_FOUT, 0)

    if (IN(L3_MOD)) { const float* mod = MOD + (size_t)3 * 3 * NMOD; phase_modulate(F, XR, args.in[6] + 3 * D, mod + 0 * D, mod + 1 * D, H, false, PEND, KS_FOUT, MOD + (size_t)2 * 3 * NMOD + 5 * D); SEAM(L3_MOD); }
    if (IN(L3_IN)) { pg8::Gemm g{H, (const bf16_t*)(ws + WS_GLIN_T), D, D, D}; pg8::Sched2D S{34, 25, F.G, cu, D, D, 0, REP_MIXIN}; pg8::EpiGla E{BIG, (float*)(ws + G_GD)};
        pg8::gemm_phase<pg8::EpiGla, pg8::Sched2D, true>(F.lds, g, S, E);
        if (F.G == 256 && cu >= 82) BG_WOUT(3, cu - 82, 174); else if (F.G != 256) BG_WOUT(3, cu, F.G); SEAM(L3_IN); }
    if (IN(L3_G1)) { phase_gla_pre(F, BIG, (const float*)(ws + G_GD), args.in[23], args.in[24], ws, REP_G1); SEAM(L3_G1); }
    if (IN(L3_G2)) { phase_gla_scan(F, ws, F1, F2, REP_G2); SEAM(L3_G2); }
    if (IN(L3_FSH)) { phase_gla_finish(F, F1, F2, BIG, args.in[25], A2); if (REP_THIN == 2) phase_gla_finish(F, F1, F2, BIG, args.in[25], A2); SEAM(L3_FSH); }
    if (IN(L3_OUT)) { const float* mod = MOD + (size_t)3 * 3 * NMOD; pg8::Gemm g{A2, (const bf16_t*)(ws + WS_GLOUT_T), D, D, D}; pg8::Sched2D S{32, D / 256, F.G, cu, D, D, 1}; pg8::EpiResid E{XR, mod + 2 * D};
        pg8::gemm_phase<pg8::EpiResid, pg8::Sched2D, true>(F.lds, g, S, E); SEAM(L3_OUT); }
    FFN_PHASES(3, L3_FMOD, L3_FIN, L3_FOUT, 1)

    if (IN(PH_FINAL)) { phase_final(F, XR, args.in[10], args.out); }
#undef IN
#undef SEAM
}
#ifndef MK_ONE_LAUNCH
#define MK_ONE_LAUNCH 1
#endif
extern "C" void kernel_launch(void* const* d_in, const int* in_sizes, int n_in, void* d_out, int out_size, void* d_ws, size_t ws_size, hipStream_t st) {
    static int grid = 0;
    if (grid == 0) {
        int dev = 0, cus = 0;
        if (hipGetDevice(&dev) != hipSuccess || hipDeviceGetAttribute(&cus, hipDeviceAttributeMultiprocessorCount, dev) != hipSuccess) { fprintf(stderr, "device query failed\n"); grid = -1; return; }
        if (hipFuncSetAttribute((const void*)mk_fwd, hipFuncAttributeMaxDynamicSharedMemorySize, LDS_BYTES) != hipSuccess) { fprintf(stderr, "hipFuncSetAttribute failed\n"); grid = -1; return; }
        if (WS_END_MK > ws_size) { fprintf(stderr, "ws too small: need %zu have %zu\n", (size_t)WS_END_MK, ws_size); grid = -1; return; }
        grid = cus;
    }
    if (grid < 0) return;
    unsigned char* wsb = (unsigned char*)d_ws;
    (void)hipMemsetAsync(wsb + WS_CTL, 0, CTL_ZERO_BYTES, st);
    Args a{};
    for (int i = 0; i < 27; ++i) a.in[i] = (const float*)d_in[i];
    a.out = (float*)d_out; a.ws = wsb;
    if (MK_ONE_LAUNCH) { a.ph_lo = 0; a.ph_hi = NPH; a.li = 0; hipLaunchKernelGGL(mk_fwd, dim3(grid), dim3(NWAVES * 64), LDS_BYTES, st, a); }
    else for (int p = 0; p < NPH; ++p) { a.ph_lo = p; a.ph_hi = p + 1; a.li = p; hipLaunchKernelGGL(mk_fwd, dim3(grid), dim3(NWAVES * 64), LDS_BYTES, st, a); }
}
```

```cpp
#include <hip/hip_runtime.h>
#include <math.h>
#include <stdio.h>
#include <stdint.h>
constexpr int D = 2048, BATCH = 2, SEQ = 4096, CTX = 256, RB = SEQ + CTX, M = BATCH * RB, DFF = 8192;
constexpr int NMOD = 6 * D;
constexpr int LDP = 4096 + 64;
constexpr int LDH = DFF + 64;
#define LAS __attribute__((address_space(3)))
#define GAS __attribute__((address_space(1)))
typedef unsigned short bf16_t;
typedef short bf16x8 __attribute__((ext_vector_type(8)));
typedef float f32x4 __attribute__((ext_vector_type(4)));
typedef float f32x2 __attribute__((ext_vector_type(2)));
typedef float f32x16 __attribute__((ext_vector_type(16)));
typedef unsigned u32x4 __attribute__((ext_vector_type(4)));
typedef unsigned u32x2 __attribute__((ext_vector_type(2)));
typedef short s16x4 __attribute__((ext_vector_type(4)));

__device__ __forceinline__ unsigned cvt_pk_bf16(float lo, float hi) { unsigned r; asm volatile("v_cvt_pk_bf16_f32 %0, %1, %2" : "=v"(r) : "v"(lo), "v"(hi)); return r; }
__device__ __forceinline__ float bf2f(unsigned short h) { return __uint_as_float((unsigned)h << 16); }
__device__ __forceinline__ float bflo(unsigned w) { return __uint_as_float(w << 16); }
__device__ __forceinline__ float bfhi(unsigned w) { return __uint_as_float(w & 0xffff0000u); }
#define LDS_WAIT() asm volatile("s_waitcnt lgkmcnt(0)" ::: "memory")
#define VM_WAIT() asm volatile("s_waitcnt vmcnt(0)" ::: "memory")

__device__ __forceinline__ int fresh_tid() { int t = threadIdx.x; asm volatile("" : "+v"(t)); return t; }
__device__ __forceinline__ int mrow_of_tile(int pm) { const int b = pm >= 17 ? 1 : 0; const int t = pm - 17 * b; return t == 16 ? 2 : b; }

namespace pg8 {
constexpr int BM = 256, BK = 64, HALF = 128, HTB = HALF * BK * 2, STAGE_BYTES = 8 * HTB, NXCD = 8, WGM = 8;
__host__ __device__ __forceinline__ int lds_byte(int r, int c) { const int st = (r >> 4) * 2 + (c >> 5), rr = r & 15, cc = c & 31, ob = rr * 64 + cc * 2; return st * 1024 + (ob ^ (((ob >> 9) & 1) << 5)); }
__host__ __device__ __forceinline__ void stage_rc(int b, int& R, int& C) { const int st = b / 1024, sb = b % 1024, swz = sb ^ (((sb >> 9) & 1) << 5); R = (st >> 1) * 16 + swz / 64; C = (st & 1) * 32 + (swz % 64) / 2; }
__host__ __device__ __forceinline__ int perm32(int rho) { const int n = rho >> 4, i = rho & 15; return 8 * (i >> 2) + 4 * n + (i & 3); }

struct Unit { int pm, pn, z; size_t aoff, boff; };
struct Gemm { const bf16_t* A; const bf16_t* Bt; int lda, ldb, K; };

__device__ __forceinline__ bool static_tile(int i, int G, int c, int nM, int nN, int& pm, int& pn) {
    const int nwg = nM * nN; const long L = (long)i * G + c; if (L >= nwg) return false;
    int wgid = (int)L; { const int q = nwg / NXCD, r = nwg % NXCD, xcd = wgid % NXCD, off = wgid / NXCD; wgid = (xcd < r ? xcd * (q + 1) : r * (q + 1) + (xcd - r) * q) + off; }
    const int nig = WGM * nN, gid = wgid / nig, fm = gid * WGM, gsz = (nM - fm) < WGM ? (nM - fm) : WGM;
    pm = fm + ((wgid % nig) % gsz); pn = (wgid % nig) / gsz; return true;
}
struct Sched2D {
    int nM, nN, G, c, lda, ldb, skip_ctx, rep = 1;
    __device__ __forceinline__ bool next(int i, Unit& u) const {
        int pm, pn; if (!static_tile(rep == 2 ? (i >> 1) : i, G, c, nM, nN, pm, pn)) return false;
        if (skip_ctx) pm += (pm >= 16) ? 1 : 0;
        u.pm = pm; u.pn = pn; u.z = (rep == 2) ? (i & 1) : 0; u.aoff = (size_t)pm * BM * lda * 2; u.boff = (size_t)pn * BM * ldb * 2; return true;
    }
};

template <class Epi, class Sched, bool ALIGN_EPI>
__device__ __forceinline__ void gemm_phase(LAS unsigned char* lds, const Gemm g, const Sched& S, const Epi& E) {
    const int tid = fresh_tid(), wid = __builtin_amdgcn_readfirstlane(tid >> 6), lane = tid & 63, wr = wid >> 2, wc = wid & 3, fr = lane & 15, fq = lane >> 4;
    const int nt = g.K / BK;
    unsigned voffA[2], voffB[2];
#pragma unroll
    for (int i = 0; i < 2; ++i) { int R, C; stage_rc(tid * 16 + i * 8192, R, C); const int Rb = Epi::PERM ? ((R & ~31) + perm32(R & 31)) : R;
        voffA[i] = (unsigned)(R * g.lda + C) * 2u; voffB[i] = (unsigned)(Rb * g.ldb + C) * 2u; }
    const size_t kstep = (size_t)(BK * 2);
    const size_t hstepA = (size_t)HALF * g.lda * 2, hstepB = (size_t)HALF * g.ldb * 2;
    const unsigned ldsw = (unsigned)wid * 1024u;
    const int aoff = lds_byte(wr * 64 + fr, fq * 8), boff = lds_byte(wc * 32 + fr, fq * 8);
#define PG8_SA(b, h) (((b) * 2 + (h)) * HTB)
#define PG8_SB(b, h) ((4 + (b) * 2 + (h)) * HTB)
#define PG8_STAGE(bufoff, gbase, voff) do { _Pragma("unroll") for (int _i = 0; _i < 2; ++_i) \
        __builtin_amdgcn_global_load_lds((const unsigned*)((const char*)(gbase) + (voff)[_i]), (LAS unsigned*)(lds + (bufoff) + ldsw + _i * 8192), 16, 0, 0); } while (0)
#define PG8_LDA(dst, b, h) do { _Pragma("unroll") for (int m = 0; m < 4; ++m) _Pragma("unroll") for (int k = 0; k < 2; ++k) dst[m][k] = *(const LAS bf16x8*)(lds + PG8_SA(b, h) + aoff + m * 2048 + k * 1024); } while (0)
#define PG8_LDB(dst, b, h) do { _Pragma("unroll") for (int n = 0; n < 2; ++n) _Pragma("unroll") for (int k = 0; k < 2; ++k) dst[n][k] = *(const LAS bf16x8*)(lds + PG8_SB(b, h) + boff + n * 2048 + k * 1024); } while (0)
#define PG8_MMA(ai, bj, At, Bt) do { __builtin_amdgcn_s_setprio(1); _Pragma("unroll") for (int m = 0; m < 4; ++m) _Pragma("unroll") for (int n = 0; n < 2; ++n) _Pragma("unroll") for (int k = 0; k < 2; ++k) \
        acc[ai][bj][m][n] = __builtin_amdgcn_mfma_f32_16x16x32_bf16(Bt[n][k], At[m][k], acc[ai][bj][m][n], 0, 0, 0); __builtin_amdgcn_s_setprio(0); } while (0)
#define PG8_WAIT_V(n) asm volatile("s_waitcnt vmcnt(" #n ")" ::: "memory")
#define PG8_WAIT_L(n) asm volatile("s_waitcnt lgkmcnt(" #n ")" ::: "memory")
#define PG8_BAR __builtin_amdgcn_s_barrier()
#define PG8_SCHED __builtin_amdgcn_sched_barrier(0)
    Unit cur, nxt; int ui = 0;
    if (!S.next(0, cur)) return;
    f32x4 acc[2][2][4][2];
#pragma unroll
    for (int a = 0; a < 2; ++a)
#pragma unroll
        for (int b = 0; b < 2; ++b)
#pragma unroll
            for (int m = 0; m < 4; ++m)
#pragma unroll
                for (int n = 0; n < 2; ++n) acc[a][b][m][n] = (f32x4){0.f, 0.f, 0.f, 0.f};
    bf16x8 At[4][2], B0[2][2], B1[2][2];
    const char* cA = (const char*)g.A + cur.aoff; const char* cB = (const char*)g.Bt + cur.boff;
    PG8_STAGE(PG8_SB(0, 0), cB, voffB); PG8_STAGE(PG8_SB(0, 1), cB + hstepB, voffB); PG8_STAGE(PG8_SA(0, 0), cA, voffA); PG8_STAGE(PG8_SA(0, 1), cA + hstepA, voffA);
    if (wr == 1) PG8_BAR;
    PG8_WAIT_V(2); PG8_BAR;
    PG8_STAGE(PG8_SB(1, 0), cB + kstep, voffB); PG8_STAGE(PG8_SA(1, 0), cA + kstep, voffA); PG8_STAGE(PG8_SB(1, 1), cB + hstepB + kstep, voffB);
    PG8_WAIT_V(6); PG8_BAR;
    for (;;) {
        const bool has_next = S.next(ui + 1, nxt);
        const char* nA = has_next ? (const char*)g.A + nxt.aoff : cA; const char* nB = has_next ? (const char*)g.Bt + nxt.boff : cB;
        for (int t = 0; t < nt; t += 2) {
            const bool last = (t == nt - 2);
            const char* a1 = cA + (size_t)(t + 1) * kstep;
            const char* a2 = last ? nA : cA + (size_t)(t + 2) * kstep; const char* b2 = last ? nB : cB + (size_t)(t + 2) * kstep;
            const char* a3 = a2 + kstep; const char* b3 = b2 + kstep;
            PG8_LDB(B0, 0, 0); PG8_LDB(B1, 0, 1); PG8_SCHED; PG8_LDA(At, 0, 0); PG8_STAGE(PG8_SA(1, 1), a1 + hstepA, voffA);
            PG8_WAIT_V(8); PG8_WAIT_L(0); PG8_BAR; PG8_MMA(0, 0, At, B0); PG8_MMA(0, 1, At, B1); PG8_BAR; PG8_SCHED;
            PG8_LDA(At, 0, 1); PG8_STAGE(PG8_SB(0, 0), b2, voffB); PG8_STAGE(PG8_SB(0, 1), b2 + hstepB, voffB); PG8_STAGE(PG8_SA(0, 0), a2, voffA);
            PG8_WAIT_V(8); PG8_WAIT_L(0); PG8_BAR; PG8_MMA(1, 0, At, B0); PG8_MMA(1, 1, At, B1); PG8_BAR; PG8_SCHED;
            PG8_LDB(B0, 1, 0); PG8_LDB(B1, 1, 1); PG8_SCHED; PG8_LDA(At, 1, 0); PG8_STAGE(PG8_SA(0, 1), a2 + hstepA, voffA);
            PG8_WAIT_V(8); PG8_WAIT_L(0); PG8_BAR; PG8_MMA(0, 0, At, B0); PG8_MMA(0, 1, At, B1); PG8_BAR; PG8_SCHED;
            PG8_LDA(At, 1, 1); PG8_STAGE(PG8_SB(1, 0), b3, voffB); PG8_STAGE(PG8_SB(1, 1), b3 + hstepB, voffB); PG8_STAGE(PG8_SA(1, 0), a3, voffA);
            PG8_WAIT_V(8); PG8_WAIT_L(0); PG8_BAR; PG8_MMA(1, 0, At, B0); PG8_MMA(1, 1, At, B1); PG8_BAR; PG8_SCHED;
        }
        if constexpr (ALIGN_EPI) { if (wr == 0) PG8_BAR; }
        E(acc, cur, wr, wc, fr, fq);
        if (!has_next) break;
#pragma unroll
        for (int a = 0; a < 2; ++a)
#pragma unroll
            for (int b = 0; b < 2; ++b)
#pragma unroll
                for (int m = 0; m < 4; ++m)
#pragma unroll
                    for (int n = 0; n < 2; ++n) acc[a][b][m][n] = (f32x4){0.f, 0.f, 0.f, 0.f};
        cur = nxt; cA = nA; cB = nB; ++ui;
        if constexpr (ALIGN_EPI) { if (wr == 1) PG8_BAR; }
    }
    PG8_WAIT_V(0);
    if constexpr (!ALIGN_EPI) { if (wr == 0) PG8_BAR; }
    PG8_BAR;
#undef PG8_SA
#undef PG8_SB
#undef PG8_STAGE
#undef PG8_LDA
#undef PG8_LDB
#undef PG8_MMA
#undef PG8_WAIT_V
#undef PG8_WAIT_L
#undef PG8_BAR
#undef PG8_SCHED
}

__device__ __forceinline__ f32x2 gelu_pk(f32x2 v) {
    const f32x2 av = __builtin_elementwise_abs(v), d = av * 0.2316418882f + 1.0f;
    f32x2 t; t.x = __builtin_amdgcn_rcpf(d.x); t.y = __builtin_amdgcn_rcpf(d.y);
    f32x2 q = t * 0.5307027145f + (-0.7265760135f); q = q * t + 0.7107068705f; q = q * t + (-0.142248368f); q = q * t + 0.127414796f; q = q * t;
    const f32x2 s = (v * v) * (-0.72134752044f);
    f32x2 e; e.x = __builtin_amdgcn_exp2f(s.x); e.y = __builtin_amdgcn_exp2f(s.y);
    const f32x2 m = v * (q * e), r = v - m;
    f32x2 o; o.x = v.x < 0.f ? m.x : r.x; o.y = v.y < 0.f ? m.y : r.y; return o;
}
template <int ACT> struct EpiBf16 {
    static constexpr bool PERM = true;
    bf16_t* O; int ldc; float scale;
    __device__ __forceinline__ void operator()(const f32x4 (&acc)[2][2][4][2], const Unit& u, int wr, int wc, int fr, int fq) const {
        const int row0 = u.pm * BM + wr * 64 + fr, col0 = u.pn * BM + wc * 32 + 8 * fq;
#pragma unroll
        for (int ai = 0; ai < 2; ++ai)
#pragma unroll
            for (int m = 0; m < 4; ++m) { bf16_t* rowp = O + (size_t)(row0 + ai * HALF + m * 16) * ldc + col0;
#pragma unroll
                for (int bj = 0; bj < 2; ++bj) { f32x4 v0 = acc[ai][bj][m][0], v1 = acc[ai][bj][m][1];
                    if (ACT == 2) { v0 = __builtin_elementwise_max(v0, (f32x4){0.f, 0.f, 0.f, 0.f}); v1 = __builtin_elementwise_max(v1, (f32x4){0.f, 0.f, 0.f, 0.f}); v0 = v0 * v0; v1 = v1 * v1; }
                    else { v0 = v0 * scale; v1 = v1 * scale; }
                    u32x4 w; w.x = cvt_pk_bf16(v0[0], v0[1]); w.y = cvt_pk_bf16(v0[2], v0[3]); w.z = cvt_pk_bf16(v1[0], v1[1]); w.w = cvt_pk_bf16(v1[2], v1[3]);
                    *(u32x4*)(rowp + bj * HALF) = w; } }
    }
};
struct EpiResid {
    static constexpr bool PERM = false;
    float* X; const float* gate;
    __device__ __forceinline__ void operator()(const f32x4 (&acc)[2][2][4][2], const Unit& u, int wr, int wc, int fr, int fq) const {
        const int row0 = u.pm * BM + wr * 64 + fr, col0 = u.pn * BM + wc * 32 + 4 * fq;
        const float* gp = gate + (size_t)mrow_of_tile(u.pm) * NMOD + col0; const float msk = u.z ? 0.f : 1.f;
        f32x4 gv[2][2];
#pragma unroll
        for (int bj = 0; bj < 2; ++bj)
#pragma unroll
            for (int n = 0; n < 2; ++n) gv[bj][n] = *(const f32x4*)(gp + bj * HALF + n * 16);
#pragma unroll
        for (int ai = 0; ai < 2; ++ai)
#pragma unroll
            for (int m = 0; m < 4; ++m) { float* rowp = X + (size_t)(row0 + ai * HALF + m * 16) * D + col0;
#pragma unroll
                for (int bj = 0; bj < 2; ++bj)
#pragma unroll
                    for (int n = 0; n < 2; ++n) { f32x4* p = (f32x4*)(rowp + bj * HALF + n * 16); *p = *p + gv[bj][n] * acc[ai][bj][m][n] * msk; } }
    }
};

template <bool STATS> struct EpiGeluStats {
    static constexpr bool PERM = true;
    bf16_t* O; int ldc; float* stats;
    __device__ __forceinline__ void operator()(const f32x4 (&acc)[2][2][4][2], const Unit& u, int wr, int wc, int fr, int fq) const {
        const int row0 = u.pm * BM + wr * 64 + fr, col0 = u.pn * BM + wc * 32 + 8 * fq;
        const bool st = STATS && (u.pn >= 8);
#pragma unroll
        for (int ai = 0; ai < 2; ++ai)
#pragma unroll
            for (int m = 0; m < 4; ++m) { const int row = row0 + ai * HALF + m * 16; bf16_t* rowp = O + (size_t)row * ldc + col0; float s = 0.f, q = 0.f;
#pragma unroll
                for (int bj = 0; bj < 2; ++bj) { f32x4 v0 = acc[ai][bj][m][0], v1 = acc[ai][bj][m][1];
                    f32x2 a = gelu_pk((f32x2){v0[0], v0[1]}), b = gelu_pk((f32x2){v0[2], v0[3]}), c = gelu_pk((f32x2){v1[0], v1[1]}), d = gelu_pk((f32x2){v1[2], v1[3]});
                    s += (a.x + a.y) + (b.x + b.y) + (c.x + c.y) + (d.x + d.y);
                    q += (a.x * a.x + a.y * a.y) + (b.x * b.x + b.y * b.y) + (c.x * c.x + c.y * c.y) + (d.x * d.x + d.y * d.y);
                    u32x4 w; w.x = cvt_pk_bf16(a.x, a.y); w.y = cvt_pk_bf16(b.x, b.y); w.z = cvt_pk_bf16(c.x, c.y); w.w = cvt_pk_bf16(d.x, d.y);
                    *(u32x4*)(rowp + bj * HALF) = w; }
                if (st) { s += __shfl_xor(s, 16); s += __shfl_xor(s, 32); q += __shfl_xor(q, 16); q += __shfl_xor(q, 32);
                    if (fq == 0) *(f32x2*)(stats + (((size_t)row * 8 + (u.pn - 8)) * 4 + wc) * 2) = (f32x2){s, q}; } }
    }
};
struct SchedChan {
    int G, c;
    __device__ __forceinline__ bool next(int i, Unit& u) const {
        const int L = i * G + c; if (L >= 544) return false;
        int b, g, pm, pn, ctx;
        if (L < 512) { ctx = 0; pn = L & 15; pm = (L >> 4) & 3; g = (L >> 6) & 3; b = L >> 8; }
        else { const int r = L - 512; ctx = 1; pn = 0; pm = r & 3; g = (r >> 2) & 3; b = r >> 4; }
        u.pm = pm; u.pn = pn; u.z = b | (g << 1) | (ctx << 3);
        u.aoff = (size_t)pm * BM * 512 * 2;
        u.boff = ((size_t)(b * RB + (ctx ? SEQ : pn * BM)) * D + g * 512) * 2;
        return true;
    }
};
struct EpiChan {
    static constexpr bool PERM = true;
    bf16_t* PB; bf16_t* PBc;
    __device__ __forceinline__ void operator()(const f32x4 (&acc)[2][2][4][2], const Unit& u, int wr, int wc, int fr, int fq) const {
        const int b = u.z & 1, g = (u.z >> 1) & 3, ctx = u.z >> 3;
        const int ldc = ctx ? 512 : LDH;
        bf16_t* base = (ctx ? PBc + (size_t)b * 2048 * 512 : PB + (size_t)b * 2048 * LDH) + (size_t)(g * 512 + (u.pm & 1) * 256) * ldc + (u.pm >> 1) * (ctx ? 256 : 4096) + u.pn * BM;
        const int row0 = wr * 64 + fr, col0 = wc * 32 + 8 * fq;
#pragma unroll
        for (int ai = 0; ai < 2; ++ai)
#pragma unroll
            for (int m = 0; m < 4; ++m) { bf16_t* rowp = base + (size_t)(row0 + ai * HALF + m * 16) * ldc + col0;
#pragma unroll
                for (int bj = 0; bj < 2; ++bj) { const f32x4 v0 = acc[ai][bj][m][0], v1 = acc[ai][bj][m][1];
                    u32x4 w; w.x = cvt_pk_bf16(v0[0], v0[1]); w.y = cvt_pk_bf16(v0[2], v0[3]); w.z = cvt_pk_bf16(v1[0], v1[1]); w.w = cvt_pk_bf16(v1[2], v1[3]);
                    *(u32x4*)(rowp + bj * HALF) = w; } }
    }
};
struct SchedPosL {
    int G, c, rep = 1;
    __device__ __forceinline__ bool next(int i, Unit& u) const {
        int pm, pn; if (!static_tile(rep == 2 ? (i >> 1) : i, G, c, 32, 8, pm, pn)) return false;
        const int b = pm >> 4; pm &= 15;
        u.pm = b * 17 + pm; u.pn = pn; u.z = b; u.aoff = (size_t)pm * BM * LDH * 2; u.boff = ((size_t)b * 2048 + pn * BM) * LDH * 2; return true;
    }
};
struct SchedPosC {
    int G, c;
    __device__ __forceinline__ bool next(int i, Unit& u) const {
        const int L = i * G + (G - 1 - c); if (L >= 16) return false;
        const int b = L >> 3, pn = L & 7;
        u.pm = b * 17 + 16; u.pn = pn; u.z = b; u.aoff = 0; u.boff = ((size_t)b * 2048 + pn * BM) * 512 * 2; return true;
    }
};

struct EpiQKV {
    static constexpr bool PERM = true;
    bf16_t* O; const float* rope;
    __device__ __forceinline__ void operator()(const f32x4 (&acc)[2][2][4][2], const Unit& u, int wr, int wc, int fr, int fq) const {
        const int rloc = wr * 64 + fr, col0 = u.pn * BM + wc * 32 + 8 * fq;
        const int mr = mrow_of_tile(u.pm); const bool dorope = (u.pn < 16) && (mr != 2);
        const int b = u.pm >= 17 ? 1 : 0, t0 = (u.pm - 17 * b) * BM; const int i0 = wc * 16 + 4 * fq;
        const float qs = (u.pn < 8) ? 0.12751743074602448f : 1.f;
#pragma unroll
        for (int ai = 0; ai < 2; ++ai)
#pragma unroll
            for (int m = 0; m < 4; ++m) { const int rl = rloc + ai * HALF + m * 16; bf16_t* rowp = O + (size_t)(u.pm * BM + rl) * 6144 + col0;
                f32x4 cs = {1.f, 1.f, 1.f, 1.f}, sn = {0.f, 0.f, 0.f, 0.f};
                if (dorope) { const int pos = t0 + rl; cs = *(const f32x4*)(rope + (size_t)pos * 64 + i0); sn = *(const f32x4*)(rope + (size_t)4096 * 64 + (size_t)pos * 64 + i0); }
                cs = cs * qs; sn = sn * qs;
#pragma unroll
                for (int bj = 0; bj < 2; ++bj) { const f32x4 v0 = acc[ai][bj][m][0], v1 = acc[ai][bj][m][1];
                    const float e0 = v0[0] * cs[0] - v0[1] * sn[0], o0 = v0[0] * sn[0] + v0[1] * cs[0];
                    const float e1 = v0[2] * cs[1] - v0[3] * sn[1], o1 = v0[2] * sn[1] + v0[3] * cs[1];
                    const float e2 = v1[0] * cs[2] - v1[1] * sn[2], o2 = v1[0] * sn[2] + v1[1] * cs[2];
                    const float e3 = v1[2] * cs[3] - v1[3] * sn[3], o3 = v1[2] * sn[3] + v1[3] * cs[3];
                    u32x4 w; w.x = cvt_pk_bf16(e0, o0); w.y = cvt_pk_bf16(e1, o1); w.z = cvt_pk_bf16(e2, o2); w.w = cvt_pk_bf16(e3, o3);
                    *(u32x4*)(rowp + bj * HALF) = w; } }
    }
};

struct EpiGla {
    static constexpr bool PERM = true;
    bf16_t* O; float* GD;
    __device__ __forceinline__ void operator()(const f32x4 (&acc)[2][2][4][2], const Unit& u, int wr, int wc, int fr, int fq) const {
        const int row0 = u.pm * BM + wr * 64 + fr, col0 = u.pn * BM + wc * 32 + 8 * fq;
        const bool gd = (u.pn == 24) && (wc == 0);
#pragma unroll
        for (int ai = 0; ai < 2; ++ai)
#pragma unroll
            for (int m = 0; m < 4; ++m) { const int row = row0 + ai * HALF + m * 16; bf16_t* rowp = O + (size_t)row * 6400 + col0;
#pragma unroll
                for (int bj = 0; bj < 2; ++bj) { const f32x4 v0 = acc[ai][bj][m][0], v1 = acc[ai][bj][m][1];
                    u32x4 w; w.x = cvt_pk_bf16(v0[0], v0[1]); w.y = cvt_pk_bf16(v0[2], v0[3]); w.z = cvt_pk_bf16(v1[0], v1[1]); w.w = cvt_pk_bf16(v1[2], v1[3]);
                    *(u32x4*)(rowp + bj * HALF) = w;
                    if (bj == 0 && gd) { *(f32x4*)(GD + (size_t)row * 32 + 8 * fq) = v0; *(f32x4*)(GD + (size_t)row * 32 + 8 * fq + 4) = v1; } } }
    }
};

struct SchedCtxSplit {
    int nN, KS, G, c, lda, ldb, kpiece;
    __device__ __forceinline__ bool next(int i, Unit& u) const {
        const int L = i * G + c; if (L >= 2 * nN * KS) return false;
        const int ks = L / (2 * nN), rem = L % (2 * nN), bt = rem / nN, pn = rem % nN;
        u.pm = bt ? 33 : 16; u.pn = pn; u.z = ks | (bt << 8);
        u.aoff = ((size_t)u.pm * BM * lda + (size_t)ks * kpiece) * 2; u.boff = ((size_t)pn * BM * ldb + (size_t)ks * kpiece) * 2; return true;
    }
};
struct EpiPartial {
    static constexpr bool PERM = false;
    float* PB;
    __device__ __forceinline__ void operator()(const f32x4 (&acc)[2][2][4][2], const Unit& u, int wr, int wc, int fr, int fq) const {
        const int ks = u.z & 255, bt = u.z >> 8;
        float* base = PB + ((size_t)ks * 512 + bt * 256 + wr * 64 + fr) * D + u.pn * BM + wc * 32 + 4 * fq;
#pragma unroll
        for (int ai = 0; ai < 2; ++ai)
#pragma unroll
            for (int m = 0; m < 4; ++m) { float* rowp = base + (size_t)(ai * HALF + m * 16) * D;
#pragma unroll
                for (int bj = 0; bj < 2; ++bj)
#pragma unroll
                    for (int n = 0; n < 2; ++n) *(f32x4*)(rowp + bj * HALF + n * 16) = acc[ai][bj][m][n]; }
    }
};

struct SchedPos2 {
    int G, c, rep = 1;
    __device__ __forceinline__ bool next(int i, Unit& u) const {
        int pm, pn; if (!static_tile(rep == 2 ? (i >> 1) : i, G, c, 32, 8, pm, pn)) return false;
        const int type = pm >> 4, b = (pm >> 3) & 1, p8 = pm & 7;
        u.pm = pm; u.pn = pn; u.z = 0; u.aoff = ((size_t)(type * 2048 + p8 * BM) * LDP) * 2; u.boff = (((size_t)b * 2048 + pn * BM) * LDH + (size_t)type * 4096) * 2; return true;
    }
};
struct EpiF32 {
    static constexpr bool PERM = false;
    float* C; int ldc;
    __device__ __forceinline__ void operator()(const f32x4 (&acc)[2][2][4][2], const Unit& u, int wr, int wc, int fr, int fq) const {
        float* base = C + (size_t)(u.pm * BM + wr * 64 + fr) * ldc + u.pn * BM + wc * 32 + 4 * fq;
#pragma unroll
        for (int ai = 0; ai < 2; ++ai)
#pragma unroll
            for (int m = 0; m < 4; ++m) { float* rowp = base + (size_t)(ai * HALF + m * 16) * ldc;
#pragma unroll
                for (int bj = 0; bj < 2; ++bj)
#pragma unroll
                    for (int n = 0; n < 2; ++n) *(f32x4*)(rowp + bj * HALF + n * 16) = acc[ai][bj][m][n]; }
    }
};
}

#define XB_TMO      128
#define XB_XCNT(j)  (256  + 64 * (j))
#define XB_XSUB(j)  (1280 + 64 * (j))
#define XB_XGEN(j)  (2304 + 64 * (j))
#define XB_TOP      3328
#define XB_TOPGEN   3392
#define XCD_BAR_WORDS 3456
#define XB_SPIN_CAP (1u << 18)
__device__ __forceinline__ unsigned xb_ld(unsigned* p)              { return __hip_atomic_load(p, __ATOMIC_RELAXED, __HIP_MEMORY_SCOPE_AGENT); }
__device__ __forceinline__ unsigned xb_add(unsigned* p, unsigned v) { return __hip_atomic_fetch_add(p, v, __ATOMIC_RELAXED, __HIP_MEMORY_SCOPE_AGENT); }
__device__ __forceinline__ unsigned xb_xcc_id() { return (unsigned)__builtin_amdgcn_s_getreg((3 << 11) | 20) & 0xFu; }
#define XB_SPIN(cond, bar) do { unsigned _sp = 0; while (cond) { __builtin_amdgcn_s_sleep(1); \
    if ((++_sp & 255u) == 0u) { if (xb_ld(&(bar)[XB_TMO])) break; if (_sp > XB_SPIN_CAP) { atomicAdd(&(bar)[XB_TMO], 1u); break; } } } } while (0)
struct XcdBarrier { unsigned* bar; unsigned x; volatile LAS unsigned* st; };
__device__ __forceinline__ XcdBarrier xcd_barrier_post(unsigned* bar, volatile LAS unsigned* st) {
    XcdBarrier b; b.bar = bar; b.x = xb_xcc_id(); b.st = st;
    if (threadIdx.x == 0) (void)xb_add(&bar[XB_XCNT(b.x)], 1u);
    return b;
}
__device__ __forceinline__ void xcd_barrier_complete(unsigned* bar, unsigned x, unsigned& nloc, unsigned& nx) {
    const unsigned G = gridDim.x * gridDim.y * gridDim.z;
    unsigned sum, cnt, mine, sp = 0u;
    for (;;) {
        sum = 0u; cnt = 0u; mine = 0u;
#pragma unroll
        for (unsigned j = 0; j < 16; ++j) { const unsigned c = xb_ld(&bar[XB_XCNT(j)]); sum += c; cnt += (c > 0u) ? 1u : 0u; mine = (j == x) ? c : mine; }
        if (sum == G) break;
        __builtin_amdgcn_s_sleep(1);
        if ((++sp & 255u) == 0u) { if (xb_ld(&bar[XB_TMO])) break; if (sp > XB_SPIN_CAP) { atomicAdd(&bar[XB_TMO], 1u); break; } }
    }
    nloc = mine > 0u ? mine : 1u; nx = cnt > 0u ? cnt : 1u;
}
__device__ __forceinline__ void xcd_barrier(const XcdBarrier& b) {
    asm volatile("s_waitcnt vmcnt(0)" ::: "memory");
    __syncthreads();
    if (threadIdx.x == 0) {
        unsigned* bar = b.bar;
        __builtin_amdgcn_s_waitcnt(0);
        unsigned nloc = b.st[0], nx = b.st[1];
        if (nloc == 0u) { xcd_barrier_complete(bar, b.x, nloc, nx); b.st[0] = nloc; b.st[1] = nx; }
        const unsigned old = xb_add(&bar[XB_XSUB(b.x)], 1u);
        const unsigned gen = old / nloc;
        if (old + 1u == (gen + 1u) * nloc) {
            __builtin_amdgcn_fence(__ATOMIC_RELEASE, "agent");
            asm volatile("s_waitcnt vmcnt(0)" ::: "memory");
            const unsigned og = xb_add(&bar[XB_TOP], 1u);
            const unsigned tg = og / nx;
            if (og + 1u == (tg + 1u) * nx) xb_add(&bar[XB_TOPGEN], 1u);
            else XB_SPIN(xb_ld(&bar[XB_TOPGEN]) == tg, bar);
            __builtin_amdgcn_fence(__ATOMIC_ACQUIRE, "agent");
            xb_add(&bar[XB_XGEN(b.x)], 1u);
            asm volatile("s_waitcnt vmcnt(0)" ::: "memory");
        } else {
            XB_SPIN(xb_ld(&bar[XB_XGEN(b.x)]) == gen, bar);
            __builtin_amdgcn_fence(__ATOMIC_ACQUIRE, "agent");
            asm volatile("s_waitcnt vmcnt(0)" ::: "memory");
        }
    }
    __syncthreads();
}
constexpr size_t MiB = 1u << 20;
constexpr size_t WS_CTL = 0, CTL_ZERO_BYTES = 4 * MiB;
constexpr size_t WS_MOD = 1 * MiB;
constexpr size_t WS_WIN_T = 4 * MiB;
constexpr size_t WS_WOUT_T = WS_WIN_T + 128 * MiB;
constexpr size_t WS_FNO_T = WS_WOUT_T + 130 * MiB;
constexpr size_t WS_GMIN_T = WS_FNO_T + 8 * MiB;
constexpr size_t WS_GMOUT_T = WS_GMIN_T + 16 * MiB;
constexpr size_t WS_DFIN_T = WS_GMOUT_T + 8 * MiB;
constexpr size_t WS_DFOUT_T = WS_DFIN_T + 24 * MiB;
constexpr size_t WS_GLIN_T = WS_DFOUT_T + 8 * MiB;
constexpr size_t WS_GLOUT_T = WS_GLIN_T + 25 * MiB;
constexpr size_t WS_TC = WS_GLOUT_T + 8 * MiB;
constexpr size_t WS_PT = WS_TC + 1 * MiB;
constexpr size_t WS_PC = WS_PT + 65 * MiB;
constexpr size_t WS_ROPE = WS_PC + 1 * MiB;
constexpr size_t WS_GMWS = WS_ROPE + 2 * MiB;
constexpr size_t WS_XR = WS_GMWS + 1 * MiB;
constexpr size_t WS_H = WS_XR + 68 * MiB;
constexpr size_t WS_BIG = WS_H + 34 * MiB;
constexpr size_t WS_A2 = WS_BIG + 138 * MiB;
constexpr size_t WS_F1 = WS_A2 + 34 * MiB;
constexpr size_t WS_F2 = WS_F1 + 68 * MiB;
constexpr size_t WS_LNS = WS_F1;
constexpr size_t WS_G1 = WS_F2 + 68 * MiB;
constexpr size_t WS_NAIVE = WS_G1 + 128 * MiB;
constexpr size_t WS_END_MK = WS_NAIVE;

constexpr int NWAVES = 8;
constexpr int RING_BYTES = 131072, LDS_BYTES = 163840, MISC_OFF = LDS_BYTES - 1024;

struct Args { const float* in[27]; float* out; unsigned char* ws; int ph_lo, ph_hi, li, pad; };

struct Frame {
    LAS unsigned char* lds; volatile LAS unsigned* MISC; unsigned* ctl;
    int tid, lane, wave, vcu, G;
};
__device__ __forceinline__ float wave_sum(float v) {
#pragma unroll
    for (int o = 1; o < 64; o <<= 1) v += __shfl_xor(v, o);
    return v;
}
__device__ __forceinline__ unsigned f2bf(float f) { unsigned u = __float_as_uint(f); return (u + 0x7fffu + ((u >> 16) & 1u)) >> 16; }
__device__ __forceinline__ unsigned pk2(float lo, float hi) { return f2bf(lo) | (f2bf(hi) << 16); }

template <int MAP>
__device__ __forceinline__ void transpose_item(const float* W, int K, int N, bf16_t* WT, int ldt, LAS float* scr, int item, int lane) {
    const int nblk = (N + 63) / 64, kb = item / nblk, nb = item % nblk, k0 = 64 * kb, n0 = 64 * nb;
    const int c4 = (lane & 15) * 4; const bool cok = n0 + c4 < N;
#pragma unroll 8
    for (int i = 0; i < 16; ++i) { const int kk = 4 * i + (lane >> 4); f32x4 v = {0.f, 0.f, 0.f, 0.f}; if (cok) v = *(const f32x4*)(W + (size_t)(k0 + kk) * N + n0 + c4);
        LAS float* d = scr + kk * 65 + c4; d[0] = v.x; d[1] = v.y; d[2] = v.z; d[3] = v.w; }
    LDS_WAIT(); asm volatile("" ::: "memory");
    const int c = lane & 7;
#pragma unroll
    for (int j = 0; j < 8; ++j) { const int n = (lane >> 3) + 8 * j; const LAS float* s = scr + (8 * c) * 65 + n;
        u32x4 o; o.x = pk2(s[0 * 65], s[1 * 65]); o.y = pk2(s[2 * 65], s[3 * 65]); o.z = pk2(s[4 * 65], s[5 * 65]); o.w = pk2(s[6 * 65], s[7 * 65]);
        int nn = n0 + n;
        if (nn < N) {
            if (MAP == 1) { if (nn < 4096) { const int blk = nn >> 7, w = nn & 127, sgn = w >> 6, i2 = w & 63; nn = blk * 128 + 2 * i2 + sgn; } }
            *(u32x4*)(WT + (size_t)nn * ldt + k0 + 8 * c) = o; } }
    LDS_WAIT(); asm volatile("" ::: "memory");
}
template <int MAP>
__device__ __forceinline__ void transpose_all(Frame& F, const float* W, int K, int N, bf16_t* WT, int ldt = 0) {
    const int f_tid = fresh_tid(), f_lane = f_tid & 63, f_wave = __builtin_amdgcn_readfirstlane(f_tid >> 6); (void)f_lane; (void)f_wave;
    if (ldt == 0) ldt = K;
    LAS float* scr = (LAS float*)(F.lds + f_wave * 16896);
    const int gw = F.vcu * NWAVES + f_wave, NGW = F.G * NWAVES, nitems = (K / 64) * ((N + 63) / 64);
    for (int it = gw; it < nitems; it += NGW) transpose_item<MAP>(W, K, N, WT, ldt, scr, it, f_lane);
}

template <int MAP = 0>
__device__ __forceinline__ void transpose_part(Frame& F, const float* W, int K, int N, bf16_t* WT, int ldt, int part, int nparts) {
    const int f_tid = fresh_tid(), f_lane = f_tid & 63, f_wave = __builtin_amdgcn_readfirstlane(f_tid >> 6);
    LAS float* scr = (LAS float*)(F.lds + f_wave * 16896);
    const int nitems = (K / 64) * ((N + 63) / 64);
    for (int it = part * NWAVES + f_wave; it < nitems; it += nparts * NWAVES) transpose_item<MAP>(W, K, N, WT, ldt, scr, it, f_lane);
}

__device__ __forceinline__ void ada_item(Frame& F, const Args& a, int l, int jg) {
    const int f_tid = fresh_tid(), lane = f_tid & 63, w = __builtin_amdgcn_readfirstlane(f_tid >> 6);
    float* MOD = (float*)(a.ws + WS_MOD);
    const float* c = a.in[1]; const float* cc = a.in[3]; const float* wa = a.in[4]; const float* ba = a.in[5];
    const int col = jg * 256 + 4 * lane;
    const float* wp = wa + ((size_t)l * D + w * 256) * NMOD + col;
    f32x4 a0 = {0.f, 0.f, 0.f, 0.f}, a1 = a0, a2 = a0;
#pragma unroll 8
    for (int k = 0; k < 256; ++k) {
        const f32x4 wv = *(const f32x4*)(wp + (size_t)k * NMOD);
        const int kk = w * 256 + k;
        float c0 = c[kk], c1 = c[D + kk], c2 = cc[kk];
        c0 = c0 / (1.f + __expf(-c0)); c1 = c1 / (1.f + __expf(-c1)); c2 = c2 / (1.f + __expf(-c2));
        a0 = a0 + wv * c0; a1 = a1 + wv * c1; a2 = a2 + wv * c2;
    }
    LAS float* part = (LAS float*)F.lds;
    __syncthreads();
    *(LAS f32x4*)(part + (w * 3 + 0) * 256 + 4 * lane) = a0; *(LAS f32x4*)(part + (w * 3 + 1) * 256 + 4 * lane) = a1; *(LAS f32x4*)(part + (w * 3 + 2) * 256 + 4 * lane) = a2;
    __syncthreads();
    for (int i = f_tid; i < 768; i += NWAVES * 64) { const int r = i >> 8, cj = i & 255; float sacc = ba[(size_t)l * NMOD + jg * 256 + cj];
#pragma unroll
        for (int ww = 0; ww < 8; ++ww) sacc += part[(ww * 3 + r) * 256 + cj];
        MOD[((size_t)l * 3 + r) * NMOD + jg * 256 + cj] = sacc; }
    __syncthreads();
}

__device__ __forceinline__ void phase_prologue(Frame& F, const Args& a) {
    const int f_tid = fresh_tid(), f_lane = f_tid & 63, f_wave = __builtin_amdgcn_readfirstlane(f_tid >> 6); (void)f_lane; (void)f_wave;
    unsigned char* ws = a.ws;
    const int gw = F.vcu * NWAVES + f_wave, NGW = F.G * NWAVES, lane = f_lane;
    {
        float* XR = (float*)(ws + WS_XR);
        for (int row = gw; row < M; row += NGW) {
            const int b = row >= RB ? 1 : 0, t = row - b * RB;
            const float* src = t < SEQ ? a.in[0] + (size_t)(b * SEQ + t) * D : a.in[2] + (size_t)(b * CTX + (t - SEQ)) * D;
            const f32x4* s4 = (const f32x4*)src + lane; f32x4* d4 = (f32x4*)(XR + (size_t)row * D) + lane;
#pragma unroll
            for (int j = 0; j < 8; ++j) d4[64 * j] = s4[64 * j];
        }
    }
    if (F.vcu < 192) ada_item(F, a, F.vcu / 48, F.vcu % 48);
    transpose_all<0>(F, a.in[8], D, DFF, (bf16_t*)(ws + WS_WIN_T));
    transpose_all<0>(F, a.in[9], DFF, D, (bf16_t*)(ws + WS_WOUT_T), LDH);
    transpose_all<0>(F, a.in[11], D, D, (bf16_t*)(ws + WS_FNO_T));
    transpose_all<0>(F, a.in[12], D, 4096, (bf16_t*)(ws + WS_GMIN_T));
    transpose_all<1>(F, a.in[18], D, 6144, (bf16_t*)(ws + WS_DFIN_T));
    transpose_all<0>(F, a.in[21], D, D, (bf16_t*)(ws + WS_DFOUT_T));
    transpose_all<0>(F, a.in[22], D, 6176, (bf16_t*)(ws + WS_GLIN_T));
    transpose_all<0>(F, a.in[26], D, D, (bf16_t*)(ws + WS_GLOUT_T));
    {
        u32x4* z = (u32x4*)((bf16_t*)(ws + WS_GLIN_T) + (size_t)6176 * D);
        const int n16 = 224 * D * 2 / 16;
        for (int i = gw * 64 + lane; i < n16; i += NGW * 64) z[i] = (u32x4){0u, 0u, 0u, 0u};
    }
    {
        bf16_t* TC = (bf16_t*)(ws + WS_TC); bf16_t* PT = (bf16_t*)(ws + WS_PT); bf16_t* PC = (bf16_t*)(ws + WS_PC);
        const int gt = gw * 64 + lane, NT = NGW * 64;
        for (int i = gt; i < 2 * 2048 * 4096 / 8; i += NT) {
            const int row = i >> 9, n0 = (i & 511) * 8, type = row >> 11, k = row & 2047; unsigned w[4];
#pragma unroll
            for (int e = 0; e < 8; e += 2) { float s0, c0, s1, c1; sincospif((float)((k * (n0 + e)) & 4095) * (1.f / 2048.f), &s0, &c0); sincospif((float)((k * (n0 + e + 1)) & 4095) * (1.f / 2048.f), &s1, &c1);
                w[e >> 1] = type ? pk2(s0, s1) : pk2(c0, c1); }
            *(u32x4*)(PT + (size_t)row * LDP + n0) = (u32x4){w[0], w[1], w[2], w[3]};
        }
        for (int i = gt; i < 1024 * 512 / 8; i += NT) {
            const int r = i >> 6, c0 = (i & 63) * 8; const bool isn = r >= 512; const int rr = r & 511; unsigned w[4];
#pragma unroll
            for (int e = 0; e < 8; e += 2) { float s0, cc0, s1, cc1; sincospif((float)((rr * (c0 + e)) & 511) * (1.f / 256.f), &s0, &cc0); sincospif((float)((rr * (c0 + e + 1)) & 511) * (1.f / 256.f), &s1, &cc1);
                w[e >> 1] = isn ? pk2(s0, s1) : pk2(cc0, cc1); }
            *(u32x4*)(TC + (size_t)r * 512 + c0) = (u32x4){w[0], w[1], w[2], w[3]};
        }
        for (int i = gt; i < 256 * 512 / 8; i += NT) {
            const int k = i >> 6, j0 = (i & 63) * 8; const bool isn = j0 >= 256; const int n0 = j0 & 255; unsigned w[4];
#pragma unroll
            for (int e = 0; e < 8; e += 2) { float s0, c0, s1, c1; sincospif((float)((k * (n0 + e)) & 255) * (1.f / 128.f), &s0, &c0); sincospif((float)((k * (n0 + e + 1)) & 255) * (1.f / 128.f), &s1, &c1);
                w[e >> 1] = isn ? pk2(-s0, -s1) : pk2(c0, c1); }
            *(u32x4*)(PC + (size_t)k * 512 + j0) = (u32x4){w[0], w[1], w[2], w[3]};
        }
        {
            float* rc = (float*)(ws + WS_ROPE); float* rs = rc + 4096 * 64;
            for (int i = gt; i < 4096 * 64; i += NT) { const int pos = i >> 6, j = i & 63; const float inv = powf(10000.f, -(float)(j & 31) * (1.f / 32.f));
                const float ang = (float)(j < 32 ? (pos >> 6) : (pos & 63)) * inv; float sn, cs; sincosf(ang, &sn, &cs); rc[i] = cs; rs[i] = sn; }
        }
        const float* wsf = a.in[15]; bf16_t* wsb = (bf16_t*)(ws + WS_GMWS);
        for (int i = gt; i < 16 * 128 * 128 / 8; i += NT) { const f32x4 x0 = *(const f32x4*)(wsf + (size_t)i * 8), x1 = *(const f32x4*)(wsf + (size_t)i * 8 + 4);
            *(u32x4*)(wsb + (size_t)i * 8) = (u32x4){pk2(x0.x, x0.y), pk2(x0.z, x0.w), pk2(x1.x, x1.y), pk2(x1.z, x1.w)}; }
    }
}

__device__ __forceinline__ void phase_modulate(Frame& F, float* X, const float* g, const float* shift, const float* scale, bf16_t* H, bool skip_ctx, const float* pend = nullptr, int pend_ks = 0, const float* pgate = nullptr) {
    const int f_tid = fresh_tid(), f_lane = f_tid & 63, f_wave = __builtin_amdgcn_readfirstlane(f_tid >> 6); (void)f_lane; (void)f_wave;
    const int gw = F.vcu * NWAVES + f_wave, NGW = F.G * NWAVES, lane = f_lane;
    for (int row = gw; row < M; row += NGW) {
        const int mr = mrow_of_tile(row >> 8);
        if (skip_ctx && mr == 2) continue;
        f32x4* xr = (f32x4*)(X + (size_t)row * D) + lane;
        f32x4 v[8]; float s = 0.f;
#pragma unroll
        for (int j = 0; j < 8; ++j) v[j] = xr[64 * j];
        if (pend && mr == 2) {
            const int b = row >= RB ? 1 : 0, cr = b * 256 + (row - b * RB - SEQ);
            f32x4 ps[8];
#pragma unroll
            for (int j = 0; j < 8; ++j) ps[j] = (f32x4){0.f, 0.f, 0.f, 0.f};
            for (int ks = 0; ks < pend_ks; ++ks) { const f32x4* pp = (const f32x4*)(pend + ((size_t)ks * 512 + cr) * D) + lane;
#pragma unroll
                for (int j = 0; j < 8; ++j) ps[j] = ps[j] + pp[64 * j]; }
            const f32x4* pg4 = (const f32x4*)(pgate + (size_t)2 * NMOD) + lane;
#pragma unroll
            for (int j = 0; j < 8; ++j) { v[j] = v[j] + pg4[64 * j] * ps[j]; xr[64 * j] = v[j]; }
        }
#pragma unroll
        for (int j = 0; j < 8; ++j) s += (v[j].x * v[j].x + v[j].y * v[j].y) + (v[j].z * v[j].z + v[j].w * v[j].w);
        const float r = rsqrtf(wave_sum(s) * (1.f / D) + 1e-6f);
        const f32x4* g4 = (const f32x4*)g + lane; const f32x4* sc4 = (const f32x4*)(scale + (size_t)mr * NMOD) + lane; const f32x4* sh4 = (const f32x4*)(shift + (size_t)mr * NMOD) + lane;
        u32x2* o8 = (u32x2*)(H + (size_t)row * D) + lane;
#pragma unroll
        for (int j = 0; j < 8; ++j) { const f32x4 o = v[j] * r * g4[64 * j] * (sc4[64 * j] + 1.f) + sh4[64 * j];
            u32x2 w; w.x = cvt_pk_bf16(o.x, o.y); w.y = cvt_pk_bf16(o.z, o.w); o8[64 * j] = w; }
    }
}
__device__ __forceinline__ void phase_final(Frame& F, const float* X, const float* g, float* out) {
    const int f_tid = fresh_tid(), f_lane = f_tid & 63, f_wave = __builtin_amdgcn_readfirstlane(f_tid >> 6); (void)f_lane; (void)f_wave;
    const int gw = F.vcu * NWAVES + f_wave, NGW = F.G * NWAVES, lane = f_lane;
    for (int orow = gw; orow < BATCH * SEQ; orow += NGW) {
        const int b = orow >> 12, t = orow & 4095;
        const f32x4* xr = (const f32x4*)(X + (size_t)(b * RB + t) * D) + lane;
        f32x4 v[8]; float s = 0.f;
#pragma unroll
        for (int j = 0; j < 8; ++j) { v[j] = xr[64 * j]; s += (v[j].x * v[j].x + v[j].y * v[j].y) + (v[j].z * v[j].z + v[j].w * v[j].w); }
        const float r = rsqrtf(wave_sum(s) * (1.f / D) + 1e-6f);
        const f32x4* g4 = (const f32x4*)g + lane; f32x4* o4 = (f32x4*)(out + (size_t)orow * D) + lane;
#pragma unroll
        for (int j = 0; j < 8; ++j) o4[64 * j] = v[j] * r * g4[64 * j];
    }
}

__device__ __forceinline__ void phase_spatial(Frame& F, const bf16_t* Z, const float* LNS, const float* ln_g, const float* ln_b, const bf16_t* WsB, const float* b_s, bf16_t* OUT) {
    const int f_tid = fresh_tid(), f_lane = f_tid & 63, f_wave = __builtin_amdgcn_readfirstlane(f_tid >> 6); (void)f_lane; (void)f_wave;
    LAS bf16_t* VT = (LAS bf16_t*)(F.lds); LAS float* S = (LAS float*)(F.lds + 36864); LAS float* ST = (LAS float*)(F.lds + 104448);
    const int tid = f_tid, lane = f_lane, w = f_wave, l32 = lane & 31, hi = lane >> 5;
    for (int unit = F.vcu; unit < 68 * 16; unit += F.G) {
        const int chunk = unit >> 4, h = unit & 15; const int row0 = chunk * 128;
        if (tid < 128) { float sm = 0.f, sq = 0.f; const f32x2* pp = (const f32x2*)(LNS + (size_t)(row0 + tid) * 64);
#pragma unroll
            for (int j = 0; j < 32; ++j) { const f32x2 t = pp[j]; sm += t.x; sq += t.y; }
            const float mu = sm * (1.f / 2048.f); const float var = sq * (1.f / 2048.f) - mu * mu;
            ST[tid * 2] = mu; ST[tid * 2 + 1] = rsqrtf(fmaxf(var, 0.f) + 1e-5f); }
        __syncthreads();
#pragma unroll
        for (int i = 0; i < 4; ++i) { const int idx = tid + 512 * i, q = idx >> 4, e8 = (idx & 15) * 8;
            const u32x4 raw = *(const u32x4*)(Z + (size_t)(row0 + q) * 4096 + 2048 + h * 128 + e8);
            const float mu = ST[q * 2], rs = ST[q * 2 + 1];
            const f32x4 g0 = *(const f32x4*)(ln_g + h * 128 + e8), g1 = *(const f32x4*)(ln_g + h * 128 + e8 + 4), b0 = *(const f32x4*)(ln_b + h * 128 + e8), b1 = *(const f32x4*)(ln_b + h * 128 + e8 + 4);
            float v[8] = {bflo(raw.x), bfhi(raw.x), bflo(raw.y), bfhi(raw.y), bflo(raw.z), bfhi(raw.z), bflo(raw.w), bfhi(raw.w)};
            const float gg[8] = {g0.x, g0.y, g0.z, g0.w, g1.x, g1.y, g1.z, g1.w}, bb[8] = {b0.x, b0.y, b0.z, b0.w, b1.x, b1.y, b1.z, b1.w};
#pragma unroll
            for (int j = 0; j < 8; ++j) { const float o = (v[j] - mu) * rs * gg[j] + bb[j]; VT[(e8 + j) * 136 + q] = (bf16_t)f2bf(o); } }
        __syncthreads();
        const int pt = w >> 1, et0 = (w & 1) * 2;
        f32x16 acc0 = {}, acc1 = {};
        const bf16_t* Ap = WsB + ((size_t)h * 128 + pt * 32 + l32) * 128 + hi * 8;
#pragma unroll
        for (int ks = 0; ks < 8; ++ks) {
            const bf16x8 af = *(const bf16x8*)(Ap + ks * 16);
            const bf16x8 b0 = *(const LAS bf16x8*)(VT + (et0 * 32 + l32) * 136 + ks * 16 + hi * 8);
            const bf16x8 b1 = *(const LAS bf16x8*)(VT + ((et0 + 1) * 32 + l32) * 136 + ks * 16 + hi * 8);
            acc0 = __builtin_amdgcn_mfma_f32_32x32x16_bf16(af, b0, acc0, 0, 0, 0);
            acc1 = __builtin_amdgcn_mfma_f32_32x32x16_bf16(af, b1, acc1, 0, 0, 0);
        }
#pragma unroll
        for (int r = 0; r < 16; ++r) { const int p = pt * 32 + (r & 3) + 8 * (r >> 2) + 4 * hi; const float bs = b_s[h * 128 + p];
            S[p * 132 + et0 * 32 + l32] = acc0[r] + bs; S[p * 132 + (et0 + 1) * 32 + l32] = acc1[r] + bs; }
        __syncthreads();
#pragma unroll
        for (int i = 0; i < 4; ++i) { const int idx = tid + 512 * i, p = idx >> 4, e8 = (idx & 15) * 8;
            const u32x4 raw = *(const u32x4*)(Z + (size_t)(row0 + p) * 4096 + h * 128 + e8);
            const LAS float* sp = S + p * 132 + e8;
            u32x4 o; o.x = cvt_pk_bf16(bflo(raw.x) * sp[0], bfhi(raw.x) * sp[1]); o.y = cvt_pk_bf16(bflo(raw.y) * sp[2], bfhi(raw.y) * sp[3]);
            o.z = cvt_pk_bf16(bflo(raw.z) * sp[4], bfhi(raw.z) * sp[5]); o.w = cvt_pk_bf16(bflo(raw.w) * sp[6], bfhi(raw.w) * sp[7]);
            *(u32x4*)(OUT + (size_t)(row0 + p) * D + h * 128 + e8) = o; }
        __syncthreads();
    }
}

__device__ __forceinline__ void phase_lnstats(Frame& F, const bf16_t* Z, float* LNS) {
    const int f_tid = fresh_tid(), f_lane = f_tid & 63, f_wave = __builtin_amdgcn_readfirstlane(f_tid >> 6); (void)f_lane; (void)f_wave;
    const int gw = F.vcu * NWAVES + f_wave, NGW = F.G * NWAVES, lane = f_lane;
    for (int row = gw; row < M; row += NGW) {
        const u32x4* zr = (const u32x4*)(Z + (size_t)row * 4096 + 2048) + lane; float s = 0.f, q = 0.f;
#pragma unroll
        for (int j = 0; j < 4; ++j) { const u32x4 r = zr[64 * j]; const float v[8] = {bflo(r.x), bfhi(r.x), bflo(r.y), bfhi(r.y), bflo(r.z), bfhi(r.z), bflo(r.w), bfhi(r.w)};
#pragma unroll
            for (int e = 0; e < 8; ++e) { s += v[e]; q += v[e] * v[e]; } }
        s = wave_sum(s); q = wave_sum(q);
        if (lane < 32) *(f32x2*)(LNS + (size_t)row * 64 + lane * 2) = lane == 0 ? (f32x2){s, q} : (f32x2){0.f, 0.f};
    }
}

__device__ __forceinline__ void phase_fourier_combine(Frame& F, const float* Gp, const bf16_t* PosB, bf16_t* OUT) {
    const int f_tid = fresh_tid(), f_lane = f_tid & 63, f_wave = __builtin_amdgcn_readfirstlane(f_tid >> 6);
    const int gw = F.vcu * NWAVES + f_wave, NGW = F.G * NWAVES, lane = f_lane; constexpr float SC = 0.00069053396600248786f;
    for (int it = gw; it < 2 * 2048; it += NGW) { const int b = it >> 11, k = it & 2047;
        const f32x4* fc = (const f32x4*)(Gp + ((size_t)(0 * 2 + b) * 2048 + k) * D) + lane; const f32x4* fs = (const f32x4*)(Gp + ((size_t)(1 * 2 + b) * 2048 + k) * D) + lane;
        u32x2* o1 = (u32x2*)(OUT + ((size_t)b * RB + k) * D) + lane; u32x2* o2 = (u32x2*)(OUT + ((size_t)b * RB + ((4096 - k) & 4095)) * D) + lane;
#pragma unroll
        for (int j = 0; j < 8; ++j) { const f32x4 c = fc[64 * j], s = fs[64 * j]; const f32x4 lo = (c - s) * SC, hi = (c + s) * SC;
            u32x2 w; w.x = cvt_pk_bf16(lo.x, lo.y); w.y = cvt_pk_bf16(lo.z, lo.w); o1[64 * j] = w;
            if (k != 0) { w.x = cvt_pk_bf16(hi.x, hi.y); w.y = cvt_pk_bf16(hi.z, hi.w); o2[64 * j] = w; } } }
    for (int it = gw; it < 2 * 2048; it += NGW) { const int b = it >> 11, ch = it & 2047;
        const u32x4* yr = (const u32x4*)(PosB + ((size_t)b * 2048 + ch) * LDH) + lane; float s = 0.f;
#pragma unroll
        for (int j = 0; j < 8; ++j) { const u32x4 r = yr[64 * j]; s += (bflo(r.x) - bfhi(r.x)) + (bflo(r.y) - bfhi(r.y)) + (bflo(r.z) - bfhi(r.z)) + (bflo(r.w) - bfhi(r.w)); }
        s = wave_sum(s);
        if (lane == 0) OUT[((size_t)b * RB + 2048) * D + ch] = (bf16_t)f2bf(s * SC); }
}
namespace attn3 {
using bf16 = unsigned short;
constexpr float THR2 = 11.5f;
#define SBAR() __builtin_amdgcn_sched_barrier(0)
__device__ __forceinline__ int crow(int r, int hi) { return (r & 3) + 8 * (r >> 2) + 4 * hi; }
__device__ __forceinline__ unsigned cvtpk(float lo, float hi) { unsigned r; asm volatile("v_cvt_pk_bf16_f32 %0, %1, %2" : "=v"(r) : "v"(lo), "v"(hi)); return r; }
__device__ __forceinline__ int v_rd_base(int lane) { return ((lane & 3) << 3) | (((lane >> 2) & 3) << 6) | (((lane >> 4) & 1) << 5) | (((lane >> 5) & 1) << 8); }
constexpr int v_rd_off(int d0, int ks, int half) { return (d0 >> 2) * 8192 + (d0 & 3) * 512 + ks * 4096 + half * 2048; }
template <int OFF> __device__ __forceinline__ s16x4 tr_read(int vb) {
  s16x4 r; asm volatile("ds_read_b64_tr_b16 %0, %1 offset:%2" : "=&v"(r) : "v"(vb), "i"(OFF) : "memory"); return r;
}
#define TRD(D0, A0, A1, A2, A3) do { A0 = tr_read<v_rd_off(D0, 0, 0)>(vb); A1 = tr_read<v_rd_off(D0, 0, 1)>(vb); A2 = tr_read<v_rd_off(D0, 1, 0)>(vb); A3 = tr_read<v_rd_off(D0, 1, 1)>(vb); } while (0)
#define PVM(OD, A0, A1, A2, A3) do { OD = __builtin_amdgcn_mfma_f32_32x32x16_bf16(paA, (bf16x8){A0[0], A0[1], A0[2], A0[3], A1[0], A1[1], A1[2], A1[3]}, OD, 0, 0, 0); \
    OD = __builtin_amdgcn_mfma_f32_32x32x16_bf16(paB, (bf16x8){A2[0], A2[1], A2[2], A2[3], A3[0], A3[1], A3[2], A3[3]}, OD, 0, 0, 0); } while (0)
#define LW(n) do { asm volatile("s_waitcnt lgkmcnt(" #n ")" ::: "memory"); SBAR(); } while (0)
__device__ __forceinline__ void pv_all(f32x16* o, int vb, bf16x8 paA, bf16x8 paB) {
  s16x4 a0, a1, a2, a3, b0, b1, b2, b3;
  TRD(0, a0, a1, a2, a3); TRD(1, b0, b1, b2, b3); LW(4); PVM(o[0], a0, a1, a2, a3); SBAR();
  TRD(2, a0, a1, a2, a3); LW(4); PVM(o[1], b0, b1, b2, b3); SBAR();
  TRD(3, b0, b1, b2, b3); LW(4); PVM(o[2], a0, a1, a2, a3); SBAR();
  TRD(4, a0, a1, a2, a3); LW(4); PVM(o[3], b0, b1, b2, b3); SBAR();
  TRD(5, b0, b1, b2, b3); LW(4); PVM(o[4], a0, a1, a2, a3); SBAR();
  TRD(6, a0, a1, a2, a3); LW(4); PVM(o[5], b0, b1, b2, b3); SBAR();
  TRD(7, b0, b1, b2, b3); LW(4); PVM(o[6], a0, a1, a2, a3); SBAR();
  LW(0); PVM(o[7], b0, b1, b2, b3); SBAR();
}
#undef TRD
#undef PVM
#undef LW
__device__ __forceinline__ void unit(const bf16* __restrict__ Qb, const bf16* __restrict__ Kb, const bf16* __restrict__ Vb, bf16* __restrict__ Ob, int seq, float lam, const float* __restrict__ gsub, LAS unsigned char* lds) {
  const int tid = fresh_tid(), wid = __builtin_amdgcn_readfirstlane(tid >> 6), lane = tid & 63, r32 = lane & 31, hi = lane >> 5, comp = wid >> 2, wq = wid & 3;
  lam = __int_as_float(__builtin_amdgcn_readfirstlane(__float_as_int(lam)));
  LAS float* wsf = (LAS float*)(lds + 131072) + wid * 64;
  float m_reg = -1e30f, l_reg = 0.f; f32x16 o[8] = {}; bf16x8 qr[8];
  { const bf16* Qw = Qb + (long)(wq * 32 + r32) * 6144 + comp * 128 + hi * 8;
#pragma unroll
    for (int d0 = 0; d0 < 8; ++d0) qr[d0] = *reinterpret_cast<const bf16x8*>(Qw + d0 * 16); }
  const bf16* sbase = (wid < 4) ? Kb + (wid >> 1) * 128 : Vb + ((wid - 4) >> 1) * 128;
#define ISSUE(t, buf) do { const int ln_ = fresh_tid() & 63; const bf16* _s = sbase + (long)(t) * 32 * 6144; _Pragma("unroll") for (int _i = 0; _i < 4; ++_i) { \
      const int g_ = (wid & 1) * 256 + _i * 64 + ln_; int row_, col_; \
      if (wid < 4) { row_ = g_ >> 4; col_ = ((g_ & 15) ^ (row_ & 7)) * 8; } \
      else { const int sub_ = g_ >> 5, wv_ = g_ & 31, kk_ = ((sub_ >> 2) << 3) | (wv_ >> 2); row_ = (kk_ & ~0xC) | ((kk_ & 4) << 1) | ((kk_ & 8) >> 1); col_ = ((sub_ & 3) << 5) | ((wv_ & 3) << 3); } \
      __builtin_amdgcn_global_load_lds((const unsigned*)(_s + row_ * 6144 + col_), (LAS unsigned*)(lds + (buf) * 32768 + wid * 4096 + _i * 1024), 16, 0, 0); } } while (0)
  int kbase[4];
#pragma unroll
  for (int q = 0; q < 4; ++q) kbase[q] = r32 * 256 + ((q * 32 + hi * 16) ^ ((r32 & 7) << 4));
#define QK(P, buf) do { const LAS unsigned char* Ks_ = lds + (buf) * 32768 + comp * 8192; P = (f32x16){}; _Pragma("unroll") for (int d0 = 0; d0 < 8; ++d0) { \
      const bf16x8 b0_ = *reinterpret_cast<const LAS bf16x8*>(Ks_ + kbase[d0 & 3] + (d0 >> 2) * 128); P = __builtin_amdgcn_mfma_f32_32x32x16_bf16(b0_, qr[d0], P, 0, 0, 0); } } while (0)
  const int NT = seq >> 5;
  ISSUE(0, 0); ISSUE(1, 1); ISSUE(2, 2);
  asm volatile("s_waitcnt vmcnt(0)" ::: "memory"); __builtin_amdgcn_s_barrier(); asm volatile("" ::: "memory");
  f32x16 pc; QK(pc, 0);
  for (int j = 0; j < NT; ++j) {
    if (j + 3 < NT) ISSUE(j + 3, (j + 3) & 3);
    f32x16 pn = {};
    if (j + 1 < NT) QK(pn, (j + 1) & 3);
    float pmax = pc[0];
#pragma unroll
    for (int r = 1; r < 16; ++r) pmax = fmaxf(pmax, pc[r]);
    { auto rr = __builtin_amdgcn_permlane32_swap(__float_as_uint(pmax), __float_as_uint(pmax), false, false); pmax = fmaxf(__uint_as_float(rr[0]), __uint_as_float(rr[1])); }
    float mn, alpha;
    if (__builtin_expect(__all(pmax - m_reg <= THR2), 1)) { mn = m_reg; alpha = 1.f; }
    else { mn = fmaxf(m_reg, pmax); alpha = __builtin_amdgcn_exp2f(m_reg - mn); m_reg = mn; }
    float ps = 0.f;
#pragma unroll
    for (int r = 0; r < 16; ++r) { pc[r] = __builtin_amdgcn_exp2f(pc[r] - mn); ps += pc[r]; }
    { auto rr = __builtin_amdgcn_permlane32_swap(__float_as_uint(ps), __float_as_uint(ps), false, false); ps = __uint_as_float(rr[0]) + __uint_as_float(rr[1]); }
    l_reg = l_reg * alpha + ps;
    bf16x8 paA, paB;
#define PK4(P, BASE, OUT) do { unsigned a0 = cvtpk(P[BASE + 0], P[BASE + 1]), a1 = cvtpk(P[BASE + 2], P[BASE + 3]);   \
    unsigned b0_ = cvtpk(P[BASE + 4], P[BASE + 5]), b1_ = cvtpk(P[BASE + 6], P[BASE + 7]);                              \
    auto r0 = __builtin_amdgcn_permlane32_swap(a0, b0_, false, false); auto r1 = __builtin_amdgcn_permlane32_swap(a1, b1_, false, false); \
    u32x4 w_ = {r0[0], r1[0], r0[1], r1[1]}; OUT = *reinterpret_cast<bf16x8*>(&w_); } while (0)
    PK4(pc, 0, paA); PK4(pc, 8, paB);
#undef PK4
    if (__any(alpha < 1.f)) { if (hi == 0) wsf[r32] = alpha; asm volatile("s_waitcnt lgkmcnt(0)" ::: "memory");
#pragma unroll
      for (int d = 0; d < 8; ++d)
#pragma unroll
        for (int r = 0; r < 16; ++r) o[d][r] *= wsf[crow(r, hi)]; }
    const int vb = (int)(uintptr_t)(lds + (j & 3) * 32768 + 16384) + v_rd_base(lane);
    pv_all(o, vb, paA, paB);
    pc = pn;
    if (j + 3 < NT) asm volatile("s_waitcnt vmcnt(4) lgkmcnt(0)" ::: "memory"); else asm volatile("s_waitcnt vmcnt(0) lgkmcnt(0)" ::: "memory");
    __builtin_amdgcn_s_barrier(); asm volatile("" ::: "memory");
  }
#undef ISSUE
#undef QK
  if (hi == 0) wsf[r32] = l_reg; asm volatile("s_waitcnt lgkmcnt(0)" ::: "memory");
  LAS float* X = (LAS float*)(lds + wq * 32768);
  if (comp == 1) {
#pragma unroll
    for (int r = 0; r < 16; ++r) { const float ri = __builtin_amdgcn_rcpf(wsf[crow(r, hi)]);
#pragma unroll
      for (int d = 0; d < 8; ++d) X[crow(r, hi) * 256 + d * 32 + r32] = o[d][r] * ri; }
  }
  __syncthreads();
  if (comp == 0) {
#pragma unroll
    for (int r = 0; r < 16; ++r) { const float ri = __builtin_amdgcn_rcpf(wsf[crow(r, hi)]);
#pragma unroll
      for (int d = 0; d < 8; ++d) { LAS float* xp = X + crow(r, hi) * 256 + d * 32 + r32; *xp = o[d][r] * ri - lam * (*xp); } }
    asm volatile("s_waitcnt lgkmcnt(0)" ::: "memory");
    const int row = lane >> 1, half = lane & 1; const LAS float* xr = X + row * 256 + half * 128; float ssq = 0.f;
#pragma unroll 8
    for (int i = 0; i < 32; ++i) { const f32x4 v = *(const LAS f32x4*)(xr + ((i + row) & 31) * 4); ssq += (v.x * v.x + v.y * v.y) + (v.z * v.z + v.w * v.w); }
    ssq += __shfl_xor(ssq, 1);
    const float sc = rsqrtf(ssq * (1.f / 256.f) + 1e-6f) * (1.f - 0.47071301834358414f);
    bf16* orow = Ob + (long)(wq * 32 + row) * 2048 + half * 128;
#pragma unroll 4
    for (int i = 0; i < 16; ++i) { const int c8 = ((i + row) & 15) * 8; const f32x4 v0 = *(const LAS f32x4*)(xr + c8), v1 = *(const LAS f32x4*)(xr + c8 + 4);
      const f32x4 g0 = *(const f32x4*)(gsub + half * 128 + c8), g1 = *(const f32x4*)(gsub + half * 128 + c8 + 4);
      *(u32x4*)(orow + c8) = (u32x4){cvtpk(v0.x * sc * g0.x, v0.y * sc * g0.y), cvtpk(v0.z * sc * g0.z, v0.w * sc * g0.w), cvtpk(v1.x * sc * g1.x, v1.y * sc * g1.y), cvtpk(v1.z * sc * g1.z, v1.w * sc * g1.w)}; }
  }
  __syncthreads();
}
#undef SBAR
}

__device__ __forceinline__ void phase_attention2(Frame& F, const bf16_t* QKV, const float* lamv, const float* gsub, bf16_t* OUT, int rep = 1) {
    const int lane = fresh_tid() & 63;
    const float d0 = wave_sum(lamv[lane] * lamv[128 + lane] + lamv[64 + lane] * lamv[192 + lane]);
    const float d1 = wave_sum(lamv[256 + lane] * lamv[384 + lane] + lamv[320 + lane] * lamv[448 + lane]);
    const float lam = expf(d0) - expf(d1) + 0.47071301834358414f;
    for (int it = 0;; ++it) { const int L = (it / rep) * F.G + (int)blockIdx.x; if (L >= 544) break;
        int b, h, seq; long krow0, qrow0;
        if (L < 512) { const int qb = L & 31; h = (L >> 5) & 7; b = L >> 8; seq = RB; krow0 = (long)b * RB; qrow0 = krow0 + qb * 128; }
        else { const int r = L - 512; const int qb = r & 1; h = (r >> 1) & 7; b = r >> 4; seq = CTX; krow0 = (long)b * RB + SEQ; qrow0 = krow0 + qb * 128; }
        attn3::unit(QKV + qrow0 * 6144 + h * 256, QKV + krow0 * 6144 + 2048 + h * 256, QKV + krow0 * 6144 + 4096 + h * 256, OUT + qrow0 * 2048 + h * 256, seq, lam, gsub, F.lds);
    }
}
constexpr size_t G_QD = WS_G1, G_KT = WS_G1 + 34 * MiB, G_VT = WS_G1 + 68 * MiB, G_ATT = WS_G1 + 102 * MiB, G_DEC = WS_G1 + 111 * MiB, G_GD = WS_G1 + 113 * MiB;
__device__ __forceinline__ void phase_gla_pre(Frame& F, const bf16_t* P, const float* GD, const float* wup, const float* bgate, unsigned char* ws, int rep = 1) {
    const int f_tid = fresh_tid(), f_lane = f_tid & 63, f_wave = __builtin_amdgcn_readfirstlane(f_tid >> 6); (void)f_lane; (void)f_wave;
    LAS bf16_t* QDs = (LAS bf16_t*)(F.lds); LAS bf16_t* KIs = (LAS bf16_t*)(F.lds + 33792); LAS float* gds = (LAS float*)(F.lds + 67584); LAS float* tot = (LAS float*)(F.lds + 71680); LAS bf16_t* VS = (LAS bf16_t*)(F.lds + 73728);
    bf16_t* QD = (bf16_t*)(ws + G_QD); bf16_t* KT = (bf16_t*)(ws + G_KT); bf16_t* VT = (bf16_t*)(ws + G_VT); bf16_t* ATT = (bf16_t*)(ws + G_ATT); float* DEC = (float*)(ws + G_DEC);
    const int tid = f_tid, lane = f_lane, w = f_wave, d = tid & 255, th = tid >> 8;
    for (int it = 0;; ++it) { const int unit = (it / rep) * F.G + F.vcu; if (unit >= 1088) break;
        const int dir = unit & 1, h = (unit >> 1) & 3; int b, c;
        if (unit < 1024) { const int lc = unit >> 3; b = lc >> 6; c = lc & 63; } else { const int cc = (unit - 1024) >> 3; b = cc >> 2; c = 64 + (cc & 3); }
        const int uidx = b * 68 + c; const bool isctx = c >= 64;
        const size_t row0 = (size_t)b * RB + (size_t)c * 64;
        { const int t = tid >> 3, r2 = (tid & 7) * 2; const f32x2 gv = *(const f32x2*)(GD + (row0 + t) * 32 + dir * 16 + r2); gds[t * 16 + r2] = gv.x; gds[t * 16 + r2 + 1] = gv.y; }
#pragma unroll
        for (int i = 0; i < 4; ++i) { const int idx = tid + 512 * i, t = idx >> 5, c8 = (idx & 31) * 8; const bf16_t* src = P + (row0 + t) * 6400 + h * 256 + c8;
            *(LAS u32x4*)(QDs + t * 264 + c8) = *(const u32x4*)src; *(LAS u32x4*)(KIs + t * 264 + c8) = *(const u32x4*)(src + 1024); }
        if (dir == 0) {
#pragma unroll
            for (int i = 0; i < 8; ++i) { const int idx = tid + 512 * i, sx = idx >> 6, c8 = (idx & 63) * 8; *(LAS u32x4*)(VS + sx * 520 + c8) = *(const u32x4*)(P + (row0 + sx) * 6400 + 2048 + h * 512 + c8); }
        }
        float wu[16];
#pragma unroll
        for (int r = 0; r < 16; ++r) wu[r] = wup[(size_t)(dir * 16 + r) * 1024 + h * 256 + d];
        const float bgv = bgate[dir * 1024 + h * 256 + d];
        __syncthreads();
        if (dir == 0) {
            u32x4* dst = (u32x4*)(VT + ((size_t)uidx * 2048 + h * 512 + tid) * 64);
#pragma unroll
            for (int s8 = 0; s8 < 8; ++s8) { unsigned e[8];
#pragma unroll
                for (int j = 0; j < 8; ++j) e[j] = VS[(s8 * 8 + j) * 520 + tid];
                dst[s8] = (u32x4){e[0] | (e[1] << 16), e[2] | (e[3] << 16), e[4] | (e[5] << 16), e[6] | (e[7] << 16)}; }
        }
        float bc[32]; float run = 0.f;
#pragma unroll
        for (int i = 0; i < 32; ++i) { const int t = th * 32 + i; float z = bgv;
#pragma unroll
            for (int r = 0; r < 16; ++r) z = fmaf(gds[t * 16 + r], wu[r], z);
            bc[i] = (fminf(z, 0.f) - __logf(1.f + __expf(-fabsf(z)))) * 0.0625f; }
        if (dir == 0) {
#pragma unroll
            for (int i = 0; i < 32; ++i) { run += bc[i]; bc[i] = run; }
        } else {
#pragma unroll
            for (int i = 31; i >= 0; --i) { run += bc[i]; bc[i] = run; }
        }
        tot[th * 256 + d] = run;
        __syncthreads();
        const float t0v = tot[d], t1v = tot[256 + d]; const float blast = t0v + t1v;
        const float addv = (dir == 0) ? (th == 1 ? t0v : 0.f) : (th == 0 ? t1v : 0.f);
        unsigned ktp[16];
#pragma unroll
        for (int i = 0; i < 32; i += 2) {
            float kt2[2];
#pragma unroll
            for (int e = 0; e < 2; ++e) { const int t = th * 32 + i + e; const float bcum = bc[i + e] + addv;
                const float qv = bf2f(QDs[t * 264 + d]), kv = bf2f(KIs[t * 264 + d]);
                const float ex = __expf(bcum); const float qd = qv * 0.0625f * ex, ki = kv * __expf(-bcum); kt2[e] = kv * __expf(blast - bcum);
                QDs[t * 264 + d] = (bf16_t)f2bf(qd); KIs[t * 264 + d] = (bf16_t)f2bf(ki); }
            ktp[i >> 1] = cvt_pk_bf16(kt2[0], kt2[1]);
        }
        { u32x4* dst = (u32x4*)(KT + ((((size_t)dir * 136 + uidx) * 4 + h) * 256 + d) * 64 + th * 32);
#pragma unroll
          for (int j = 0; j < 4; ++j) dst[j] = (u32x4){ktp[4 * j], ktp[4 * j + 1], ktp[4 * j + 2], ktp[4 * j + 3]}; }
        if (th == 0) DEC[(((size_t)dir * 136 + uidx) * 4 + h) * 256 + d] = __expf(blast);
        __syncthreads();
        if (!isctx) {
#pragma unroll
            for (int i = 0; i < 4; ++i) { const int idx = tid + 512 * i, t = idx >> 5, c8 = (idx & 31) * 8;
                *(u32x4*)(QD + ((size_t)dir * M + row0 + t) * 1024 + h * 256 + c8) = *(const LAS u32x4*)(QDs + t * 264 + c8); }
        }
        if (!isctx) {
            const int fr = lane & 15, fq = lane >> 4;
#pragma unroll
            for (int tl = 0; tl < 2; ++tl) { const int tile = 2 * w + tl, ti = tile >> 2, si = tile & 3; f32x4 acc = {0.f, 0.f, 0.f, 0.f};
#pragma unroll
                for (int ks = 0; ks < 8; ++ks) { const bf16x8 af = *(const LAS bf16x8*)(QDs + (ti * 16 + fr) * 264 + ks * 32 + fq * 8), bfr = *(const LAS bf16x8*)(KIs + (si * 16 + fr) * 264 + ks * 32 + fq * 8);
                    acc = __builtin_amdgcn_mfma_f32_16x16x32_bf16(af, bfr, acc, 0, 0, 0); }
                bf16_t* ap = ATT + ((((size_t)dir * 136 + uidx) * 4 + h) * 64) * 64;
#pragma unroll
                for (int i = 0; i < 4; ++i) { const int t = ti * 16 + 4 * fq + i, s = si * 16 + fr; const bool keep = dir == 0 ? (s <= t) : (s >= t);
                    ap[t * 64 + s] = (bf16_t)f2bf(keep ? acc[i] : 0.f); } }
        }
        __syncthreads();
    }
}
__device__ __forceinline__ void phase_gla_scan(Frame& F, unsigned char* ws, float* O0, float* O1, int rep = 1) {
    const int f_tid = fresh_tid(), f_lane = f_tid & 63, f_wave = __builtin_amdgcn_readfirstlane(f_tid >> 6); (void)f_lane; (void)f_wave;
    LAS bf16_t* QDs = (LAS bf16_t*)(F.lds); LAS bf16_t* KTs = (LAS bf16_t*)(F.lds + 33792); LAS bf16_t* VTs = (LAS bf16_t*)(F.lds + 70656); LAS bf16_t* ATs = (LAS bf16_t*)(F.lds + 75264);
    LAS float* DECs = (LAS float*)(F.lds + 84480); LAS float* PART = (LAS float*)(F.lds + 85504);
    const bf16_t* QD = (const bf16_t*)(ws + G_QD); const bf16_t* KT = (const bf16_t*)(ws + G_KT); const bf16_t* VT = (const bf16_t*)(ws + G_VT); const bf16_t* ATT = (const bf16_t*)(ws + G_ATT); const float* DEC = (const float*)(ws + G_DEC);
    const int tid = f_tid, lane = f_lane, w = f_wave, l32 = lane & 31, hi = lane >> 5;
    for (int it = 0;; ++it) { const int L = (it / rep) * F.G + (int)blockIdx.x; if (L >= 256) break;
        const int slice = L & 15, combo = L >> 4, dir = combo & 1, h = (combo >> 1) & 3, b = combo >> 3;
        float* Od = dir ? O1 : O0;
        f32x16 S = {};
        u32x4 rq[4], rk[4], rv, ra, rd;
        rv = (u32x4){0u, 0u, 0u, 0u}; rd = rv;
#define GLA_LOAD(j) do { const int cc = dir == 0 ? ((j) < 4 ? 64 + (j) : (j) - 4) : 67 - (j); const int uidx = b * 68 + cc; const size_t row0 = (size_t)b * RB + (size_t)cc * 64; \
            const size_t kb = (((size_t)dir * 136 + uidx) * 4 + h); \
            _Pragma("unroll") for (int i = 0; i < 4; ++i) { const int idx = tid + 512 * i; rq[i] = *(const u32x4*)(QD + ((size_t)dir * M + row0 + (idx >> 5)) * 1024 + h * 256 + (idx & 31) * 8); \
                rk[i] = *(const u32x4*)(KT + kb * 16384 + (size_t)idx * 8); } \
            if (tid < 256) rv = *(const u32x4*)(VT + ((size_t)uidx * 2048 + h * 512 + slice * 32 + (tid >> 3)) * 64 + (tid & 7) * 8); \
            ra = *(const u32x4*)(ATT + kb * 4096 + (size_t)tid * 8); \
            if (tid < 64) rd = *(const u32x4*)(DEC + kb * 256 + tid * 4); } while (0)
        GLA_LOAD(0);
        for (int j = 0; j < 68; ++j) {
            const int cc = dir == 0 ? (j < 4 ? 64 + j : j - 4) : 67 - j; const bool isctx = cc >= 64; const size_t row0 = (size_t)b * RB + (size_t)cc * 64;
#pragma unroll
            for (int i = 0; i < 4; ++i) { const int idx = tid + 512 * i; *(LAS u32x4*)(QDs + (idx >> 5) * 264 + (idx & 31) * 8) = rq[i]; *(LAS u32x4*)(KTs + (idx >> 3) * 72 + (idx & 7) * 8) = rk[i]; }
            if (tid < 256) *(LAS u32x4*)(VTs + (tid >> 3) * 72 + (tid & 7) * 8) = rv;
            *(LAS u32x4*)(ATs + (tid >> 3) * 72 + (tid & 7) * 8) = ra;
            if (tid < 64) *(LAS u32x4*)(DECs + tid * 4) = rd;
            __syncthreads();
            if (j + 1 < 68) GLA_LOAD(j + 1);
            bf16x8 vb[4];
#pragma unroll
            for (int ks = 0; ks < 4; ++ks) vb[ks] = *(const LAS bf16x8*)(VTs + l32 * 72 + ks * 16 + hi * 8);
            if (!isctx) {
                bf16x8 sb[2];
#pragma unroll
                for (int jj = 0; jj < 2; ++jj) { u32x4 t4 = {cvt_pk_bf16(S[8 * jj + 0], S[8 * jj + 1]), cvt_pk_bf16(S[8 * jj + 2], S[8 * jj + 3]), cvt_pk_bf16(S[8 * jj + 4], S[8 * jj + 5]), cvt_pk_bf16(S[8 * jj + 6], S[8 * jj + 7])};
                    sb[jj] = *reinterpret_cast<bf16x8*>(&t4); }
                f32x16 ao[2] = {};
#pragma unroll
                for (int tt = 0; tt < 2; ++tt)
#pragma unroll
                    for (int jj = 0; jj < 2; ++jj) { const LAS bf16_t* qp = QDs + (tt * 32 + l32) * 264 + 32 * w + 16 * jj + 4 * hi;
                        const u32x2 lo = *(const LAS u32x2*)qp, hi2 = *(const LAS u32x2*)(qp + 8); u32x4 a4 = {lo.x, lo.y, hi2.x, hi2.y};
                        ao[tt] = __builtin_amdgcn_mfma_f32_32x32x16_bf16(*reinterpret_cast<bf16x8*>(&a4), sb[jj], ao[tt], 0, 0, 0); }
                if (w < 2) {
#pragma unroll
                    for (int ks = 0; ks < 4; ++ks) { const bf16x8 af = *(const LAS bf16x8*)(ATs + (w * 32 + l32) * 72 + ks * 16 + hi * 8);
                        if (w == 0) ao[0] = __builtin_amdgcn_mfma_f32_32x32x16_bf16(af, vb[ks], ao[0], 0, 0, 0); else ao[1] = __builtin_amdgcn_mfma_f32_32x32x16_bf16(af, vb[ks], ao[1], 0, 0, 0); }
                }
#pragma unroll
                for (int tt = 0; tt < 2; ++tt)
#pragma unroll
                    for (int r = 0; r < 16; ++r) PART[(w * 64 + tt * 32 + (r & 3) + 8 * (r >> 2) + 4 * hi) * 32 + l32] = ao[tt][r];
            }
#pragma unroll
            for (int r = 0; r < 16; ++r) S[r] *= DECs[32 * w + (r & 3) + 8 * (r >> 2) + 4 * hi];
#pragma unroll
            for (int ks = 0; ks < 4; ++ks) { const bf16x8 af = *(const LAS bf16x8*)(KTs + (32 * w + l32) * 72 + ks * 16 + hi * 8);
                S = __builtin_amdgcn_mfma_f32_32x32x16_bf16(af, vb[ks], S, 0, 0, 0); }
            __syncthreads();
            if (!isctx) { const int t = tid >> 3, v4 = (tid & 7) * 4; f32x4 acc = *(const LAS f32x4*)(PART + t * 32 + v4);
#pragma unroll
                for (int ww = 1; ww < 8; ++ww) acc = acc + *(const LAS f32x4*)(PART + (ww * 64 + t) * 32 + v4);
                *(f32x4*)(Od + (row0 + t) * D + h * 512 + slice * 32 + v4) = acc; }
        }
#undef GLA_LOAD
        __syncthreads();
    }
}
__device__ __forceinline__ void phase_gla_finish(Frame& F, const float* O0, const float* O1, const bf16_t* P, const float* g, bf16_t* OUT) {
    const int f_tid = fresh_tid(), f_lane = f_tid & 63, f_wave = __builtin_amdgcn_readfirstlane(f_tid >> 6); (void)f_lane; (void)f_wave;
    const int gw = F.vcu * NWAVES + f_wave, NGW = F.G * NWAVES, lane = f_lane;
    const f32x4 ga = *(const f32x4*)(g + 8 * lane), gb = *(const f32x4*)(g + 8 * lane + 4);
    for (int lr = gw; lr < BATCH * SEQ; lr += NGW) {
        const size_t row = (size_t)(lr >> 12) * RB + (lr & 4095);
#pragma unroll
        for (int h = 0; h < 4; ++h) {
            const size_t o = row * D + h * 512 + 8 * lane;
            const f32x4 a0 = *(const f32x4*)(O0 + o) + *(const f32x4*)(O1 + o), a1 = *(const f32x4*)(O0 + o + 4) + *(const f32x4*)(O1 + o + 4);
            const float ss = wave_sum((a0.x * a0.x + a0.y * a0.y) + (a0.z * a0.z + a0.w * a0.w) + (a1.x * a1.x + a1.y * a1.y) + (a1.z * a1.z + a1.w * a1.w));
            const float rn = rsqrtf(ss * (1.f / 512.f) + 1e-6f);
            const u32x4 rr = *(const u32x4*)(P + row * 6400 + 4096 + h * 512 + 8 * lane);
            const float rv[8] = {bflo(rr.x), bfhi(rr.x), bflo(rr.y), bfhi(rr.y), bflo(rr.z), bfhi(rr.z), bflo(rr.w), bfhi(rr.w)};
            float y[8] = {a0.x * ga.x, a0.y * ga.y, a0.z * ga.z, a0.w * ga.w, a1.x * gb.x, a1.y * gb.y, a1.z * gb.z, a1.w * gb.w};
#pragma unroll
            for (int e = 0; e < 8; ++e) y[e] = y[e] * rn * (rv[e] / (1.f + __expf(-rv[e])));
            *(u32x4*)(OUT + o) = (u32x4){cvt_pk_bf16(y[0], y[1]), cvt_pk_bf16(y[2], y[3]), cvt_pk_bf16(y[4], y[5]), cvt_pk_bf16(y[6], y[7])};
        }
    }
}
enum { PH_PRO = 0, L0_MOD = 1, L0_CH = 2, L0_POS = 3, L0_OUT = 4, L0_FMOD = 5, L0_FIN = 6, L0_FOUT = 7,
       L1_MOD = 8, L1_IN = 9, L1_SP = 10, L1_OUT = 11, L1_FMOD = 12, L1_FIN = 13, L1_FOUT = 14,
       L2_MOD = 15, L2_QKV = 16, L2_ATT = 17, L2_CMB = 18, L2_OUT = 19, L2_FMOD = 20, L2_FIN = 21, L2_FOUT = 22,
       L3_MOD = 23, L3_IN = 24, L3_G1 = 25, L3_G2 = 26, L3_FSH = 27, L3_OUT = 28, L3_FMOD = 29, L3_FIN = 30, L3_FOUT = 31, PH_FINAL = 32, NPH = 33 };

__global__ void __launch_bounds__(NWAVES * 64, 2) mk_fwd(Args args) {
    extern __shared__ __attribute__((aligned(16))) unsigned char lds_raw[];
    Frame F;
    F.lds = (LAS unsigned char*)lds_raw; F.MISC = (volatile LAS unsigned*)(F.lds + MISC_OFF);
    F.tid = threadIdx.x; F.lane = F.tid & 63; F.wave = __builtin_amdgcn_readfirstlane(F.tid >> 6);
    F.G = gridDim.x; { const int bx = blockIdx.x; F.vcu = (F.G % 8 == 0) ? (bx % 8) * (F.G / 8) + bx / 8 : bx; }
    unsigned char* ws = args.ws; F.ctl = (unsigned*)(ws + WS_CTL);
    for (int u = F.tid; u < (LDS_BYTES - MISC_OFF) / 4; u += NWAVES * 64) ((LAS unsigned*)(F.lds + MISC_OFF))[u] = 0u;
    __syncthreads();
    const int lo = args.ph_lo, hi = args.ph_hi;
    XcdBarrier bar; bar.bar = F.ctl + args.li * XCD_BAR_WORDS; bar.x = 0; bar.st = F.MISC + 8;
    if (hi - lo > 1) bar = xcd_barrier_post(F.ctl + args.li * XCD_BAR_WORDS, F.MISC + 8);
#define IN(k) (lo <= (k) && (k) < hi)
#ifndef REP_BAR
#define REP_BAR 1
#endif
#define SEAM(k) do { if (IN(k) && IN((k) + 1)) { xcd_barrier(bar); if (REP_BAR == 2) xcd_barrier(bar); } } while (0)
#ifndef REP_FOUT
#define REP_FOUT 1
#endif
#ifndef REP_OUT
#define REP_OUT 1
#endif
#ifndef REP_POS
#define REP_POS 1
#endif
#ifndef REP_FIN
#define REP_FIN 1
#endif
#ifndef REP_MIXIN
#define REP_MIXIN 1
#endif
#ifndef REP_ATT
#define REP_ATT 1
#endif
#ifndef REP_G1
#define REP_G1 1
#endif
#ifndef REP_G2
#define REP_G2 1
#endif
#ifndef REP_PRO
#define REP_PRO 1
#endif
#ifndef REP_THIN
#define REP_THIN 1
#endif
    float* XR = (float*)(ws + WS_XR); const float* MOD = (const float*)(ws + WS_MOD);
    bf16_t* H = (bf16_t*)(ws + WS_H); bf16_t* BIG = (bf16_t*)(ws + WS_BIG);
    const int cu = (int)blockIdx.x;

    if (IN(PH_PRO)) { phase_prologue(F, args); if (REP_PRO == 2) { VM_WAIT(); __syncthreads(); phase_prologue(F, args); } SEAM(PH_PRO); }

#define BG_WIN(l, part, nparts)  transpose_part(F, args.in[8] + (size_t)(l) * D * DFF, D, DFF, (bf16_t*)(ws + WS_WIN_T) + (size_t)(l) * DFF * D, D, part, nparts)
#define BG_WOUT(l, part, nparts) transpose_part(F, args.in[9] + (size_t)(l) * DFF * D, DFF, D, (bf16_t*)(ws + WS_WOUT_T) + (size_t)(l) * LDH * D, LDH, part, nparts)
#define KS_OUT 8
#define KS_FOUT 16
    float* PEND = (float*)(ws + WS_F1);
#define RESID_GEMM(Aptr, Btptr, KK, LD, GATE, KS, SKIPC) do { \
        { pg8::Gemm g{Aptr, Btptr, LD, LD, KK}; pg8::Sched2D S{32, D / 256, F.G, cu, LD, LD, 1, ((KK) == DFF) ? REP_FOUT : REP_OUT}; pg8::EpiResid E{XR, GATE}; pg8::gemm_phase<pg8::EpiResid, pg8::Sched2D, true>(F.lds, g, S, E); } \
        if (!(SKIPC)) { pg8::Gemm g{Aptr, Btptr, LD, LD, (KK) / (KS)}; pg8::SchedCtxSplit S{D / 256, KS, F.G, (F.G - 1 - cu), LD, LD, (KK) / (KS)}; pg8::EpiPartial E{PEND}; pg8::gemm_phase<pg8::EpiPartial, pg8::SchedCtxSplit, true>(F.lds, g, S, E); } } while (0)
#define FFN_PHASES(l, P_FMOD, P_FIN, P_FOUT, SKIPC) \
    if (IN(P_FMOD)) { const float* mod = MOD + (size_t)(l) * 3 * NMOD; phase_modulate(F, XR, args.in[7] + (l) * D, mod + 3 * D, mod + 4 * D, H, SKIPC, (SKIPC) ? nullptr : PEND, KS_OUT, mod + 2 * D); if (REP_THIN == 2) { VM_WAIT(); __syncthreads(); phase_modulate(F, XR, args.in[7] + (l) * D, mod + 3 * D, mod + 4 * D, H, SKIPC); } SEAM(P_FMOD); } \
    if (IN(P_FIN)) { pg8::Gemm g{H, (const bf16_t*)(ws + WS_WIN_T) + (size_t)(l) * DFF * D, D, D, D}; pg8::Sched2D S{(SKIPC) ? 32 : 34, DFF / 256, F.G, cu, D, D, SKIPC, REP_FIN}; \
        pg8::EpiBf16<2> E{BIG, LDH, 1.f}; pg8::gemm_phase<pg8::EpiBf16<2>, pg8::Sched2D, true>(F.lds, g, S, E); \
        if (!(SKIPC)) { const int part_ = F.G == 256 ? cu - 64 : cu, np_ = F.G == 256 ? 192 : F.G; if (part_ >= 0) { BG_WIN((l) + 1, part_, np_); \
            } } SEAM(P_FIN); } \
    if (IN(P_FOUT)) { const float* mod = MOD + (size_t)(l) * 3 * NMOD; RESID_GEMM(BIG, (const bf16_t*)(ws + WS_WOUT_T) + (size_t)(l) * LDH * D, DFF, LDH, mod + 5 * D, KS_FOUT, SKIPC); SEAM(P_FOUT); }

    bf16_t* A2 = (bf16_t*)(ws + WS_A2);
    if (IN(L0_MOD)) { phase_modulate(F, XR, args.in[6] + 0 * D, MOD + 0 * D, MOD + 1 * D, H, false); SEAM(L0_MOD); }
    if (IN(L0_CH)) { pg8::Gemm g{(const bf16_t*)(ws + WS_TC), H, 512, D, 512}; pg8::SchedChan S{F.G, cu}; pg8::EpiChan E{BIG, BIG + (size_t)2 * 2048 * LDH};
        pg8::gemm_phase<pg8::EpiChan, pg8::SchedChan, true>(F.lds, g, S, E);
        if (F.G == 256 && cu >= 32) transpose_part(F, args.in[17], D, D, (bf16_t*)(ws + WS_GMOUT_T), D, cu - 32, 224); else if (F.G != 256) transpose_part(F, args.in[17], D, D, (bf16_t*)(ws + WS_GMOUT_T), D, cu, F.G); SEAM(L0_CH); }
    if (IN(L0_POS)) {
        { pg8::Gemm g{(const bf16_t*)(ws + WS_PT), BIG, LDP, LDH, 4096}; pg8::SchedPos2 S{F.G, cu, REP_POS}; pg8::EpiF32 E{(float*)(ws + WS_F1), D};
          pg8::gemm_phase<pg8::EpiF32, pg8::SchedPos2, true>(F.lds, g, S, E); }
        { pg8::Gemm g{(const bf16_t*)(ws + WS_PC), BIG + (size_t)2 * 2048 * LDH, 512, 512, 512}; pg8::SchedPosC S{F.G, cu}; pg8::EpiBf16<0> E{A2, D, 0.0027621358640099515f};
          pg8::gemm_phase<pg8::EpiBf16<0>, pg8::SchedPosC, true>(F.lds, g, S, E); }
        xcd_barrier(bar);
        phase_fourier_combine(F, (const float*)(ws + WS_F1), BIG, A2);
        SEAM(L0_POS); }
    if (IN(L0_OUT)) { RESID_GEMM(A2, (const bf16_t*)(ws + WS_FNO_T), D, D, MOD + 2 * D, KS_OUT, 0); SEAM(L0_OUT); }
    FFN_PHASES(0, L0_FMOD, L0_FIN, L0_FOUT, 0)

    if (IN(L1_MOD)) { const float* mod = MOD + (size_t)1 * 3 * NMOD; phase_modulate(F, XR, args.in[6] + 1 * D, mod + 0 * D, mod + 1 * D, H, false, PEND, KS_FOUT, MOD + (size_t)0 * 3 * NMOD + 5 * D); SEAM(L1_MOD); }
    if (IN(L1_IN)) { pg8::Gemm g{H, (const bf16_t*)(ws + WS_GMIN_T), D, D, D}; pg8::Sched2D S{34, 16, F.G, cu, D, D, 0, REP_MIXIN}; pg8::EpiGeluStats<true> E{BIG, 4096, (float*)(ws + WS_LNS)};
        pg8::gemm_phase<pg8::EpiGeluStats<true>, pg8::Sched2D, true>(F.lds, g, S, E);
        { const int part_ = F.G == 256 ? cu - 32 : cu, np_ = F.G == 256 ? 224 : F.G; if (part_ >= 0) { BG_WOUT(1, part_, np_); } } SEAM(L1_IN); }
    if (IN(L1_SP)) { phase_spatial(F, BIG, (const float*)(ws + WS_LNS), args.in[13], args.in[14], (const bf16_t*)(ws + WS_GMWS), args.in[16], A2); if (REP_THIN == 2) phase_spatial(F, BIG, (const float*)(ws + WS_LNS), args.in[13], args.in[14], (const bf16_t*)(ws + WS_GMWS), args.in[16], A2); SEAM(L1_SP); }
    if (IN(L1_OUT)) { const float* mod = MOD + (size_t)1 * 3 * NMOD; RESID_GEMM(A2, (const bf16_t*)(ws + WS_GMOUT_T), D, D, mod + 2 * D, KS_OUT, 0); SEAM(L1_OUT); }
    FFN_PHASES(1, L1_FMOD, L1_FIN, L1_FOUT, 0)

    float* F1 = (float*)(ws + WS_F1); float* F2 = (float*)(ws + WS_F2);
    if (IN(L2_MOD)) { const float* mod = MOD + (size_t)2 * 3 * NMOD; phase_modulate(F, XR, args.in[6] + 2 * D, mod + 0 * D, mod + 1 * D, H, false, PEND, KS_FOUT, MOD + (size_t)1 * 3 * NMOD + 5 * D); SEAM(L2_MOD); }
    if (IN(L2_QKV)) { pg8::Gemm g{H, (const bf16_t*)(ws + WS_DFIN_T), D, D, D}; pg8::Sched2D S{34, 24, F.G, cu, D, D, 0, REP_MIXIN}; pg8::EpiQKV E{BIG, (const float*)(ws + WS_ROPE)};
        pg8::gemm_phase<pg8::EpiQKV, pg8::Sched2D, true>(F.lds, g, S, E);
        { const int part_ = F.G == 256 ? cu - 48 : cu, np_ = F.G == 256 ? 208 : F.G; if (part_ >= 0) { BG_WOUT(2, part_, np_); } } SEAM(L2_QKV); }
    if (IN(L2_ATT)) { phase_attention2(F, BIG, args.in[19], args.in[20], A2, REP_ATT); SEAM(L2_ATT); }
    if (IN(L2_OUT)) { const float* mod = MOD + (size_t)2 * 3 * NMOD; RESID_GEMM(A2, (const bf16_t*)(ws + WS_DFOUT_T), D, D, mod + 2 * D, KS_OUT, 0); SEAM(L2_OUT); }
    FFN_PHASES(2, L2_FMOD, L2_FIN, L2_FOUT, 0)

    if (IN(L3_MOD)) { const float* mod = MOD + (size_t)3 * 3 * NMOD; phase_modulate(F, XR, args.in[6] + 3 * D, mod + 0 * D, mod + 1 * D, H, false, PEND, KS_FOUT, MOD + (size_t)2 * 3 * NMOD + 5 * D); SEAM(L3_MOD); }
    if (IN(L3_IN)) { pg8::Gemm g{H, (const bf16_t*)(ws + WS_GLIN_T), D, D, D}; pg8::Sched2D S{34, 25, F.G, cu, D, D, 0, REP_MIXIN}; pg8::EpiGla E{BIG, (float*)(ws + G_GD)};
        pg8::gemm_phase<pg8::EpiGla, pg8::Sched2D, true>(F.lds, g, S, E);
        if (F.G == 256 && cu >= 82) BG_WOUT(3, cu - 82, 174); else if (F.G != 256) BG_WOUT(3, cu, F.G); SEAM(L3_IN); }
    if (IN(L3_G1)) { phase_gla_pre(F, BIG, (const float*)(ws + G_GD), args.in[23], args.in[24], ws, REP_G1); SEAM(L3_G1); }
    if (IN(L3_G2)) { phase_gla_scan(F, ws, F1, F2, REP_G2); SEAM(L3_G2); }
    if (IN(L3_FSH)) { phase_gla_finish(F, F1, F2, BIG, args.in[25], A2); if (REP_THIN == 2) phase_gla_finish(F, F1, F2, BIG, args.in[25], A2); SEAM(L3_FSH); }
    if (IN(L3_OUT)) { const float* mod = MOD + (size_t)3 * 3 * NMOD; pg8::Gemm g{A2, (const bf16_t*)(ws + WS_GLOUT_T), D, D, D}; pg8::Sched2D S{32, D / 256, F.G, cu, D, D, 1}; pg8::EpiResid E{XR, mod + 2 * D};
        pg8::gemm_phase<pg8::EpiResid, pg8::Sched2D, true>(F.lds, g, S, E); SEAM(L3_OUT); }
    FFN_PHASES(3, L3_FMOD, L3_FIN, L3_FOUT, 1)

    if (IN(PH_FINAL)) { phase_final(F, XR, args.in[10], args.out); }
#undef IN
#undef SEAM
}
#ifndef MK_ONE_LAUNCH
#define MK_ONE_LAUNCH 1
#endif
extern "C" void kernel_launch(void* const* d_in, const int* in_sizes, int n_in, void* d_out, int out_size, void* d_ws, size_t ws_size, hipStream_t st) {
    static int grid = 0;
    if (grid == 0) {
        int dev = 0, cus = 0;
        if (hipGetDevice(&dev) != hipSuccess || hipDeviceGetAttribute(&cus, hipDeviceAttributeMultiprocessorCount, dev) != hipSuccess) { fprintf(stderr, "device query failed\n"); grid = -1; return; }
        if (hipFuncSetAttribute((const void*)mk_fwd, hipFuncAttributeMaxDynamicSharedMemorySize, LDS_BYTES) != hipSuccess) { fprintf(stderr, "hipFuncSetAttribute failed\n"); grid = -1; return; }
        if (WS_END_MK > ws_size) { fprintf(stderr, "ws too small: need %zu have %zu\n", (size_t)WS_END_MK, ws_size); grid = -1; return; }
        grid = cus;
    }
    if (grid < 0) return;
    unsigned char* wsb = (unsigned char*)d_ws;
    (void)hipMemsetAsync(wsb + WS_CTL, 0, CTL_ZERO_BYTES, st);
    Args a{};
    for (int i = 0; i < 27; ++i) a.in[i] = (const float*)d_in[i];
    a.out = (float*)d_out; a.ws = wsb;
    if (MK_ONE_LAUNCH) { a.ph_lo = 0; a.ph_hi = NPH; a.li = 0; hipLaunchKernelGGL(mk_fwd, dim3(grid), dim3(NWAVES * 64), LDS_BYTES, st, a); }
    else for (int p = 0; p < NPH; ++p) { a.ph_lo = p; a.ph_hi = p + 1; a.li = p; hipLaunchKernelGGL(mk_fwd, dim3(grid), dim3(NWAVES * 64), LDS_BYTES, st, a); }
}
```
